# Optimizing an MI355X kernel written in HIP

```python
import math
import jax
import jax.numpy as jnp
from jax import lax
import numpy as np

D_MODEL = 1024
BATCH = 16
SEQ = 2048
DEPTH = 2

GRID_W = 64
CTX_LEN = 256
EPS = 1e-6
ROPE_THETA = 10000.0
Q_BLOCK = 128

S5_WIDTH = D_MODEL // 2
S5_GROUP = 16
S5_GROUPS = S5_WIDTH // S5_GROUP
S5_STATE = 64
MLA_HEADS = 4
MLA_NOPE = 128
MLA_ROPE = 64
MLA_V = 128
MLA_Q_RANK = 3 * D_MODEL // 8
MLA_KV_RANK = D_MODEL // 4
RET_HEADS = 4
RET_DK = 128
RET_DV = 128
RET_CHUNK = 128
GQA_HEADS = 4
GQA_KV_HEADS = 2
GQA_HEAD_DIM = 128
FFN_HIDDEN = ((8 * D_MODEL // 3 + 127) // 128) * 128
CONV_W = 3

AB_SIZES = (S5_WIDTH, MLA_Q_RANK, MLA_KV_RANK, MLA_ROPE)
AB_IN = S5_WIDTH + MLA_Q_RANK + MLA_KV_RANK + MLA_ROPE
AB_OUT = S5_WIDTH + MLA_HEADS * MLA_V
CD_SIZES = (RET_HEADS * RET_DK, RET_HEADS * RET_DK, RET_HEADS * RET_DV, RET_HEADS * RET_DV,
            GQA_HEADS * GQA_HEAD_DIM, GQA_KV_HEADS * GQA_HEAD_DIM, GQA_KV_HEADS * GQA_HEAD_DIM)
CD_IN = 2 * RET_HEADS * RET_DK + 2 * RET_HEADS * RET_DV + (GQA_HEADS + 2 * GQA_KV_HEADS) * GQA_HEAD_DIM
CD_OUT = RET_HEADS * RET_DV + GQA_HEADS * GQA_HEAD_DIM

kernel_name = 'hybrid_s5_mla_retention_gqa_prefix_dit'


def rmsnorm(x):
    x32 = x.astype(jnp.float32)
    y = x32 * lax.rsqrt(jnp.mean(x32 * x32, axis=-1, keepdims=True) + EPS)
    return y.astype(x.dtype)


def modulate(h, shift, scale):
    return h * (1.0 + scale) + shift


def heads(t, n_heads):
    return t.reshape(t.shape[:2] + (n_heads, -1))


def split_cols(z, sizes):
    cuts, acc = [], 0
    for s in sizes[:-1]:
        acc += s
        cuts.append(acc)
    return jnp.split(z, cuts, axis=-1)


def rope_tables(rows, cols, dim):
    quarter = dim // 4
    inv = ROPE_THETA ** (-jnp.arange(quarter, dtype=jnp.float32) / quarter)
    ang_r = rows.astype(jnp.float32)[:, None] * inv
    ang_c = cols.astype(jnp.float32)[:, None] * inv
    ang = jnp.concatenate([ang_r, ang_r, ang_c, ang_c], axis=-1)
    return jnp.cos(ang), jnp.sin(ang)


def apply_rope(x, cos, sin):
    r1, r2, c1, c2 = jnp.split(x, 4, axis=-1)
    rot = jnp.concatenate([-r2, r1, -c2, c1], axis=-1)
    return (x * cos[:, None, :] + rot * sin[:, None, :]).astype(x.dtype)


def attend(q, k, v):
    s = jnp.einsum('bqgrd,bkgd->bgrqk', q, k).astype(jnp.float32) * (q.shape[-1] ** -0.5)
    p = jax.nn.softmax(s, axis=-1).astype(v.dtype)
    o = jnp.einsum('bgrqk,bkge->bqgre', p, v)
    return o.reshape(o.shape[:2] + (-1,))


def attend_blocked(q, k, v):
    b, n = q.shape[:2]
    qb = jnp.swapaxes(q.reshape((b, n // Q_BLOCK, Q_BLOCK) + q.shape[2:]), 0, 1)
    o = lax.map(lambda qi: attend(qi, k, v), qb)
    return jnp.swapaxes(o, 0, 1).reshape(b, n, -1)


def zoh_power(ar, ai, k):
    mag = jnp.exp(ar * k)
    return mag * jnp.cos(ai * k), mag * jnp.sin(ai * k)


def s5_discretise(lam_re, lam_im, log_step, b_re, b_im):
    lam_re, lam_im = lam_re.astype(jnp.float32), lam_im.astype(jnp.float32)
    dt = jnp.exp(log_step.astype(jnp.float32))[:, None]
    ar, ai = lam_re * dt, lam_im * dt
    lb_re, lb_im = zoh_power(ar, ai, 1.0)
    den = lam_re * lam_re + lam_im * lam_im
    cf_re = ((lb_re - 1.0) * lam_re + lb_im * lam_im) / den
    cf_im = (lb_im * lam_re - (lb_re - 1.0) * lam_im) / den
    b_re, b_im = b_re.astype(jnp.float32), b_im.astype(jnp.float32)
    bb_re = cf_re[..., None] * b_re - cf_im[..., None] * b_im
    bb_im = cf_re[..., None] * b_im + cf_im[..., None] * b_re
    return ar, ai, bb_re, bb_im


def complex_affine_combine(e1, e2):
    a1r, a1i, b1r, b1i = e1
    a2r, a2i, b2r, b2i = e2
    return (a2r * a1r - a2i * a1i, a2r * a1i + a2i * a1r,
            a2r * b1r - a2i * b1i + b2r, a2r * b1i + a2i * b1r + b2i)


def s5_scan(u, disc, s0):
    ar, ai, bb_re, bb_im = disc
    n = u.shape[1]
    bu_re = jnp.einsum('gph,bngh->bngp', bb_re, u)
    bu_im = jnp.einsum('gph,bngh->bngp', bb_im, u)
    lb_re, lb_im = zoh_power(ar, ai, 1.0)
    a_re = jnp.broadcast_to(lb_re, (1, n) + lb_re.shape)
    a_im = jnp.broadcast_to(lb_im, (1, n) + lb_im.shape)
    _, _, s_re, s_im = lax.associative_scan(complex_affine_combine, (a_re, a_im, bu_re, bu_im), axis=1)
    if s0 is not None:
        k = jnp.arange(1, n + 1, dtype=jnp.float32)[:, None, None]
        p_re, p_im = zoh_power(ar, ai, k)
        s0_re, s0_im = s0[0][:, None], s0[1][:, None]
        s_re, s_im = (s_re + p_re * s0_re - p_im * s0_im,
                      s_im + p_re * s0_im + p_im * s0_re)
    return s_re, s_im


def s5_readout(c_re, c_im, s_re, s_im):
    return (jnp.einsum('ghp,bngp->bngh', c_re.astype(jnp.float32), s_re)
            - jnp.einsum('ghp,bngp->bngh', c_im.astype(jnp.float32), s_im))


def s5_mixer(uc, ux, lam_re, lam_im, log_step, b_re, b_im, c_re, c_im, d_skip, w_glu, b_glu, ctx_out):
    dtype = ux.dtype
    uc32 = uc.astype(jnp.float32).reshape(uc.shape[:2] + (S5_GROUPS, S5_GROUP))
    ux32 = ux.astype(jnp.float32).reshape(ux.shape[:2] + (S5_GROUPS, S5_GROUP))
    d32 = d_skip.astype(jnp.float32)
    yx = d32 * ux32
    yc = d32 * uc32 if ctx_out else None
    for d in range(2):
        flip = (lambda t: jnp.flip(t, axis=1)) if d == 1 else (lambda t: t)
        disc = s5_discretise(lam_re[d], lam_im[d], log_step[d], b_re[d], b_im[d])
        sc_re, sc_im = s5_scan(flip(uc32), disc, None)
        sx_re, sx_im = s5_scan(flip(ux32), disc, (sc_re[:, -1], sc_im[:, -1]))
        yx = yx + flip(s5_readout(c_re[d], c_im[d], sx_re, sx_im))
        if ctx_out:
            yc = yc + flip(s5_readout(c_re[d], c_im[d], sc_re, sc_im))

    def glu(y):
        g = jax.nn.gelu(y.reshape(y.shape[:2] + (S5_WIDTH,)))
        return (g * jax.nn.sigmoid(g @ w_glu.astype(jnp.float32) + b_glu.astype(jnp.float32))).astype(dtype)

    return (glu(yc) if ctx_out else None), glu(yx)


def mla_q(cq, g_q, w_uq, rope):
    q = heads((rmsnorm(cq) * g_q) @ w_uq, MLA_HEADS)
    q_nope, q_rope = q[..., :MLA_NOPE], q[..., MLA_NOPE:]
    if rope is not None:
        q_rope = apply_rope(q_rope, *rope)
    return jnp.concatenate([q_nope, q_rope], axis=-1)[:, :, :, None, :]


def mla_kv(ckv, kr, g_kv, w_ukv, rope):
    kv = heads((rmsnorm(ckv) * g_kv) @ w_ukv, MLA_HEADS)
    k_nope, v = kv[..., :MLA_NOPE], kv[..., MLA_NOPE:]
    kr = kr[:, :, None, :]
    if rope is not None:
        kr = apply_rope(kr, *rope)
    kr = jnp.broadcast_to(kr, k_nope.shape[:3] + (MLA_ROPE,))
    return jnp.concatenate([k_nope, kr], axis=-1), v


def mixer_ab(cn, xn, rope, w_in, w_out, lam_re, lam_im, log_step, b_re, b_im, c_re, c_im, d_skip,
             w_glu, b_glu, g_q, w_uq, g_kv, w_ukv, ctx_out):
    uc, cqc, ckvc, krc = split_cols(cn @ w_in, AB_SIZES)
    ux, cqx, ckvx, krx = split_cols(xn @ w_in, AB_SIZES)
    s5_c, s5_x = s5_mixer(uc, ux, lam_re, lam_im, log_step, b_re, b_im, c_re, c_im, d_skip,
                          w_glu, b_glu, ctx_out)
    kc, vc = mla_kv(ckvc, krc, g_kv, w_ukv, None)
    kx, vx = mla_kv(ckvx, krx, g_kv, w_ukv, rope)
    att_x = attend_blocked(mla_q(cqx, g_q, w_uq, rope),
                           jnp.concatenate([kc, kx], axis=1), jnp.concatenate([vc, vx], axis=1))
    yx = jnp.concatenate([s5_x, att_x], axis=-1) @ w_out
    if not ctx_out:
        return None, yx
    att_c = attend(mla_q(cqc, g_q, w_uq, None), kc, vc)
    return jnp.concatenate([s5_c, att_c], axis=-1) @ w_out, yx


def retention_context_states(k, v, lg):
    L = k.shape[1]
    m = jnp.arange(L, dtype=jnp.float32)[:, None]
    w_f = jnp.exp((L - 1.0 - m) * lg[0])
    w_b = jnp.exp(m * lg[1])
    s_f = jnp.einsum('bmhk,bmhv,mh->bhkv', k, v, w_f)
    s_b = jnp.einsum('bmhk,bmhv,mh->bhkv', k, v, w_b)
    return s_f, s_b


def retention_chunkwise(q, k, v, lg, s0):
    b, n, h, _ = q.shape
    c = RET_CHUNK
    nc = n // c
    i = jnp.arange(c, dtype=jnp.float32)
    dist = i[:, None] - i[None, :]
    inner_decay = jnp.where(dist >= 0, jnp.exp(jnp.maximum(dist, 0.0)[None] * lg[:, None, None]), 0.0)
    q_decay = jnp.exp((i[:, None] + 1.0) * lg)
    k_decay = jnp.exp((c - 1.0 - i)[:, None] * lg)
    chunk_decay = jnp.exp(c * lg)

    def chunks(t):
        return jnp.swapaxes(t.reshape(b, nc, c, h, t.shape[-1]), 0, 1)

    def step(s, qkv):
        qc, kc, vc = qkv
        att = jnp.einsum('bihk,bjhk->bhij', qc, kc) * inner_decay
        o = (jnp.einsum('bhij,bjhv->bihv', att, vc)
             + jnp.einsum('bihk,bhkv->bihv', qc, s) * q_decay[:, :, None])
        s = chunk_decay[:, None, None] * s + jnp.einsum('bjhk,bjhv,jh->bhkv', kc, vc, k_decay)
        return s, o

    _, o = lax.scan(step, s0, (chunks(q), chunks(k), chunks(v)))
    return jnp.swapaxes(o, 0, 1).reshape(b, n, h, -1)


def retention_latent(q, k, v, s_f, s_b, lg):
    fwd = retention_chunkwise(q, k, v, lg[0], s_f)
    bwd = retention_chunkwise(jnp.flip(q, 1), jnp.flip(k, 1), jnp.flip(v, 1), lg[1], s_b)
    return fwd + jnp.flip(bwd, 1)


def retention_context(q, k, v, lg):
    L = q.shape[1]
    m = jnp.arange(L, dtype=jnp.float32)
    dist = m[:, None] - m[None, :]
    dec = (jnp.where(dist >= 0, jnp.exp(jnp.maximum(dist, 0.0)[None] * lg[0][:, None, None]), 0.0)
           + jnp.where(dist <= 0, jnp.exp(jnp.maximum(-dist, 0.0)[None] * lg[1][:, None, None]), 0.0))
    att = jnp.einsum('bihk,bjhk->bhij', q, k) * dec
    return jnp.einsum('bhij,bjhv->bihv', att, v)


def retention_output(o, gate):
    b, n = o.shape[:2]
    return rmsnorm(o).reshape(b, n, -1) * jax.nn.silu(gate.astype(jnp.float32))


def mixer_cd(cn, xn, rope, w_in, w_out, decay_logit, g_q, g_k, ctx_out):
    dtype = xn.dtype
    rq_c, rk_c, rv_c, rg_c, gq_c, gk_c, gv_c = split_cols(cn @ w_in, CD_SIZES)
    rq_x, rk_x, rv_x, rg_x, gq_x, gk_x, gv_x = split_cols(xn @ w_in, CD_SIZES)
    lg = jax.nn.log_sigmoid(decay_logit.astype(jnp.float32))
    k_scale = RET_DK ** -0.5

    def f32(t):
        return t.astype(jnp.float32)

    kc_r = f32(heads(rk_c, RET_HEADS)) * k_scale
    vc_r = f32(heads(rv_c, RET_HEADS))
    s_f, s_b = retention_context_states(kc_r, vc_r, lg)
    qx_r = f32(apply_rope(heads(rq_x, RET_HEADS), *rope))
    kx_r = f32(apply_rope(heads(rk_x, RET_HEADS), *rope)) * k_scale
    vx_r = f32(heads(rv_x, RET_HEADS))
    ret_x = retention_output(retention_latent(qx_r, kx_r, vx_r, s_f, s_b, lg), rg_x)

    def gqa_q(t, rot):
        q = rmsnorm(heads(t, GQA_HEADS)) * g_q
        if rot is not None:
            q = apply_rope(q, *rot)
        return q.reshape(q.shape[:2] + (GQA_KV_HEADS, GQA_HEADS // GQA_KV_HEADS, GQA_HEAD_DIM))

    def gqa_k(t, rot):
        k = rmsnorm(heads(t, GQA_KV_HEADS)) * g_k
        return apply_rope(k, *rot) if rot is not None else k

    kc_g, vc_g = gqa_k(gk_c, None), heads(gv_c, GQA_KV_HEADS)
    att_x = attend_blocked(gqa_q(gq_x, rope),
                           jnp.concatenate([kc_g, gqa_k(gk_x, rope)], axis=1),
                           jnp.concatenate([vc_g, heads(gv_x, GQA_KV_HEADS)], axis=1))
    yx = jnp.concatenate([ret_x.astype(dtype), att_x], axis=-1) @ w_out
    if not ctx_out:
        return None, yx
    qc_r = f32(heads(rq_c, RET_HEADS))
    ret_c = retention_output(retention_context(qc_r, kc_r, vc_r, lg), rg_c)
    att_c = attend(gqa_q(gq_c, None), kc_g, vc_g)
    return jnp.concatenate([ret_c.astype(dtype), att_c], axis=-1) @ w_out, yx


def conv_ffn(h, w_up, conv_w, conv_b, w_down):
    a, g = jnp.split(h @ w_up, 2, axis=-1)
    n = a.shape[1]
    pad = CONV_W // 2
    ap = jnp.pad(a, ((0, 0), (pad, pad), (0, 0)))
    conv = conv_b
    for j in range(CONV_W):
        conv = conv + ap[:, j:j + n] * conv_w[j]
    return (jax.nn.gelu(conv) * g) @ w_down


def setup_inputs(seed: int = 0) -> dict:
    key = jax.random.key(seed)
    ks = iter(jax.random.split(key, 48))

    def nrm(shape, scale):
        return jax.random.normal(next(ks), shape, jnp.float32) * scale

    ne, no = (DEPTH + 1) // 2, DEPTH // 2
    D, F = D_MODEL, FFN_HIDDEN
    gamma0 = 1.0 - 2.0 ** (-5.0 - jnp.arange(RET_HEADS, dtype=jnp.float32))
    decay_logit0 = jnp.log(gamma0) - jnp.log1p(-gamma0)
    return {
        'x': nrm((BATCH, SEQ, D), 1.0),
        'c': nrm((BATCH, D), 1.0),
        'ctx': nrm((BATCH, CTX_LEN, D), 1.0),
        'c_ctx': nrm((D,), 1.0),
        'w_mod': nrm((DEPTH, D, 6 * D), 0.5 * D ** -0.5),
        'b_mod': nrm((DEPTH, 6 * D), 0.02),
        'w_in_ab': nrm((ne, D, AB_IN), D ** -0.5),
        'w_out_ab': nrm((ne, AB_OUT, D), AB_OUT ** -0.5),
        's5_lam_re': -0.5 + nrm((ne, 2, S5_GROUPS, S5_STATE), 0.01),
        's5_lam_im': math.pi * jnp.arange(S5_STATE, dtype=jnp.float32) + nrm((ne, 2, S5_GROUPS, S5_STATE), 0.01),
        's5_log_step': jax.random.uniform(next(ks), (ne, 2, S5_GROUPS), jnp.float32,
                                          math.log(1e-3), math.log(1e-1)),
        's5_b_re': nrm((ne, 2, S5_GROUPS, S5_STATE, S5_GROUP), (2 * S5_GROUP) ** -0.5),
        's5_b_im': nrm((ne, 2, S5_GROUPS, S5_STATE, S5_GROUP), (2 * S5_GROUP) ** -0.5),
        's5_c_re': nrm((ne, 2, S5_GROUPS, S5_GROUP, S5_STATE), S5_STATE ** -0.5),
        's5_c_im': nrm((ne, 2, S5_GROUPS, S5_GROUP, S5_STATE), S5_STATE ** -0.5),
        's5_d': nrm((ne, S5_GROUPS, S5_GROUP), 1.0),
        's5_w_glu': nrm((ne, S5_WIDTH, S5_WIDTH), S5_WIDTH ** -0.5),
        's5_b_glu': nrm((ne, S5_WIDTH), 0.02),
        'mla_g_q': 1.0 + nrm((ne, MLA_Q_RANK), 0.02),
        'mla_w_uq': nrm((ne, MLA_Q_RANK, MLA_HEADS * (MLA_NOPE + MLA_ROPE)), MLA_Q_RANK ** -0.5),
        'mla_g_kv': 1.0 + nrm((ne, MLA_KV_RANK), 0.02),
        'mla_w_ukv': nrm((ne, MLA_KV_RANK, MLA_HEADS * (MLA_NOPE + MLA_V)), MLA_KV_RANK ** -0.5),
        'w_in_cd': nrm((no, D, CD_IN), D ** -0.5),
        'w_out_cd': nrm((no, CD_OUT, D), CD_OUT ** -0.5),
        'ret_decay_logit': decay_logit0 + nrm((no, 2, RET_HEADS), 0.05),
        'gqa_g_q': 1.0 + nrm((no, GQA_HEAD_DIM), 0.02),
        'gqa_g_k': 1.0 + nrm((no, GQA_HEAD_DIM), 0.02),
        'ffn_w_up': nrm((DEPTH, D, 2 * F), D ** -0.5),
        'ffn_conv_w': nrm((DEPTH, CONV_W, F), CONV_W ** -0.5),
        'ffn_conv_b': nrm((DEPTH, F), 0.02),
        'ffn_w_down': nrm((DEPTH, F, D), F ** -0.5),
        'g_final': 1.0 + nrm((D,), 0.02),
    }


def reference(x, c, ctx, c_ctx, w_mod, b_mod, w_in_ab, w_out_ab, s5_lam_re, s5_lam_im, s5_log_step,
              s5_b_re, s5_b_im, s5_c_re, s5_c_im, s5_d, s5_w_glu, s5_b_glu, mla_g_q, mla_w_uq,
              mla_g_kv, mla_w_ukv, w_in_cd, w_out_cd, ret_decay_logit, gqa_g_q, gqa_g_k,
              ffn_w_up, ffn_conv_w, ffn_conv_b, ffn_w_down, g_final):
    n = x.shape[1]
    ROWS = n // GRID_W
    rows = jnp.repeat(jnp.arange(ROWS, dtype=jnp.int32), GRID_W)
    cols = jnp.arange(n, dtype=jnp.int32) % GRID_W
    rope64 = rope_tables(rows, cols, MLA_ROPE)
    rope128 = rope_tables(rows, cols, RET_DK)

    cond_x = jax.nn.silu(c)
    cond_c = jax.nn.silu(c_ctx)
    hx, hc = x, ctx
    for layer in range(DEPTH):
        last = layer == DEPTH - 1
        i = layer // 2
        mx = [m[:, None, :] for m in jnp.split(cond_x @ w_mod[layer] + b_mod[layer], 6, axis=-1)]
        mc = jnp.split(cond_c @ w_mod[layer] + b_mod[layer], 6, axis=-1)
        xn = modulate(rmsnorm(hx), mx[0], mx[1])
        cn = modulate(rmsnorm(hc), mc[0], mc[1])
        if layer % 2 == 0:
            yc, yx = mixer_ab(cn, xn, rope64, w_in_ab[i], w_out_ab[i], s5_lam_re[i], s5_lam_im[i],
                              s5_log_step[i], s5_b_re[i], s5_b_im[i], s5_c_re[i], s5_c_im[i], s5_d[i],
                              s5_w_glu[i], s5_b_glu[i], mla_g_q[i], mla_w_uq[i], mla_g_kv[i],
                              mla_w_ukv[i], not last)
        else:
            yc, yx = mixer_cd(cn, xn, rope128, w_in_cd[i], w_out_cd[i], ret_decay_logit[i],
                              gqa_g_q[i], gqa_g_k[i], not last)
        hx = hx + mx[2] * yx
        xn = modulate(rmsnorm(hx), mx[3], mx[4])
        hx = hx + mx[5] * conv_ffn(xn, ffn_w_up[layer], ffn_conv_w[layer], ffn_conv_b[layer], ffn_w_down[layer])
        if not last:
            hc = hc + mc[2] * yc
            cn = modulate(rmsnorm(hc), mc[3], mc[4])
            hc = hc + mc[5] * conv_ffn(cn, ffn_w_up[layer], ffn_conv_w[layer], ffn_conv_b[layer], ffn_w_down[layer])
    return rmsnorm(hx) * g_final
```

```cpp
#include <hip/hip_runtime.h>
#include <cstdio>
#include <cstdint>

typedef float f32x16 __attribute__((ext_vector_type(16)));
typedef float f32x4 __attribute__((ext_vector_type(4)));

#define DM 1024
#define NB 16
#define SEQ 2048
#define CTX 256
#define ROWS 2304
#define FF 2816
#define EPSN 1e-6f

template <bool BT>
__global__ __launch_bounds__(256) void gemm_f32(const float* __restrict__ A, int lda, long sa, const float* __restrict__ B, int ldb, long sb,
                                                float* __restrict__ C, int ldc, long sc, int K) {
  __shared__ float sA[64][17];
  __shared__ float sB[16][65];
  const int tid = threadIdx.x, lane = tid & 63, w = tid >> 6, wr = w >> 1, wc = w & 1;
  const int m0 = blockIdx.y * 64, n0 = blockIdx.x * 64;
  A += (long)blockIdx.z * sa; B += (long)blockIdx.z * sb; C += (long)blockIdx.z * sc;
  f32x16 acc = {};
  for (int k0 = 0; k0 < K; k0 += 16) {
    { const int r = tid >> 2, k4 = (tid & 3) * 4; const f32x4 v = *(const f32x4*)(A + (long)(m0 + r) * lda + k0 + k4);
      sA[r][k4] = v[0]; sA[r][k4 + 1] = v[1]; sA[r][k4 + 2] = v[2]; sA[r][k4 + 3] = v[3]; }
    if (!BT) { const int k = tid >> 4, n4 = (tid & 15) * 4; const f32x4 v = *(const f32x4*)(B + (long)(k0 + k) * ldb + n0 + n4);
      sB[k][n4] = v[0]; sB[k][n4 + 1] = v[1]; sB[k][n4 + 2] = v[2]; sB[k][n4 + 3] = v[3]; }
    else { const int n = tid >> 2, k4 = (tid & 3) * 4; const f32x4 v = *(const f32x4*)(B + (long)(n0 + n) * ldb + k0 + k4);
      sB[k4][n] = v[0]; sB[k4 + 1][n] = v[1]; sB[k4 + 2][n] = v[2]; sB[k4 + 3][n] = v[3]; }
    __syncthreads();
#pragma unroll
    for (int kk = 0; kk < 16; kk += 2) {
      const float a = sA[32 * wr + (lane & 31)][kk + (lane >> 5)];
      const float b = sB[kk + (lane >> 5)][32 * wc + (lane & 31)];
      acc = __builtin_amdgcn_mfma_f32_32x32x2f32(a, b, acc, 0, 0, 0);
    }
    __syncthreads();
  }
#pragma unroll
  for (int r = 0; r < 16; ++r) { const int row = (r & 3) + 8 * (r >> 2) + 4 * (lane >> 5);
    C[(long)(m0 + 32 * wr + row) * ldc + n0 + 32 * wc + (lane & 31)] = acc[r]; }
}

__device__ __forceinline__ float wave_sum(float v) {
#pragma unroll
  for (int o = 1; o < 64; o <<= 1) v += __shfl_xor(v, o);
  return v;
}
__device__ __forceinline__ float silu_f(float x) { return x / (1.f + expf(-x)); }
__device__ __forceinline__ float sigm_f(float x) { return 1.f / (1.f + expf(-x)); }
__device__ __forceinline__ float gelu_f(float x) { return 0.5f * x * (1.f + tanhf(0.7978845608028654f * (x + 0.044715f * x * x * x))); }

__global__ void mod_kernel(const float* c, const float* c_ctx, const float* w_mod, const float* b_mod, float* mods) {
  const int n = blockIdx.x * 256 + threadIdx.x, r = blockIdx.y, l = blockIdx.z;
  const float* cond = r < 16 ? c + r * DM : c_ctx; const float* W = w_mod + (long)l * DM * 6144;
  float acc = b_mod[l * 6144 + n];
  for (int k = 0; k < DM; ++k) acc += silu_f(cond[k]) * W[(long)k * 6144 + n];
  mods[((long)l * 17 + r) * 6144 + n] = acc;
}
__global__ void rope_kernel(float* cs, float* sn, int half) {
  const int t = blockIdx.x, i = threadIdx.x, q = half / 2, ii = i % q;
  const float inv = powf(10000.f, -(float)ii / (float)q);
  const float pos = (i < q) ? (float)(t / 64) : (float)(t % 64);
  const float ang = pos * inv; cs[t * half + i] = cosf(ang); sn[t * half + i] = sinf(ang);
}
__global__ void s5_disc_kernel(const float* lam_re, const float* lam_im, const float* log_step, const float* b_re, const float* b_im,
                               float* lbr, float* lbi, float* bbr, float* bbi) {
  const int dg = blockIdx.x, p = threadIdx.x; const int idx = dg * 64 + p;
  const float lr = lam_re[idx], li = lam_im[idx], dt = expf(log_step[dg]);
  const float ar = lr * dt, ai = li * dt, mag = expf(ar), er = mag * cosf(ai), ei = mag * sinf(ai);
  const float den = lr * lr + li * li;
  const float cr = ((er - 1.f) * lr + ei * li) / den, ci = (ei * lr - (er - 1.f) * li) / den;
  lbr[idx] = er; lbi[idx] = ei;
  for (int h = 0; h < 16; ++h) { const float br = b_re[(long)idx * 16 + h], bi = b_im[(long)idx * 16 + h];
    bbr[(long)idx * 16 + h] = cr * br - ci * bi; bbi[(long)idx * 16 + h] = cr * bi + ci * br; }
}
__global__ void norm_mod_kernel(const float* H, const float* mods_l, int b, int which, float* XN) {
  const int r = blockIdx.x * 4 + (threadIdx.x >> 6), lane = threadIdx.x & 63;
  const float* m = mods_l + (long)(r < CTX ? 16 : b) * 6144 + which * 3 * DM;
  const float* x = H + (long)r * DM; float v[16]; float ss = 0.f;
#pragma unroll
  for (int j = 0; j < 16; ++j) { v[j] = x[lane + 64 * j]; ss += v[j] * v[j]; }
  const float rs = rsqrtf(wave_sum(ss) * (1.f / DM) + EPSN);
#pragma unroll
  for (int j = 0; j < 16; ++j) { const int k = lane + 64 * j; XN[(long)r * DM + k] = v[j] * rs * (1.f + m[DM + k]) + m[k]; }
}
__global__ void resid_kernel(float* H, const float* Y, const float* mods_l, int b, int which, int r0, int nrows) {
  const long i = (long)blockIdx.x * 256 + threadIdx.x; if (i >= (long)nrows * DM) return;
  const int r = (int)(i / DM) + r0, k = (int)(i % DM);
  const float* m = mods_l + (long)(r < CTX ? 16 : b) * 6144 + (which * 3 + 2) * DM;
  H[(long)r * DM + k] += m[k] * Y[i];
}
__global__ void s5_scan_kernel(const float* Z, int ldz, const float* lbr, const float* lbi, const float* bbr, const float* bbi,
                               const float* c_re, const float* c_im, const float* dskip, float* Yd) {
  const int d = blockIdx.x >> 5, g = blockIdx.x & 31, p = threadIdx.x; const int idx = (d * 32 + g) * 64 + p;
  const float ar = lbr[idx], ai = lbi[idx];
  float br[16], bi[16], cr[16], ci[16];
#pragma unroll
  for (int h = 0; h < 16; ++h) { br[h] = bbr[(long)idx * 16 + h]; bi[h] = bbi[(long)idx * 16 + h];
    cr[h] = c_re[((long)(d * 32 + g) * 16 + h) * 64 + p]; ci[h] = c_im[((long)(d * 32 + g) * 16 + h) * 64 + p]; }
  float sr = 0.f, si = 0.f; float* Y = Yd + (long)d * ROWS * 512;
  for (int step = 0; step < ROWS; ++step) {
    int row;
    if (step < CTX) row = d ? (CTX - 1 - step) : step; else { const int t = step - CTX; row = CTX + (d ? (SEQ - 1 - t) : t); }
    const float* u = Z + (long)row * ldz + g * 16;
    float ur = 0.f, ui = 0.f, uv[16];
#pragma unroll
    for (int h = 0; h < 16; ++h) { uv[h] = u[h]; ur += br[h] * uv[h]; ui += bi[h] * uv[h]; }
    const float nr = ar * sr - ai * si + ur, ni = ar * si + ai * sr + ui; sr = nr; si = ni;
#pragma unroll
    for (int h = 0; h < 16; ++h) { float v = wave_sum(cr[h] * sr - ci[h] * si);
      if (p == h) Y[(long)row * 512 + g * 16 + h] = v + (d == 0 ? dskip[g * 16 + h] * uv[h] : 0.f); }
  }
}
__global__ void glu_prep_kernel(const float* Yd, float* G) { const long i = (long)blockIdx.x * 256 + threadIdx.x; G[i] = gelu_f(Yd[i] + Yd[i + (long)ROWS * 512]); }
__global__ void glu_fin_kernel(const float* G, const float* GL, const float* b_glu, float* CAT) {
  const long i = (long)blockIdx.x * 256 + threadIdx.x; const int r = (int)(i >> 9), c = (int)(i & 511);
  CAT[(long)r * DM + c] = G[i] * sigm_f(GL[i] + b_glu[c]);
}
__global__ void rms_scale_kernel(const float* in, int ld, int col0, int width, const float* g, float* out) {
  const int r = blockIdx.x * 4 + (threadIdx.x >> 6), lane = threadIdx.x & 63; const float* x = in + (long)r * ld + col0;
  float ss = 0.f; for (int j = lane; j < width; j += 64) ss += x[j] * x[j];
  const float rs = rsqrtf(wave_sum(ss) / (float)width + EPSN);
  for (int j = lane; j < width; j += 64) out[(long)r * width + j] = x[j] * rs * g[j];
}
__device__ __forceinline__ float rope_elem(const float* x, int d, int quarter, const float* cs, const float* sn) {
  const int qd = d / quarter, i = d % quarter; const int ti = (qd < 2 ? 0 : quarter) + i;
  const float c = cs[ti], s = sn[ti];
  return (qd & 1) ? x[d] * c + x[d - quarter] * s : x[d] * c - x[d + quarter] * s;
}
__global__ void mla_assemble_kernel(const float* QF, const float* KVF, const float* Z, int ldz, const float* cs64, const float* sn64, float* Q, float* K, float* V) {
  const int r = blockIdx.x, h = blockIdx.y, d = threadIdx.x; const bool lat = r >= CTX; const int t = r - CTX;
  const float* q = QF + (long)r * 768 + h * 192; const float* kv = KVF + (long)r * 1024 + h * 256; const float* kr = Z + (long)r * ldz + 1152;
  float qo, ko;
  if (d < 128) { qo = q[d]; ko = kv[d]; V[((long)h * ROWS + r) * 128 + d] = kv[128 + d]; }
  else { const int dd = d - 128;
    if (lat) { qo = rope_elem(q + 128, dd, 16, cs64 + t * 32, sn64 + t * 32); ko = rope_elem(kr, dd, 16, cs64 + t * 32, sn64 + t * 32); }
    else { qo = q[d]; ko = kr[dd]; } }
  Q[((long)h * ROWS + r) * 192 + d] = qo; K[((long)h * ROWS + r) * 192 + d] = ko;
}
__global__ void softmax_kernel(float* S, int cols, float scale) {
  const long r = (long)blockIdx.x * 4 + (threadIdx.x >> 6); const int lane = threadIdx.x & 63; float* s = S + r * cols;
  float mx = -1e30f; for (int j = lane; j < cols; j += 64) mx = fmaxf(mx, s[j] * scale);
#pragma unroll
  for (int o = 1; o < 64; o <<= 1) mx = fmaxf(mx, __shfl_xor(mx, o));
  float sum = 0.f; for (int j = lane; j < cols; j += 64) { const float e = expf(s[j] * scale - mx); s[j] = e; sum += e; }
  sum = wave_sum(sum); const float inv = 1.f / sum;
  for (int j = lane; j < cols; j += 64) s[j] *= inv;
}
__global__ void conv_gate_kernel(const float* UP, const float* cw, const float* cb, float* HH) {
  const long i = (long)blockIdx.x * 256 + threadIdx.x; const int r = (int)(i / FF), j = (int)(i % FF);
  const bool hasp = !(r == 0 || r == CTX), hasn = !(r == CTX - 1 || r == ROWS - 1);
  float cv = cb[j] + cw[FF + j] * UP[(long)r * 2 * FF + j];
  if (hasp) cv += cw[j] * UP[(long)(r - 1) * 2 * FF + j];
  if (hasn) cv += cw[2 * FF + j] * UP[(long)(r + 1) * 2 * FF + j];
  HH[i] = gelu_f(cv) * UP[(long)r * 2 * FF + FF + j];
}
__global__ void cd_prep_kernel(const float* Z, const float* cs128, const float* sn128, const float* gq_g, const float* gk_g,
                               float* RQ, float* RK, float* RV, float* GQ, float* GK, float* GV) {
  const int r = blockIdx.x, s = blockIdx.y, lane = threadIdx.x; const bool lat = r >= CTX; const int t = r - CTX;
  const float* z = Z + (long)r * 3072 + s * 128; float v0 = z[lane], v1 = z[lane + 64];
  int kind, h; if (s < 4) { kind = 0; h = s; } else if (s < 8) { kind = 1; h = s - 4; } else if (s < 12) { kind = 2; h = s - 8; } else if (s < 16) return;
  else if (s < 20) { kind = 3; h = s - 16; } else if (s < 22) { kind = 4; h = s - 20; } else { kind = 5; h = s - 22; }
  if (kind == 3 || kind == 4) { const float rs = rsqrtf(wave_sum(v0 * v0 + v1 * v1) * (1.f / 128.f) + EPSN); const float* g = kind == 3 ? gq_g : gk_g;
    v0 = v0 * rs * g[lane]; v1 = v1 * rs * g[lane + 64]; }
  if (kind == 1) { v0 *= 0.08838834764831845f; v1 *= 0.08838834764831845f; }
  if (lat && (kind == 0 || kind == 1 || kind == 3 || kind == 4)) {
    const float p0 = __shfl_xor(v0, 32), p1 = __shfl_xor(v1, 32); const int i = lane & 31;
    const float c0 = cs128[t * 64 + i], s0 = sn128[t * 64 + i], c1 = cs128[t * 64 + 32 + i], s1 = sn128[t * 64 + 32 + i];
    v0 = (lane < 32) ? v0 * c0 - p0 * s0 : v0 * c0 + p0 * s0;
    v1 = (lane < 32) ? v1 * c1 - p1 * s1 : v1 * c1 + p1 * s1;
  }
  float* o;
  if (kind == 0) { if (!lat) return; o = RQ + ((long)h * SEQ + t) * 128; }
  else if (kind == 1) o = RK + ((long)h * ROWS + r) * 128;
  else if (kind == 2) o = RV + ((long)h * ROWS + r) * 128;
  else if (kind == 3) { if (!lat) return; o = GQ + ((long)h * SEQ + t) * 128; }
  else if (kind == 4) o = GK + ((long)h * ROWS + r) * 128;
  else o = GV + ((long)h * ROWS + r) * 128;
  o[lane] = v0; o[lane + 64] = v1;
}
__global__ void ret_state_kernel(const float* RK, const float* RV, const float* decay_logit, float* SF, float* SB) {
  const int i = blockIdx.x * 256 + threadIdx.x, h = i >> 14, k = (i >> 7) & 127, v = i & 127;
  const float lf = -log1pf(expf(-decay_logit[h])), lb = -log1pf(expf(-decay_logit[4 + h]));
  float af = 0.f, ab = 0.f;
  for (int m = 0; m < CTX; ++m) { const float kv = RK[((long)h * ROWS + m) * 128 + k] * RV[((long)h * ROWS + m) * 128 + v];
    af += expf((255.f - m) * lf) * kv; ab += expf((float)m * lb) * kv; }
  SF[i] = af; SB[i] = ab;
}
__global__ void decay_mask_kernel(float* S, const float* decay_logit) {
  const long i = (long)blockIdx.x * 256 + threadIdx.x; const int h = (int)(i >> 22), n = (int)((i >> 11) & 2047), j = (int)(i & 2047);
  const float lf = -log1pf(expf(-decay_logit[h])), lb = -log1pf(expf(-decay_logit[4 + h]));
  float dd = 0.f; if (j <= n) dd += expf((float)(n - j) * lf); if (j >= n) dd += expf((float)(j - n) * lb);
  S[i] *= dd;
}
__global__ void ret_out_kernel(const float* O1, const float* O2, const float* O3, const float* Z, const float* decay_logit, float* CAT) {
  const int n = blockIdx.x, h = blockIdx.y, lane = threadIdx.x;
  const float lf = -log1pf(expf(-decay_logit[h])), lb = -log1pf(expf(-decay_logit[4 + h]));
  const float wf = expf((float)(n + 1) * lf), wb = expf((float)(SEQ - n) * lb); const long base = ((long)h * SEQ + n) * 128;
  float o0 = O1[base + lane] + wf * O2[base + lane] + wb * O3[base + lane], o1 = O1[base + lane + 64] + wf * O2[base + lane + 64] + wb * O3[base + lane + 64];
  const float rs = rsqrtf(wave_sum(o0 * o0 + o1 * o1) * (1.f / 128.f) + EPSN);
  const float* rg = Z + (long)(CTX + n) * 3072 + 1536 + h * 128;
  CAT[(long)(CTX + n) * DM + h * 128 + lane] = o0 * rs * silu_f(rg[lane]); CAT[(long)(CTX + n) * DM + h * 128 + lane + 64] = o1 * rs * silu_f(rg[lane + 64]);
}
__global__ void final_kernel(const float* H, const float* gf, float* out) {
  const int n = blockIdx.x * 4 + (threadIdx.x >> 6), lane = threadIdx.x & 63; const float* x = H + (long)(CTX + n) * DM;
  float v[16]; float ss = 0.f;
#pragma unroll
  for (int j = 0; j < 16; ++j) { v[j] = x[lane + 64 * j]; ss += v[j] * v[j]; }
  const float rs = rsqrtf(wave_sum(ss) * (1.f / DM) + EPSN);
#pragma unroll
  for (int j = 0; j < 16; ++j) out[(long)n * DM + lane + 64 * j] = v[j] * rs * gf[lane + 64 * j];
}

static hipStream_t g_st;
static void gemm(bool bt, const float* A, int lda, long sa, const float* B, int ldb, long sb, float* C, int ldc, long sc, int M, int N, int K, int Zb) {
  dim3 g(N / 64, M / 64, Zb);
  if (bt) hipLaunchKernelGGL(gemm_f32<true>, g, dim3(256), 0, g_st, A, lda, sa, B, ldb, sb, C, ldc, sc, K);
  else hipLaunchKernelGGL(gemm_f32<false>, g, dim3(256), 0, g_st, A, lda, sa, B, ldb, sb, C, ldc, sc, K);
}

extern "C" void kernel_launch(void* const* d_in, const int* in_sizes, int n_in, void* d_out, int out_size, void* d_ws, size_t ws_size, hipStream_t stream) {
  g_st = stream;
  const float* x = (const float*)d_in[0]; const float* c = (const float*)d_in[1]; const float* ctx = (const float*)d_in[2]; const float* c_ctx = (const float*)d_in[3];
  const float* w_mod = (const float*)d_in[4]; const float* b_mod = (const float*)d_in[5]; const float* w_in_ab = (const float*)d_in[6]; const float* w_out_ab = (const float*)d_in[7];
  const float* lam_re = (const float*)d_in[8]; const float* lam_im = (const float*)d_in[9]; const float* log_step = (const float*)d_in[10];
  const float* sb_re = (const float*)d_in[11]; const float* sb_im = (const float*)d_in[12]; const float* sc_re = (const float*)d_in[13]; const float* sc_im = (const float*)d_in[14];
  const float* s5_d = (const float*)d_in[15]; const float* w_glu = (const float*)d_in[16]; const float* b_glu = (const float*)d_in[17];
  const float* g_q = (const float*)d_in[18]; const float* w_uq = (const float*)d_in[19]; const float* g_kv = (const float*)d_in[20]; const float* w_ukv = (const float*)d_in[21];
  const float* w_in_cd = (const float*)d_in[22]; const float* w_out_cd = (const float*)d_in[23]; const float* decay_logit = (const float*)d_in[24];
  const float* gqa_gq = (const float*)d_in[25]; const float* gqa_gk = (const float*)d_in[26];
  const float* w_up = (const float*)d_in[27]; const float* conv_w = (const float*)d_in[28]; const float* conv_b = (const float*)d_in[29]; const float* w_down = (const float*)d_in[30];
  const float* g_final = (const float*)d_in[31]; float* out = (float*)d_out;

  float* ws = (float*)d_ws; size_t off = 0;
  auto alloc = [&](size_t n) { float* p = ws + off; off += (n + 63) / 64 * 64; return p; };
  float* MODS = alloc(2 * 17 * 6144);
  float* C64 = alloc(2048 * 32); float* S64 = alloc(2048 * 32); float* C128 = alloc(2048 * 64); float* S128 = alloc(2048 * 64);
  float* LBR = alloc(4096); float* LBI = alloc(4096); float* BBR = alloc(65536); float* BBI = alloc(65536);
  float* H = alloc((size_t)ROWS * DM); float* XN = alloc((size_t)ROWS * DM); float* Z = alloc((size_t)ROWS * 3072);
  float* YD = alloc((size_t)2 * ROWS * 512); float* G = alloc((size_t)ROWS * 512); float* GL = alloc((size_t)ROWS * 512);
  float* CQN = alloc((size_t)ROWS * 384); float* CKVN = alloc((size_t)ROWS * 256); float* QF = alloc((size_t)ROWS * 768); float* KVF = alloc((size_t)ROWS * 1024);
  float* Q = alloc((size_t)4 * ROWS * 192); float* K = alloc((size_t)4 * ROWS * 192); float* V = alloc((size_t)4 * ROWS * 128);
  float* S = alloc((size_t)4 * SEQ * ROWS); float* CAT = alloc((size_t)ROWS * DM); float* YO = alloc((size_t)ROWS * DM);
  float* UP = alloc((size_t)ROWS * 2 * FF); float* HH = alloc((size_t)ROWS * FF);
  float* RQ = alloc((size_t)4 * SEQ * 128); float* RK = alloc((size_t)4 * ROWS * 128); float* RV = alloc((size_t)4 * ROWS * 128);
  float* GQ = alloc((size_t)4 * SEQ * 128); float* GK = alloc((size_t)2 * ROWS * 128); float* GV = alloc((size_t)2 * ROWS * 128);
  float* SF = alloc(65536); float* SB = alloc(65536); float* O1 = alloc((size_t)4 * SEQ * 128); float* O2 = alloc((size_t)4 * SEQ * 128); float* O3 = alloc((size_t)4 * SEQ * 128);
  if (off * 4 > ws_size) { fprintf(stderr, "kernel_launch: workspace too small: need %zu have %zu\n", off * 4, ws_size); return; }

  hipLaunchKernelGGL(mod_kernel, dim3(24, 17, 2), dim3(256), 0, stream, c, c_ctx, w_mod, b_mod, MODS);
  hipLaunchKernelGGL(rope_kernel, dim3(2048), dim3(32), 0, stream, C64, S64, 32);
  hipLaunchKernelGGL(rope_kernel, dim3(2048), dim3(64), 0, stream, C128, S128, 64);
  hipLaunchKernelGGL(s5_disc_kernel, dim3(64), dim3(64), 0, stream, lam_re, lam_im, log_step, sb_re, sb_im, LBR, LBI, BBR, BBI);

  for (int b = 0; b < NB; ++b) {
    hipMemcpyAsync(H, ctx + (size_t)b * CTX * DM, (size_t)CTX * DM * 4, hipMemcpyDeviceToDevice, stream);
    hipMemcpyAsync(H + (size_t)CTX * DM, x + (size_t)b * SEQ * DM, (size_t)SEQ * DM * 4, hipMemcpyDeviceToDevice, stream);
    for (int l = 0; l < 2; ++l) {
      const float* ml = MODS + (size_t)l * 17 * 6144;
      hipLaunchKernelGGL(norm_mod_kernel, dim3(ROWS / 4), dim3(256), 0, stream, H, ml, b, 0, XN);
      if (l == 0) {
        gemm(false, XN, DM, 0, w_in_ab, 1216, 0, Z, 1216, 0, ROWS, 1216, DM, 1);
        hipLaunchKernelGGL(s5_scan_kernel, dim3(64), dim3(64), 0, stream, Z, 1216, LBR, LBI, BBR, BBI, sc_re, sc_im, s5_d, YD);
        hipLaunchKernelGGL(glu_prep_kernel, dim3(ROWS * 512 / 256), dim3(256), 0, stream, YD, G);
        gemm(false, G, 512, 0, w_glu, 512, 0, GL, 512, 0, ROWS, 512, 512, 1);
        hipLaunchKernelGGL(glu_fin_kernel, dim3(ROWS * 512 / 256), dim3(256), 0, stream, G, GL, b_glu, CAT);
        hipLaunchKernelGGL(rms_scale_kernel, dim3(ROWS / 4), dim3(256), 0, stream, Z, 1216, 512, 384, g_q, CQN);
        hipLaunchKernelGGL(rms_scale_kernel, dim3(ROWS / 4), dim3(256), 0, stream, Z, 1216, 896, 256, g_kv, CKVN);
        gemm(false, CQN, 384, 0, w_uq, 768, 0, QF, 768, 0, ROWS, 768, 384, 1);
        gemm(false, CKVN, 256, 0, w_ukv, 1024, 0, KVF, 1024, 0, ROWS, 1024, 256, 1);
        hipLaunchKernelGGL(mla_assemble_kernel, dim3(ROWS, 4), dim3(192), 0, stream, QF, KVF, Z, 1216, C64, S64, Q, K, V);
        gemm(true, Q + (size_t)CTX * 192, 192, (long)ROWS * 192, K, 192, (long)ROWS * 192, S, ROWS, (long)SEQ * ROWS, SEQ, ROWS, 192, 4);
        hipLaunchKernelGGL(softmax_kernel, dim3(4 * SEQ / 4), dim3(256), 0, stream, S, ROWS, 0.07216878364870323f);
        gemm(false, S, ROWS, (long)SEQ * ROWS, V, 128, (long)ROWS * 128, CAT + (size_t)CTX * DM + 512, DM, 128, SEQ, 128, ROWS, 4);
        gemm(true, Q, 192, (long)ROWS * 192, K, 192, (long)ROWS * 192, S, CTX, (long)CTX * CTX, CTX, CTX, 192, 4);
        hipLaunchKernelGGL(softmax_kernel, dim3(4 * CTX / 4), dim3(256), 0, stream, S, CTX, 0.07216878364870323f);
        gemm(false, S, CTX, (long)CTX * CTX, V, 128, (long)ROWS * 128, CAT + 512, DM, 128, CTX, 128, CTX, 4);
        gemm(false, CAT, DM, 0, w_out_ab, DM, 0, YO, DM, 0, ROWS, DM, DM, 1);
        hipLaunchKernelGGL(resid_kernel, dim3(ROWS * DM / 256), dim3(256), 0, stream, H, YO, ml, b, 0, 0, ROWS);
      } else {
        gemm(false, XN, DM, 0, w_in_cd, 3072, 0, Z, 3072, 0, ROWS, 3072, DM, 1);
        hipLaunchKernelGGL(cd_prep_kernel, dim3(ROWS, 24), dim3(64), 0, stream, Z, C128, S128, gqa_gq, gqa_gk, RQ, RK, RV, GQ, GK, GV);
        hipLaunchKernelGGL(ret_state_kernel, dim3(256), dim3(256), 0, stream, RK, RV, decay_logit, SF, SB);
        gemm(true, RQ, 128, (long)SEQ * 128, RK + (size_t)CTX * 128, 128, (long)ROWS * 128, S, SEQ, (long)SEQ * SEQ, SEQ, SEQ, 128, 4);
        hipLaunchKernelGGL(decay_mask_kernel, dim3(4 * SEQ * SEQ / 256), dim3(256), 0, stream, S, decay_logit);
        gemm(false, S, SEQ, (long)SEQ * SEQ, RV + (size_t)CTX * 128, 128, (long)ROWS * 128, O1, 128, (long)SEQ * 128, SEQ, 128, SEQ, 4);
        gemm(false, RQ, 128, (long)SEQ * 128, SF, 128, 16384, O2, 128, (long)SEQ * 128, SEQ, 128, 128, 4);
        gemm(false, RQ, 128, (long)SEQ * 128, SB, 128, 16384, O3, 128, (long)SEQ * 128, SEQ, 128, 128, 4);
        hipLaunchKernelGGL(ret_out_kernel, dim3(SEQ, 4), dim3(64), 0, stream, O1, O2, O3, Z, decay_logit, CAT);
        for (int g = 0; g < 2; ++g) {
          gemm(true, GQ + (size_t)2 * g * SEQ * 128, 128, (long)SEQ * 128, GK + (size_t)g * ROWS * 128, 128, 0, S, ROWS, (long)SEQ * ROWS, SEQ, ROWS, 128, 2);
          hipLaunchKernelGGL(softmax_kernel, dim3(2 * SEQ / 4), dim3(256), 0, stream, S, ROWS, 0.08838834764831845f);
          gemm(false, S, ROWS, (long)SEQ * ROWS, GV + (size_t)g * ROWS * 128, 128, 0, CAT + (size_t)CTX * DM + 512 + 256 * g, DM, 128, SEQ, 128, ROWS, 2);
        }
        gemm(false, CAT + (size_t)CTX * DM, DM, 0, w_out_cd, DM, 0, YO, DM, 0, SEQ, DM, DM, 1);
        hipLaunchKernelGGL(resid_kernel, dim3(SEQ * DM / 256), dim3(256), 0, stream, H, YO, ml, b, 0, CTX, SEQ);
      }
      hipLaunchKernelGGL(norm_mod_kernel, dim3(ROWS / 4), dim3(256), 0, stream, H, ml, b, 1, XN);
      gemm(false, XN, DM, 0, w_up + (size_t)l * DM * 2 * FF, 2 * FF, 0, UP, 2 * FF, 0, ROWS, 2 * FF, DM, 1);
      hipLaunchKernelGGL(conv_gate_kernel, dim3(ROWS * FF / 256), dim3(256), 0, stream, UP, conv_w + (size_t)l * 3 * FF, conv_b + (size_t)l * FF, HH);
      gemm(false, HH, FF, 0, w_down + (size_t)l * FF * DM, DM, 0, YO, DM, 0, ROWS, DM, FF, 1);
      hipLaunchKernelGGL(resid_kernel, dim3(ROWS * DM / 256), dim3(256), 0, stream, H, YO, ml, b, 1, 0, ROWS);
    }
    hipLaunchKernelGGL(final_kernel, dim3(SEQ / 4), dim3(256), 0, stream, H, g_final, out + (size_t)b * SEQ * DM);
  }
}
```

```cpp
#include <hip/hip_runtime.h>
#include <cstdio>
#include <cstdint>

#define LAS __attribute__((address_space(3)))
#define GAS __attribute__((address_space(1)))
typedef unsigned short bf16_t;
typedef short bf16x8 __attribute__((ext_vector_type(8)));
typedef short s16x4 __attribute__((ext_vector_type(4)));
typedef float f32x2 __attribute__((ext_vector_type(2)));
typedef float f32x4 __attribute__((ext_vector_type(4)));
typedef float f32x16 __attribute__((ext_vector_type(16)));
typedef unsigned u32x2 __attribute__((ext_vector_type(2)));
typedef unsigned u32x4 __attribute__((ext_vector_type(4)));
typedef __bf16 bf16x2_t __attribute__((ext_vector_type(2)));

constexpr int TT = 36864;
constexpr int DMODEL = 1024, RB = 2304, NCTX = 256, NLAT = 2048, FFH = 2816, NBLK128 = TT / 128;
constexpr float EPS_N = 1e-6f, LOG2E = 1.4426950408889634f;

__device__ __forceinline__ unsigned pk2(float lo, float hi) { f32x2 v = {lo, hi}; bf16x2_t b = __builtin_convertvector(v, bf16x2_t); return __builtin_bit_cast(unsigned, b); }
__device__ __forceinline__ float bflo(unsigned u) { return __uint_as_float(u << 16); }
__device__ __forceinline__ float bfhi(unsigned u) { return __uint_as_float(u & 0xffff0000u); }
__device__ __forceinline__ float bf1(bf16_t h) { return __uint_as_float(((unsigned)h) << 16); }
__device__ __forceinline__ bf16_t f2bf(float f) { return (bf16_t)(pk2(f, 0.f) & 0xffffu); }
__device__ __forceinline__ void store8(bf16_t* p, const f32x4& a, const f32x4& b) { u32x4 w; w.x = pk2(a[0], a[1]); w.y = pk2(a[2], a[3]); w.z = pk2(b[0], b[1]); w.w = pk2(b[2], b[3]); *(u32x4*)p = w; }
__device__ __forceinline__ float fast_sigmoid(float x) { return __builtin_amdgcn_rcpf(1.f + __builtin_amdgcn_exp2f(-LOG2E * x)); }
__device__ __forceinline__ float gelu_t(float x) { const float u = x + 0.044715f * x * x * x; return x * __builtin_amdgcn_rcpf(1.f + __builtin_amdgcn_exp2f(-2.302208198f * u)); }
__device__ __forceinline__ float silu_t(float x) { return x * fast_sigmoid(x); }
__device__ __forceinline__ float wave_sum64(float v) {
#pragma unroll
  for (int o = 1; o < 64; o <<= 1) v += __shfl_xor(v, o);
  return v;
}

constexpr size_t MiB = 1u << 20;
constexpr size_t WS_CTL = 0, CTL_BYTES = 1 * MiB;
constexpr size_t WS_MODS = 1 * MiB;
constexpr size_t WS_R64C = 2 * MiB, WS_R64S = WS_R64C + 2048 * 32 * 4, WS_R128C = WS_R64S + 2048 * 32 * 4, WS_R128S = WS_R128C + 2048 * 64 * 4;
constexpr size_t WS_S5LAM = 3 * MiB + 512 * 1024, WS_S5BB = WS_S5LAM + 2 * 32 * 64 * 2 * 4, WS_S5CC = WS_S5BB + 2 * 32 * 128 * 16 * 2;
constexpr size_t WS_PS = 5 * MiB;
constexpr size_t WS_EDGE = 11 * MiB, EDGE_ARR = (size_t)NBLK128 * 2 * FFH * 4;
constexpr size_t WS_W = 31 * MiB;
constexpr size_t W_INAB = WS_W, W_OUTAB = W_INAB + 1280 * 1024 * 2, W_GLU = W_OUTAB + 1024 * 1024 * 2, W_UQ = W_GLU + 512 * 512 * 2, W_UKV = W_UQ + 768 * 384 * 2,
                 W_INCD = W_UKV + 1024 * 256 * 2, W_OUTCD = W_INCD + 3072 * 1024 * 2, W_UP = W_OUTCD + 1024 * 1024 * 2, W_DN = W_UP + 2 * (size_t)5632 * 1024 * 2, W_END = W_DN + 2 * (size_t)1024 * 2816 * 2;
static_assert(W_END <= 79 * MiB, "weights");
constexpr size_t WS_HC = 79 * MiB;
constexpr size_t WS_XN = 95 * MiB;
constexpr size_t WS_R = 167 * MiB;
constexpr size_t R_U = WS_R, R_CQ = R_U + (size_t)TT * 512 * 2, R_CKV = R_CQ + (size_t)TT * 384 * 2, R_CAT = WS_R;
constexpr size_t R_Q = WS_R + 81 * MiB, R_K = R_Q + (size_t)TT * 768 * 2, R_V = R_K + (size_t)TT * 768 * 2, R_G = R_V + (size_t)TT * 512 * 2, R_END0 = R_G + (size_t)TT * 512 * 2;
constexpr size_t R_HH = WS_R;
constexpr size_t R_CAT1 = WS_R, R_RK = R_CAT1 + (size_t)TT * 1024 * 2, R_RV = R_RK + (size_t)TT * 512 * 2, R_RG = R_RV + (size_t)TT * 512 * 2, R_GK = R_RG + (size_t)TT * 512 * 2, R_GV = R_GK + (size_t)TT * 256 * 2;
constexpr size_t WS_END = WS_R + 261 * MiB;
static_assert(R_CKV + (size_t)TT * 256 * 2 <= R_Q && R_END0 <= WS_END && R_HH + (size_t)TT * FFH * 2 <= WS_END && R_GV + (size_t)TT * 256 * 2 <= WS_END && WS_END <= 512 * MiB, "ws map");

namespace pg8 {
constexpr int BM = 256, BK = 64, HALF = 128, HTB = HALF * BK * 2, STAGE_BYTES = 8 * HTB, NXCD = 8, WGM = 8;
__host__ __device__ __forceinline__ int lds_byte(int r, int c) { const int st = (r >> 4) * 2 + (c >> 5), rr = r & 15, cc = c & 31, ob = rr * 64 + cc * 2; return st * 1024 + (ob ^ (((ob >> 9) & 1) << 5)); }
__host__ __device__ __forceinline__ void stage_rc(int b, int& R, int& C) { const int st = b / 1024, sb = b % 1024, swz = sb ^ (((sb >> 9) & 1) << 5); R = (st >> 1) * 16 + swz / 64; C = (st & 1) * 32 + (swz % 64) / 2; }
__host__ __device__ __forceinline__ int perm32(int rho) { const int n = rho >> 4, i = rho & 15; return 8 * (i >> 2) + 4 * n + (i & 3); }
struct Unit { int pm, pn; };
struct Gemm { const bf16_t* A; const bf16_t* Bt; int K; };
struct StaticOrder {
    int nM, nN, nwg, G, c;
    __host__ __device__ void init(int nM_, int nN_, int G_, int c_) { nM = nM_; nN = nN_; nwg = nM * nN; G = G_; c = c_; }
    __host__ __device__ bool next(int i, Unit& u) const {
        const long L = (long)i * G + c; if (L >= nwg) return false;
        int wgid = (int)L; { const int q = nwg / NXCD, r = nwg % NXCD, xcd = wgid % NXCD, off = wgid / NXCD; wgid = (xcd < r ? xcd * (q + 1) : r * (q + 1) + (xcd - r) * q) + off; }
        const int nig = WGM * nN, gid = wgid / nig, fm = gid * WGM, gsz = (nM - fm) < WGM ? (nM - fm) : WGM;
        u.pm = fm + ((wgid % nig) % gsz); u.pn = (wgid % nig) / gsz; return true;
    }
};
template <class Epi, class Sched, bool APERM>
__device__ __forceinline__ void gemm_phase(LAS unsigned char* lds, const Gemm g, const Sched& S, const Epi& E) {
    const int tid = threadIdx.x, wid = __builtin_amdgcn_readfirstlane(tid >> 6), lane = tid & 63, wr = wid >> 2, wc = wid & 3, fr = lane & 15, fq = lane >> 4;
    const int K = g.K, nt = K / BK;
    unsigned voffA[2], voffB[2];
#pragma unroll
    for (int i = 0; i < 2; ++i) { int R, C; stage_rc(tid * 16 + i * 8192, R, C); const int Rb = (R & ~31) + perm32(R & 31);
        const int Ra = APERM ? (128 * (R >> 6) + 8 * (R & 15) + ((R >> 4) & 3)) : R;
        voffA[i] = (unsigned)(Ra * K + C) * 2u; voffB[i] = (unsigned)(Rb * K + C) * 2u; }
    const size_t kstep = (size_t)(BK * 2);
    const size_t hstepB = (size_t)HALF * K * 2, hstepA = APERM ? (size_t)4 * K * 2 : hstepB;
    const size_t tstep = (size_t)256 * K * 2;
    const unsigned ldsw = (unsigned)wid * 1024u;
    const int aoff = lds_byte(wr * 64 + fr, fq * 8), boff = lds_byte(wc * 32 + fr, fq * 8);
#define PG8_SA(b, h) (((b) * 2 + (h)) * HTB)
#define PG8_SB(b, h) ((4 + (b) * 2 + (h)) * HTB)
#define PG8_STAGE(bufoff, gbase, voff) do { _Pragma("unroll") for (int _i = 0; _i < 2; ++_i) \
        __builtin_amdgcn_global_load_lds((const unsigned*)((const char*)(gbase) + (voff)[_i]), (LAS unsigned*)(lds + (bufoff) + ldsw + _i * 8192), 16, 0, 0); } while (0)
#define PG8_LDA(dst, b, h) do { _Pragma("unroll") for (int m = 0; m < 4; ++m) _Pragma("unroll") for (int k = 0; k < 2; ++k) dst[m][k] = *(const LAS bf16x8*)(lds + PG8_SA(b, h) + aoff + m * 2048 + k * 1024); } while (0)
#define PG8_LDB(dst, b, h) do { _Pragma("unroll") for (int n = 0; n < 2; ++n) _Pragma("unroll") for (int k = 0; k < 2; ++k) dst[n][k] = *(const LAS bf16x8*)(lds + PG8_SB(b, h) + boff + n * 2048 + k * 1024); } while (0)
#define PG8_MMA(ai, bj, At, Bt) do { __builtin_amdgcn_s_setprio(1); _Pragma("unroll") for (int m = 0; m < 4; ++m) _Pragma("unroll") for (int n = 0; n < 2; ++n) _Pragma("unroll") for (int k = 0; k < 2; ++k) \
        acc[ai][bj][m][n] = __builtin_amdgcn_mfma_f32_16x16x32_bf16(Bt[n][k], At[m][k], acc[ai][bj][m][n], 0, 0, 0); __builtin_amdgcn_s_setprio(0); } while (0)
#define PG8_WAIT_V(n) asm volatile("s_waitcnt vmcnt(" #n ")" ::: "memory")
#define PG8_WAIT_L(n) asm volatile("s_waitcnt lgkmcnt(" #n ")" ::: "memory")
#define PG8_BAR __builtin_amdgcn_s_barrier()
#define PG8_SCHED __builtin_amdgcn_sched_barrier(0)
    Unit cur, nxt; int ui = 0;
    if (!S.next(0, cur)) return;
    f32x4 acc[2][2][4][2];
#pragma unroll
    for (int a = 0; a < 2; ++a)
#pragma unroll
        for (int b = 0; b < 2; ++b)
#pragma unroll
            for (int m = 0; m < 4; ++m)
#pragma unroll
                for (int n = 0; n < 2; ++n) acc[a][b][m][n] = (f32x4){0.f, 0.f, 0.f, 0.f};
    bf16x8 At[4][2], B0[2][2], B1[2][2];
    const char* cA = (const char*)g.A + (size_t)cur.pm * tstep; const char* cB = (const char*)g.Bt + (size_t)cur.pn * tstep;
    PG8_STAGE(PG8_SB(0, 0), cB, voffB); PG8_STAGE(PG8_SB(0, 1), cB + hstepB, voffB); PG8_STAGE(PG8_SA(0, 0), cA, voffA); PG8_STAGE(PG8_SA(0, 1), cA + hstepA, voffA);
    if (wr == 1) PG8_BAR;
    PG8_WAIT_V(2); PG8_BAR;
    PG8_STAGE(PG8_SB(1, 0), cB + kstep, voffB); PG8_STAGE(PG8_SA(1, 0), cA + kstep, voffA); PG8_STAGE(PG8_SB(1, 1), cB + hstepB + kstep, voffB);
    PG8_WAIT_V(6); PG8_BAR;
    for (;;) {
        const bool has_next = S.next(ui + 1, nxt);
        const char* nA = has_next ? (const char*)g.A + (size_t)nxt.pm * tstep : cA; const char* nB = has_next ? (const char*)g.Bt + (size_t)nxt.pn * tstep : cB;
        for (int t = 0; t < nt; t += 2) {
            const bool last = (t == nt - 2);
            const char* a1 = cA + (size_t)(t + 1) * kstep;
            const char* a2 = last ? nA : cA + (size_t)(t + 2) * kstep; const char* b2 = last ? nB : cB + (size_t)(t + 2) * kstep;
            const char* a3 = a2 + kstep; const char* b3 = b2 + kstep;
            PG8_LDB(B0, 0, 0); PG8_LDB(B1, 0, 1); PG8_SCHED; PG8_LDA(At, 0, 0); PG8_STAGE(PG8_SA(1, 1), a1 + hstepA, voffA);
            PG8_WAIT_V(8); PG8_WAIT_L(0); PG8_BAR; PG8_MMA(0, 0, At, B0); PG8_MMA(0, 1, At, B1); PG8_BAR; PG8_SCHED;
            PG8_LDA(At, 0, 1); PG8_STAGE(PG8_SB(0, 0), b2, voffB); PG8_STAGE(PG8_SB(0, 1), b2 + hstepB, voffB); PG8_STAGE(PG8_SA(0, 0), a2, voffA);
            PG8_WAIT_V(8); PG8_WAIT_L(0); PG8_BAR; PG8_MMA(1, 0, At, B0); PG8_MMA(1, 1, At, B1); PG8_BAR; PG8_SCHED;
            PG8_LDB(B0, 1, 0); PG8_LDB(B1, 1, 1); PG8_SCHED; PG8_LDA(At, 1, 0); PG8_STAGE(PG8_SA(0, 1), a2 + hstepA, voffA);
            PG8_WAIT_V(8); PG8_WAIT_L(0); PG8_BAR; PG8_MMA(0, 0, At, B0); PG8_MMA(0, 1, At, B1); PG8_BAR; PG8_SCHED;
            PG8_LDA(At, 1, 1); PG8_STAGE(PG8_SB(1, 0), b3, voffB); PG8_STAGE(PG8_SB(1, 1), b3 + hstepB, voffB); PG8_STAGE(PG8_SA(1, 0), a3, voffA);
            PG8_WAIT_V(8); PG8_WAIT_L(0); PG8_BAR; PG8_MMA(1, 0, At, B0); PG8_MMA(1, 1, At, B1); PG8_BAR; PG8_SCHED;
        }
        if (wr == 0) PG8_BAR;
        E(acc, cur, wr, wc, fr, fq);
        if (!has_next) break;
#pragma unroll
        for (int a = 0; a < 2; ++a)
#pragma unroll
            for (int b = 0; b < 2; ++b)
#pragma unroll
                for (int m = 0; m < 4; ++m)
#pragma unroll
                    for (int n = 0; n < 2; ++n) acc[a][b][m][n] = (f32x4){0.f, 0.f, 0.f, 0.f};
        cur = nxt; cA = nA; cB = nB; ++ui;
        if (wr == 1) PG8_BAR;
    }
    PG8_WAIT_V(0);
    PG8_BAR;
#undef PG8_SA
#undef PG8_SB
#undef PG8_STAGE
#undef PG8_LDA
#undef PG8_LDB
#undef PG8_MMA
#undef PG8_WAIT_V
#undef PG8_WAIT_L
#undef PG8_BAR
#undef PG8_SCHED
}
}
struct MArgs { const float* in[32]; float* out; unsigned char* ws; int ph_lo, ph_hi; };

struct SchedFull { pg8::StaticOrder so; __device__ __forceinline__ bool next(int i, pg8::Unit& u) const { return so.next(i, u); } };
struct SchedLat {
    pg8::StaticOrder so;
    __device__ __forceinline__ bool next(int i, pg8::Unit& u) const { if (!so.next(i, u)) return false; u.pm = (u.pm >> 3) * 9 + 1 + (u.pm & 7); return true; }
};
struct SchedInCd {
    pg8::StaticOrder so; int G, c;
    __device__ __forceinline__ bool next(int i, pg8::Unit& u) const {
        const int L = i * G + c;
        if (L < 1536) { so.next(i, u); u.pm = (u.pm >> 3) * 9 + 1 + (u.pm & 7); return true; }
        const int L2 = L - 1536; if (L2 >= 96) return false;
        const int q = L2 % 6; u.pm = (L2 / 6) * 9; u.pn = q < 4 ? 2 + q : 6 + q; return true;
    }
};

enum { EK_INAB = 0, EK_Q, EK_KV, EK_GLU, EK_RES, EK_UP, EK_INCD };
template <bool UPK> struct Epi {
    int kind;
    unsigned char* ws;
    LAS float* scr;
    const float* hin_c; const float* hin_l; float* hout_c; float* hout_l; const float* gate;
    const float* cw; const float* cb;
    const float* bglu;
    const float* gq; const float* gk;

    __device__ __forceinline__ void operator()(const f32x4 (&acc)[2][2][4][2], const pg8::Unit& u, int wr, int wc, int fr, int fq) const {
        const int jt = u.pm % 9, bb = u.pm / 9; const bool lat = jt != 0;
        const int rloc0 = wr * 64 + fr;
        if (!UPK && kind == EK_INAB) {
            bf16_t* U = (bf16_t*)(ws + R_U); bf16_t* CQ = (bf16_t*)(ws + R_CQ); bf16_t* CKV = (bf16_t*)(ws + R_CKV); bf16_t* Kb = (bf16_t*)(ws + R_K);
            float* PS = (float*)(ws + WS_PS); const float* cs = (const float*)(ws + WS_R64C); const float* sn = (const float*)(ws + WS_R64S);
#pragma unroll
            for (int bj = 0; bj < 2; ++bj) {
                const int cbase = u.pn * 256 + bj * 128 + wc * 32;
                if (cbase >= 1216) continue;
                const int c0 = cbase + 8 * fq;
#pragma unroll
                for (int ai = 0; ai < 2; ++ai)
#pragma unroll
                    for (int m = 0; m < 4; ++m) {
                        const int rl = ai * 128 + m * 16 + rloc0; const size_t row = (size_t)u.pm * 256 + rl;
                        f32x4 v0 = acc[ai][bj][m][0], v1 = acc[ai][bj][m][1];
                        if (cbase < 512) store8(U + row * 512 + c0, v0, v1);
                        else if (cbase < 1152) {
                            float s = (v0[0] * v0[0] + v0[1] * v0[1]) + (v0[2] * v0[2] + v0[3] * v0[3]) + (v1[0] * v1[0] + v1[1] * v1[1]) + (v1[2] * v1[2] + v1[3] * v1[3]);
                            s += __shfl_xor(s, 16); s += __shfl_xor(s, 32);
                            if (fq == 0) PS[row * 40 + (cbase >> 5)] = s;
                            if (cbase < 896) store8(CQ + row * 384 + (c0 - 512), v0, v1); else store8(CKV + row * 256 + (c0 - 896), v0, v1);
                        } else {
                            const int wcc = (cbase - 1152) >> 5;
                            if (lat) {
                                const int t = (jt - 1) * 256 + rl;
                                const f32x4 ca = *(const f32x4*)(cs + t * 32 + wcc * 16 + 8 * (fq & 1)), cb2 = *(const f32x4*)(cs + t * 32 + wcc * 16 + 8 * (fq & 1) + 4);
                                const f32x4 sa = *(const f32x4*)(sn + t * 32 + wcc * 16 + 8 * (fq & 1)), sb2 = *(const f32x4*)(sn + t * 32 + wcc * 16 + 8 * (fq & 1) + 4);
                                f32x4 p0, p1;
#pragma unroll
                                for (int j = 0; j < 4; ++j) { p0[j] = __shfl_xor(v0[j], 32); p1[j] = __shfl_xor(v1[j], 32); }
                                const float sg = (fq < 2) ? -1.f : 1.f;
#pragma unroll
                                for (int j = 0; j < 4; ++j) { v0[j] = v0[j] * ca[j] + sg * p0[j] * sa[j]; v1[j] = v1[j] * cb2[j] + sg * p1[j] * sb2[j]; }
                            }
#pragma unroll
                            for (int h = 0; h < 4; ++h) store8(Kb + row * 768 + h * 192 + 128 + wcc * 32 + 8 * fq, v0, v1);
                        }
                    }
            }
        } else if (!UPK && (kind == EK_Q || kind == EK_KV)) {
            const float* PS = (const float*)(ws + WS_PS);
            bf16_t* Q = (bf16_t*)(ws + R_Q); const float* cs = (const float*)(ws + WS_R64C); const float* sn = (const float*)(ws + WS_R64S);
            bf16_t* Kb = (bf16_t*)(ws + R_K); bf16_t* Vb = (bf16_t*)(ws + R_V);
#pragma unroll
            for (int ai = 0; ai < 2; ++ai)
#pragma unroll
                for (int m = 0; m < 4; ++m) {
                    const int rl = ai * 128 + m * 16 + rloc0; const size_t row = (size_t)u.pm * 256 + rl; float rsc;
                    if (kind == EK_Q) { const f32x4 a = *(const f32x4*)(PS + row * 40 + 16), b = *(const f32x4*)(PS + row * 40 + 20), c = *(const f32x4*)(PS + row * 40 + 24);
                        const float s = ((a[0] + a[1]) + (a[2] + a[3])) + ((b[0] + b[1]) + (b[2] + b[3])) + ((c[0] + c[1]) + (c[2] + c[3])); rsc = rsqrtf(s * (1.f / 384.f) + EPS_N); }
                    else { const f32x4 a = *(const f32x4*)(PS + row * 40 + 28), b = *(const f32x4*)(PS + row * 40 + 32);
                        const float s = ((a[0] + a[1]) + (a[2] + a[3])) + ((b[0] + b[1]) + (b[2] + b[3])); rsc = rsqrtf(s * (1.f / 256.f) + EPS_N); }
#pragma unroll
                    for (int bj = 0; bj < 2; ++bj) {
                        f32x4 v0 = acc[ai][bj][m][0] * rsc, v1 = acc[ai][bj][m][1] * rsc;
                        if (kind == EK_Q) {
                            const int cbase = u.pn * 256 + bj * 128 + wc * 32, d0 = cbase % 192; const bool rp = d0 >= 128; const int wcc = (d0 - 128) >> 5;
                            if (rp && lat) {
                                const int t = (jt - 1) * 256 + rl; const int to = t * 32 + wcc * 16 + 8 * (fq & 1); const float sg = (fq < 2) ? -1.f : 1.f;
                                { const f32x4 ca = *(const f32x4*)(cs + to), sa = *(const f32x4*)(sn + to);
#pragma unroll
                                  for (int j = 0; j < 4; ++j) { const float pp = __shfl_xor(v0[j], 32); v0[j] = v0[j] * ca[j] + sg * pp * sa[j]; } }
                                { const f32x4 ca = *(const f32x4*)(cs + to + 4), sa = *(const f32x4*)(sn + to + 4);
#pragma unroll
                                  for (int j = 0; j < 4; ++j) { const float pp = __shfl_xor(v1[j], 32); v1[j] = v1[j] * ca[j] + sg * pp * sa[j]; } }
                            }
                            store8(Q + row * 768 + cbase + 8 * fq, v0, v1);
                        } else {
                            if (bj == 0) store8(Kb + row * 768 + u.pn * 192 + wc * 32 + 8 * fq, v0, v1); else store8(Vb + row * 512 + u.pn * 128 + wc * 32 + 8 * fq, v0, v1);
                        }
                    }
                    __builtin_amdgcn_sched_barrier(0);
                }
        } else if (!UPK && kind == EK_GLU) {
            const bf16_t* G = (const bf16_t*)(ws + R_G); bf16_t* CAT = (bf16_t*)(ws + R_CAT);
#pragma unroll
            for (int bj = 0; bj < 2; ++bj) {
                const int c0 = u.pn * 256 + bj * 128 + wc * 32 + 8 * fq; const f32x4 b0 = *(const f32x4*)(bglu + c0), b1 = *(const f32x4*)(bglu + c0 + 4);
#pragma unroll
                for (int ai = 0; ai < 2; ++ai)
#pragma unroll
                    for (int m = 0; m < 4; ++m) { const size_t row = (size_t)u.pm * 256 + ai * 128 + m * 16 + rloc0;
                        const u32x4 gw = *(const u32x4*)(G + row * 512 + c0); f32x4 v0 = acc[ai][bj][m][0] + b0, v1 = acc[ai][bj][m][1] + b1;
                        v0[0] = bflo(gw.x) * fast_sigmoid(v0[0]); v0[1] = bfhi(gw.x) * fast_sigmoid(v0[1]); v0[2] = bflo(gw.y) * fast_sigmoid(v0[2]); v0[3] = bfhi(gw.y) * fast_sigmoid(v0[3]);
                        v1[0] = bflo(gw.z) * fast_sigmoid(v1[0]); v1[1] = bfhi(gw.z) * fast_sigmoid(v1[1]); v1[2] = bflo(gw.w) * fast_sigmoid(v1[2]); v1[3] = bfhi(gw.w) * fast_sigmoid(v1[3]);
                        store8(CAT + row * 1024 + c0, v0, v1); }
            }
        } else if (!UPK && kind == EK_RES) {
            const float* hi_ = lat ? hin_l + ((size_t)bb * NLAT + (jt - 1) * 256) * DMODEL : hin_c + (size_t)bb * NCTX * DMODEL;
            float* ho_ = lat ? hout_l + ((size_t)bb * NLAT + (jt - 1) * 256) * DMODEL : hout_c + (size_t)bb * NCTX * DMODEL;
            const float* gt = gate + (size_t)(lat ? bb : 16) * 6144;
#pragma unroll
            for (int bj = 0; bj < 2; ++bj) {
                const int c0 = u.pn * 256 + bj * 128 + wc * 32 + 8 * fq; const f32x4 g0 = *(const f32x4*)(gt + c0), g1 = *(const f32x4*)(gt + c0 + 4);
#pragma unroll
                for (int ai = 0; ai < 2; ++ai)
#pragma unroll
                    for (int m = 0; m < 4; ++m) { const size_t off = (size_t)(ai * 128 + m * 16 + rloc0) * DMODEL + c0;
                        const f32x4 h0 = *(const f32x4*)(hi_ + off), h1 = *(const f32x4*)(hi_ + off + 4);
                        *(f32x4*)(ho_ + off) = h0 + g0 * acc[ai][bj][m][0]; *(f32x4*)(ho_ + off + 4) = h1 + g1 * acc[ai][bj][m][1]; }
            }
        } else if (UPK) {
            bf16_t* HH = (bf16_t*)(ws + R_HH); float* EP = (float*)(ws + WS_EDGE); float* EG = EP + EDGE_ARR / 4; float* EA = EG + EDGE_ARR / 4;
            const int jc = u.pn * 128 + wc * 32 + 8 * fq;
            float w0[8], w1[8], w2[8], cbv[8], pvv[8], nxx[8];
#pragma unroll
            for (int c = 0; c < 8; ++c) { w0[c] = cw[jc + c]; w1[c] = cw[FFH + jc + c]; w2[c] = cw[2 * FFH + jc + c]; cbv[c] = cb[jc + c];
                const float pv_ = __shfl_up(acc[1][0][3][c >> 2][c & 3], 1, 16), nx_ = __shfl_down(acc[0][0][0][c >> 2][c & 3], 1, 16);
                pvv[c] = fr == 0 ? 0.f : pv_; nxx[c] = fr == 15 ? 0.f : nx_; }
            const size_t tok0 = (size_t)u.pm * 256 + wr * 128 + 8 * fr; const int blk = 2 * u.pm + wr;
#pragma unroll
            for (int ai = 0; ai < 2; ++ai)
#pragma unroll
                for (int m = 0; m < 4; ++m) {
                    const int idx = 4 * ai + m; float hv[8], av[8], gv[8];
#pragma unroll
                    for (int c = 0; c < 8; ++c) { const int n = c >> 2, jj = c & 3;
                        const float cur = acc[ai][0][m][n][jj];
                        const float prev = idx == 0 ? pvv[c] : (m > 0 ? acc[ai][0][m - 1][n][jj] : acc[0][0][3][n][jj]);
                        const float next = idx == 7 ? nxx[c] : (m < 3 ? acc[ai][0][m + 1][n][jj] : acc[1][0][0][n][jj]);
                        const float cv = cbv[c] + w0[c] * prev + w1[c] * cur + w2[c] * next;
                        av[c] = cur; gv[c] = acc[ai][1][m][n][jj]; hv[c] = cv; }
                    const bool edge0 = (idx == 0 && fr == 0), edge1 = (idx == 7 && fr == 15);
                    if (edge0 || edge1) { const size_t eo = ((size_t)blk * 2 + (edge1 ? 1 : 0)) * FFH + jc;
#pragma unroll
                        for (int c = 0; c < 8; ++c) { EP[eo + c] = hv[c]; EG[eo + c] = gv[c]; EA[eo + c] = av[c]; }
                    } else { f32x4 o0, o1;
#pragma unroll
                        for (int c = 0; c < 4; ++c) { o0[c] = gelu_t(hv[c]) * gv[c]; o1[c] = gelu_t(hv[4 + c]) * gv[4 + c]; }
                        store8(HH + (tok0 + idx) * FFH + jc, o0, o1); }
                }
        } else if (!UPK && kind == EK_INCD) {
            const int pn = u.pn; const int grp = pn < 2 ? 0 : pn < 4 ? 1 : pn < 6 ? 2 : pn < 8 ? 3 : pn < 10 ? 4 : pn == 10 ? 5 : 6;
            const bool roped = (grp == 0 || grp == 1 || grp == 4 || grp == 5), hnorm = (grp == 4 || grp == 5);
            bf16_t* CAT1 = (bf16_t*)(ws + R_CAT1); const float* cs = (const float*)(ws + WS_R128C); const float* sn = (const float*)(ws + WS_R128S);
            float rs[2][2][4];
            if (hnorm) {
#pragma unroll
                for (int bj = 0; bj < 2; ++bj)
#pragma unroll
                    for (int ai = 0; ai < 2; ++ai)
#pragma unroll
                        for (int m = 0; m < 4; ++m) { const f32x4 v0 = acc[ai][bj][m][0], v1 = acc[ai][bj][m][1];
                            float s = (v0[0] * v0[0] + v0[1] * v0[1]) + (v0[2] * v0[2] + v0[3] * v0[3]) + (v1[0] * v1[0] + v1[1] * v1[1]) + (v1[2] * v1[2] + v1[3] * v1[3]);
                            s += __shfl_xor(s, 16); s += __shfl_xor(s, 32);
                            if (fq == 0) scr[(((wr * 2 + bj) * 8 + ai * 4 + m) * 16 + fr) * 4 + wc] = s; }
                asm volatile("s_waitcnt lgkmcnt(0)" ::: "memory"); __builtin_amdgcn_s_barrier(); asm volatile("" ::: "memory");
#pragma unroll
                for (int bj = 0; bj < 2; ++bj)
#pragma unroll
                    for (int ai = 0; ai < 2; ++ai)
#pragma unroll
                        for (int m = 0; m < 4; ++m) { const f32x4 p = *(const LAS f32x4*)(scr + (((wr * 2 + bj) * 8 + ai * 4 + m) * 16 + fr) * 4);
                            rs[bj][ai][m] = rsqrtf(((p[0] + p[1]) + (p[2] + p[3])) * (1.f / 128.f) + EPS_N); }
                asm volatile("s_waitcnt lgkmcnt(0)" ::: "memory"); __builtin_amdgcn_s_barrier(); asm volatile("" ::: "memory");
            }
            const int dloc = 32 * wc + 8 * fq;
            bf16_t* dbase; int dld;
            if (grp == 0) { dbase = CAT1; dld = 1024; } else if (grp == 1) { dbase = (bf16_t*)(ws + R_RK); dld = 512; } else if (grp == 2) { dbase = (bf16_t*)(ws + R_RV); dld = 512; }
            else if (grp == 3) { dbase = (bf16_t*)(ws + R_RG); dld = 512; } else if (grp == 4) { dbase = CAT1 + 512; dld = 1024; } else if (grp == 5) { dbase = (bf16_t*)(ws + R_GK); dld = 256; } else { dbase = (bf16_t*)(ws + R_GV); dld = 256; }
            float gw[8];
            if (hnorm) {
#pragma unroll
                for (int c = 0; c < 8; ++c) { const int dp = dloc + c, orig = (dp & 64) + ((dp & 1) ? 32 : 0) + ((dp & 63) >> 1); gw[c] = (grp == 4 ? gq : gk)[orig]; }
            }
#pragma unroll
            for (int bj = 0; bj < 2; ++bj) {
                const int hh = (grp >= 5) ? bj : (pn & 1) * 2 + bj;
#pragma unroll
                for (int ai = 0; ai < 2; ++ai)
#pragma unroll
                    for (int m = 0; m < 4; ++m) {
                        const int rl = ai * 128 + m * 16 + rloc0; const size_t row = (size_t)u.pm * 256 + rl;
                        f32x4 v0 = acc[ai][bj][m][0], v1 = acc[ai][bj][m][1];
                        if (hnorm) { const float r = rs[bj][ai][m];
#pragma unroll
                            for (int c = 0; c < 4; ++c) { v0[c] = v0[c] * r * gw[c]; v1[c] = v1[c] * r * gw[4 + c]; } }
                        if (grp == 1) { v0 = v0 * 0.08838834764831845f; v1 = v1 * 0.08838834764831845f; }
                        if (roped && lat) {
                            const int t = (jt - 1) * 256 + rl; const int ti = t * 64 + 32 * (wc >> 1) + 16 * (wc & 1) + 4 * fq;
                            const f32x4 c4 = *(const f32x4*)(cs + ti), s4 = *(const f32x4*)(sn + ti);
                            f32x4 o0, o1;
                            o0[0] = v0[0] * c4[0] - v0[1] * s4[0]; o0[1] = v0[1] * c4[0] + v0[0] * s4[0]; o0[2] = v0[2] * c4[1] - v0[3] * s4[1]; o0[3] = v0[3] * c4[1] + v0[2] * s4[1];
                            o1[0] = v1[0] * c4[2] - v1[1] * s4[2]; o1[1] = v1[1] * c4[2] + v1[0] * s4[2]; o1[2] = v1[2] * c4[3] - v1[3] * s4[3]; o1[3] = v1[3] * c4[3] + v1[2] * s4[3];
                            v0 = o0; v1 = o1;
                        }
                        bf16_t* dst = dbase + row * dld + 128 * hh + dloc;
                        store8(dst, v0, v1);
                    }
            }
        }
    }
};
namespace att {
constexpr int NW = 8, QBLK = 32, KVBLK = 64;
constexpr float THR = 0.f;
#define SBAR() __builtin_amdgcn_sched_barrier(0)
__device__ __forceinline__ int crow(int r, int hi) { return (r & 3) + 8 * (r >> 2) + 4 * hi; }
__device__ __forceinline__ int v_st(int k, int c) { const int kk = (k & ~0xC) | ((k & 4) << 1) | ((k & 8) >> 1); return ((kk >> 3) * 4 + (c >> 5)) * 512 + ((kk & 7) * 32 + (c & 31)) * 2; }
__device__ __forceinline__ int v_rd_base(int lane) { return ((lane & 3) << 3) | (((lane >> 2) & 3) << 6) | (((lane >> 4) & 1) << 5) | (((lane >> 5) & 1) << 8); }
constexpr int v_rd_off(int d0, int ks, int half) { return d0 * 512 + ks * 4096 + half * 2048; }
template <int OFF> __device__ __forceinline__ s16x4 tr_read(int vb) { s16x4 r; asm volatile("ds_read_b64_tr_b16 %0, %1 offset:%2" : "=&v"(r) : "v"(vb), "i"(OFF) : "memory"); return r; }
template <int D0> __device__ __forceinline__ void pv_one(f32x16& od, int vb, bf16x8 pa0, bf16x8 pa1, bf16x8 pa2, bf16x8 pa3) {
  const s16x4 l0 = tr_read<v_rd_off(D0, 0, 0)>(vb), h0 = tr_read<v_rd_off(D0, 0, 1)>(vb), l1 = tr_read<v_rd_off(D0, 1, 0)>(vb), h1 = tr_read<v_rd_off(D0, 1, 1)>(vb);
  const s16x4 l2 = tr_read<v_rd_off(D0, 2, 0)>(vb), h2 = tr_read<v_rd_off(D0, 2, 1)>(vb), l3 = tr_read<v_rd_off(D0, 3, 0)>(vb), h3 = tr_read<v_rd_off(D0, 3, 1)>(vb);
  asm volatile("s_waitcnt lgkmcnt(0)" ::: "memory"); SBAR();
#define PK(L, H) (bf16x8){L[0], L[1], L[2], L[3], H[0], H[1], H[2], H[3]}
  od = __builtin_amdgcn_mfma_f32_32x32x16_bf16(pa0, PK(l0, h0), od, 0, 0, 0);
  od = __builtin_amdgcn_mfma_f32_32x32x16_bf16(pa1, PK(l1, h1), od, 0, 0, 0);
  od = __builtin_amdgcn_mfma_f32_32x32x16_bf16(pa2, PK(l2, h2), od, 0, 0, 0);
  od = __builtin_amdgcn_mfma_f32_32x32x16_bf16(pa3, PK(l3, h3), od, 0, 0, 0);
#undef PK
}
__device__ __forceinline__ void pv_d0(f32x16* o, int vb, bf16x8 pa0, bf16x8 pa1, bf16x8 pa2, bf16x8 pa3) {
  pv_one<0>(o[0], vb, pa0, pa1, pa2, pa3); pv_one<1>(o[1], vb, pa0, pa1, pa2, pa3); pv_one<2>(o[2], vb, pa0, pa1, pa2, pa3); pv_one<3>(o[3], vb, pa0, pa1, pa2, pa3);
}
__device__ __forceinline__ void pack_p(const f32x16& p0, const f32x16& p1, bf16x8& pa0, bf16x8& pa1, bf16x8& pa2, bf16x8& pa3) {
#define PK4(P, BASE, OUT) do { unsigned a0 = pk2(P[BASE + 0], P[BASE + 1]), a1 = pk2(P[BASE + 2], P[BASE + 3]);   \
    unsigned b0 = pk2(P[BASE + 4], P[BASE + 5]), b1 = pk2(P[BASE + 6], P[BASE + 7]);                              \
    auto r0 = __builtin_amdgcn_permlane32_swap(a0, b0, false, false); auto r1 = __builtin_amdgcn_permlane32_swap(a1, b1, false, false); \
    u32x4 w = {r0[0], r1[0], r0[1], r1[1]}; OUT = __builtin_bit_cast(bf16x8, w); } while (0)
  PK4(p0, 0, pa0); PK4(p0, 8, pa1); PK4(p1, 0, pa2); PK4(p1, 8, pa3);
#undef PK4
}
template <int DQK>
__device__ __forceinline__ void partialSM(f32x16& p0, f32x16& p1, float& m_reg, float& mn, float& alpha) {
  constexpr float SCALE = DQK == 128 ? 0.088388347648318440f : 0.072168783648703220f;
  constexpr float C = SCALE * LOG2E;
  float pmax = p0[0];
#pragma unroll
  for (int r = 1; r < 16; ++r) pmax = fmaxf(pmax, p0[r]);
#pragma unroll
  for (int r = 0; r < 16; ++r) pmax = fmaxf(pmax, p1[r]);
  { auto rr = __builtin_amdgcn_permlane32_swap(__float_as_uint(pmax), __float_as_uint(pmax), false, false);
    pmax = fmaxf(__uint_as_float(rr[0]), __uint_as_float(rr[1])); }
  if (__builtin_expect(__all(pmax - m_reg <= THR / SCALE), 1)) { mn = m_reg; alpha = 1.f; }
  else { mn = fmaxf(m_reg, pmax); alpha = __builtin_amdgcn_exp2f((m_reg - mn) * C); m_reg = mn; }
  const float mnC = -mn * C;
#pragma unroll
  for (int r = 0; r < 16; ++r) p0[r] = fmaf(p0[r], C, mnC);
#pragma unroll
  for (int r = 0; r < 16; ++r) p1[r] = fmaf(p1[r], C, mnC);
#pragma unroll
  for (int r = 0; r < 16; ++r) p0[r] = __builtin_amdgcn_exp2f(p0[r]);
}
__device__ __forceinline__ void finishSM(f32x16& p0, f32x16& p1, float alpha, float& l_reg, bf16x8& pa0, bf16x8& pa1, bf16x8& pa2, bf16x8& pa3) {
#pragma unroll
  for (int r = 0; r < 16; ++r) p1[r] = __builtin_amdgcn_exp2f(p1[r]);
  float ps = 0;
#pragma unroll
  for (int r = 0; r < 16; ++r) ps += p0[r];
#pragma unroll
  for (int r = 0; r < 16; ++r) ps += p1[r];
  { auto rr = __builtin_amdgcn_permlane32_swap(__float_as_uint(ps), __float_as_uint(ps), false, false);
    ps = __uint_as_float(rr[0]) + __uint_as_float(rr[1]); }
  l_reg = l_reg * alpha + ps;
  pack_p(p0, p1, pa0, pa1, pa2, pa3);
}
__device__ __forceinline__ void ret_weights(f32x16& p0, f32x16& p1, int kind, float dnb  , float lf2, float lb2) {
  if (kind == 0) {
    const float a = lf2 * dnb;
#pragma unroll
    for (int r = 0; r < 16; ++r) { const float c = (float)((r & 3) + 8 * (r >> 2));
      p0[r] *= __builtin_amdgcn_exp2f(fmaf(-lf2, c, a)); p1[r] *= __builtin_amdgcn_exp2f(fmaf(-lf2, c + 32.f, a)); }
  } else if (kind == 1) {
    const float a = -lb2 * dnb;
#pragma unroll
    for (int r = 0; r < 16; ++r) { const float c = (float)((r & 3) + 8 * (r >> 2));
      p0[r] *= __builtin_amdgcn_exp2f(fmaf(lb2, c, a)); p1[r] *= __builtin_amdgcn_exp2f(fmaf(lb2, c + 32.f, a)); }
  } else if (kind == 2) {
#pragma unroll
    for (int r = 0; r < 16; ++r) { const float c = (float)((r & 3) + 8 * (r >> 2));
      const float d0 = dnb - c, d1 = dnb - c - 32.f;
      const float w0 = (d0 >= 0.f ? __builtin_amdgcn_exp2f(lf2 * d0) : 0.f) + (d0 <= 0.f ? __builtin_amdgcn_exp2f(-lb2 * d0) : 0.f);
      const float w1 = (d1 >= 0.f ? __builtin_amdgcn_exp2f(lf2 * d1) : 0.f) + (d1 <= 0.f ? __builtin_amdgcn_exp2f(-lb2 * d1) : 0.f);
      p0[r] *= w0; p1[r] *= w1; }
  } else {
#pragma unroll
    for (int r = 0; r < 16; ++r) { const float c = (float)((r & 3) + 8 * (r >> 2));
      const float d0 = dnb - c, d1 = dnb - c - 32.f;
      p0[r] *= __builtin_amdgcn_exp2f(lf2 * d0) + __builtin_amdgcn_exp2f(lb2 * (2304.f - d0));
      p1[r] *= __builtin_amdgcn_exp2f(lf2 * d1) + __builtin_amdgcn_exp2f(lb2 * (2304.f - d1)); }
  }
}

template <int DQK> struct Shm { static constexpr int V = KVBLK * 128 * 2, K = KVBLK * DQK * 2, WSO = 2 * V + 2 * K, TOTAL = WSO + NW * 64 * 4; };

template <int DQK, int MODE, int SDEPTH, int ldq, int ldk, int ldv, int ldo, int ldg>
__device__ __forceinline__ void attn_unit(const bf16_t* Qb, const bf16_t* __restrict__ Kh, const bf16_t* __restrict__ Vh, bf16_t* Ob, int seq, char* lds,
                                          int n0, float lf2, float lb2, const bf16_t* Gb) {
  using SH = Shm<DQK>;
  constexpr int ND = DQK / 16, NKC = DQK / 8, KPT = DQK / 64, NLD = 2 + KPT;
#define KSWZ(row, colB) ((row) * (DQK * 2) + ((colB) ^ (((row) & 7) << 4)))
  int tid_ = threadIdx.x; asm volatile("" : "+v"(tid_));
  const int tid = tid_, wid = tid >> 6, lane = tid & 63, r32 = lane & 31, hi = lane >> 5;
  char* V_lds = lds; char* K_lds = lds + 2 * SH::V;
  float* ws = (float*)(lds + SH::WSO) + wid * 64; float* li_l = ws; float* al_l = ws + 32;
  float m_reg = -1e30f, l_reg = 0; f32x16 o[4] = {}; bf16x8 qr[ND];
  const bf16_t* Qw = Qb + (long)(wid * QBLK + r32) * ldq + hi * 8;
#pragma unroll
  for (int d0 = 0; d0 < ND; ++d0) qr[d0] = *reinterpret_cast<const bf16x8*>(Qw + d0 * 16);
  const int sr = tid >> 4, sc = (tid & 15) * 8, vst0 = v_st(sr, sc), vst1 = v_st(32 + sr, sc);
  int krow[KPT], kcol[KPT];
#pragma unroll
  for (int i = 0; i < KPT; ++i) { const int id = tid + 512 * i; krow[i] = id / NKC; kcol[i] = (id % NKC) * 8; }
  const int vb0 = (int)(uintptr_t)V_lds + v_rd_base(lane);
  struct { bf16x8 vs0, vs1, ks[KPT]; } sr_[SDEPTH == 0 ? 1 : SDEPTH];
  constexpr int SE = 0, SO = SDEPTH == 2 ? 1 : 0;
#define SLOAD(i, k0) do { sr_[i].vs0 = *reinterpret_cast<const bf16x8*>(&Vh[(long)((k0) + sr) * ldv + sc]); sr_[i].vs1 = *reinterpret_cast<const bf16x8*>(&Vh[(long)((k0) + 32 + sr) * ldv + sc]); \
    _Pragma("unroll") for (int q_ = 0; q_ < KPT; ++q_) sr_[i].ks[q_] = *reinterpret_cast<const bf16x8*>(&Kh[(long)((k0) + krow[q_]) * ldk + kcol[q_]]); } while (0)
#define SWRITE(b, i) do { *(bf16x8*)(V_lds + (b) * SH::V + vst0) = sr_[i].vs0; *(bf16x8*)(V_lds + (b) * SH::V + vst1) = sr_[i].vs1; \
    _Pragma("unroll") for (int q_ = 0; q_ < KPT; ++q_) *(bf16x8*)(K_lds + (b) * SH::K + KSWZ(krow[q_], kcol[q_] * 2)) = sr_[i].ks[q_]; } while (0)
#define SWAIT() do { if constexpr (SDEPTH == 1) asm volatile("s_waitcnt vmcnt(0)" ::: "memory"); else if constexpr (NLD == 4) asm volatile("s_waitcnt vmcnt(4)" ::: "memory"); else asm volatile("s_waitcnt vmcnt(5)" ::: "memory"); } while (0)
#define RESC(a) do { if (__any((a) < 1.f)) { if (hi == 0) al_l[r32] = (a); asm volatile("s_waitcnt lgkmcnt(0)" ::: "memory"); \
    _Pragma("unroll") for (int d = 0; d < 4; ++d) _Pragma("unroll") for (int r = 0; r < 16; ++r) o[d][r] *= al_l[crow(r, hi)]; } } while (0)
#define QKT(P0, P1, Kbuf) do { P0 = f32x16{}; P1 = f32x16{}; _Pragma("unroll") for (int d0 = 0; d0 < ND; ++d0) { const int cb = (d0 * 16 + hi * 8) * 2; \
    const bf16x8 b0 = *reinterpret_cast<const bf16x8*>((Kbuf) + KSWZ(r32, cb)); const bf16x8 b1 = *reinterpret_cast<const bf16x8*>((Kbuf) + KSWZ(32 + r32, cb)); \
    P0 = __builtin_amdgcn_mfma_f32_32x32x16_bf16(b0, qr[d0], P0, 0, 0, 0); P1 = __builtin_amdgcn_mfma_f32_32x32x16_bf16(b1, qr[d0], P1, 0, 0, 0); } } while (0)
  const int qb4 = n0 >> 6;
  const float nlane = (float)(n0 + wid * QBLK + r32 - 4 * hi);
#define TKIND(tj) ((tj) < 4 ? 3 : ((tj) - 4 < qb4 ? 0 : ((tj) - 4 >= qb4 + 4 ? 1 : 2)))
#define PART(P0, P1, tj, MN, AL) do { if constexpr (MODE == 0) partialSM<DQK>(P0, P1, m_reg, MN, AL); else ret_weights(P0, P1, TKIND(tj), nlane - (float)(64 * (tj) - 256), lf2, lb2); } while (0)
#define FIN(P0, P1, AL) do { if constexpr (MODE == 0) finishSM(P0, P1, AL, l_reg, pa0, pa1, pa2, pa3); else pack_p(P0, P1, pa0, pa1, pa2, pa3); } while (0)
  f32x16 pA0, pA1, pB0, pB1; float mnA = 0.f, mnB = 0.f, alA = 1.f, alB = 1.f; bf16x8 pa0, pa1, pa2, pa3; const int NT = seq / KVBLK;
  if constexpr (SDEPTH == 0) {
    SLOAD(0, 0); asm volatile("s_waitcnt vmcnt(0)" ::: "memory"); SWRITE(0, 0); __syncthreads();
#pragma unroll 1
    for (int j = 0; j < NT; ++j) {
      const int bsel = j & 1;
      if (j + 1 < NT) SLOAD(0, (j + 1) * KVBLK);
      SBAR(); QKT(pA0, pA1, K_lds + bsel * SH::K);
      PART(pA0, pA1, j, mnA, alA);
      if constexpr (MODE == 0) RESC(alA);
      FIN(pA0, pA1, alA); SBAR();
      pv_d0(o, vb0 + bsel * SH::V, pa0, pa1, pa2, pa3);
      if (j + 1 < NT) { asm volatile("s_waitcnt vmcnt(0)" ::: "memory"); SWRITE(bsel ^ 1, 0); }
      __syncthreads();
    }
  } else {
    SLOAD(SE, 0); asm volatile("s_waitcnt vmcnt(0)" ::: "memory"); SWRITE(0, SE); __syncthreads();
    QKT(pA0, pA1, K_lds); PART(pA0, pA1, 0, mnA, alA);
    SLOAD(SO, KVBLK); if constexpr (SDEPTH == 2) { if (2 < NT) SLOAD(SE, 2 * KVBLK); }
    SWAIT(); SWRITE(1, SO); __syncthreads();
#pragma unroll 1
    for (int j = 1; j + 1 < NT; j += 2) {
      SBAR(); QKT(pB0, pB1, K_lds + SH::K);
      FIN(pA0, pA1, alA); SBAR();
      SLOAD(SO, (j + SDEPTH) * KVBLK); SBAR();
      pv_d0(o, vb0, pa0, pa1, pa2, pa3); PART(pB0, pB1, j, mnB, alB);
      __syncthreads(); SWAIT(); SWRITE(0, SE);
      if constexpr (MODE == 0) RESC(alB);
      __syncthreads();
      SBAR(); QKT(pA0, pA1, K_lds);
      FIN(pB0, pB1, alB); SBAR();
      if (SDEPTH == 1 || j + 3 < NT) SLOAD(SE, (j + 1 + SDEPTH) * KVBLK); SBAR();
      pv_d0(o, vb0 + SH::V, pa0, pa1, pa2, pa3); PART(pA0, pA1, j + 1, mnA, alA);
      __syncthreads(); SWAIT(); SWRITE(1, SO);
      if constexpr (MODE == 0) RESC(alA);
      __syncthreads();
    }
    SBAR(); QKT(pB0, pB1, K_lds + SH::K);
    FIN(pA0, pA1, alA); SBAR();
    pv_d0(o, vb0, pa0, pa1, pa2, pa3); PART(pB0, pB1, NT - 1, mnB, alB);
    __syncthreads();
    if constexpr (MODE == 0) RESC(alB);
    FIN(pB0, pB1, alB); SBAR();
    pv_d0(o, vb0 + SH::V, pa0, pa1, pa2, pa3);
  }
  bf16_t* Ow = Ob + (long)(wid * QBLK) * ldo;
  if constexpr (MODE == 0) {
    if (hi == 0) li_l[r32] = l_reg; asm volatile("s_waitcnt lgkmcnt(0)" ::: "memory");
    float rli[16];
#pragma unroll
    for (int r = 0; r < 16; ++r) rli[r] = __builtin_amdgcn_rcpf(li_l[crow(r, hi)]);
#pragma unroll
    for (int r = 0; r < 16; ++r) { const int orow = crow(r, hi);
#pragma unroll
      for (int d0 = 0; d0 < 4; ++d0) Ow[(long)orow * ldo + d0 * 32 + r32] = f2bf(o[d0][r] * rli[r]);
      SBAR(); }
  } else {
    const bf16_t* Gw = Gb + (long)(wid * QBLK) * ldg;
#pragma unroll
    for (int r = 0; r < 16; ++r) {
      float ss = (o[0][r] * o[0][r] + o[1][r] * o[1][r]) + (o[2][r] * o[2][r] + o[3][r] * o[3][r]);
#pragma unroll
      for (int off = 1; off < 32; off <<= 1) ss += __shfl_xor(ss, off);
      const float rs = rsqrtf(ss * (1.f / 128.f) + EPS_N); const int orow = crow(r, hi);
#pragma unroll
      for (int d0 = 0; d0 < 4; ++d0) { const float g = bf1(Gw[(long)orow * ldg + d0 * 32 + r32]); Ow[(long)orow * ldo + d0 * 32 + r32] = f2bf(o[d0][r] * rs * silu_t(g)); }
      SBAR();
    }
  }
  __syncthreads();
#undef KSWZ
#undef SLOAD
#undef SWRITE
#undef SWAIT
#undef RESC
#undef QKT
#undef TKIND
#undef PART
#undef FIN
}
#undef SBAR
}
constexpr int NWAVES = 8;
constexpr int RING_BYTES = 131072, SCR_OFF = RING_BYTES, MISC_OFF = SCR_OFF + 8192, LDS_BYTES = 147456;

__device__ __forceinline__ void s5_wave(unsigned char* ws, const float* dskip_all, int g, int b, LAS unsigned char* lw, int lane) {
  const bf16_t* U = (const bf16_t*)(ws + R_U); bf16_t* G = (bf16_t*)(ws + R_G); float* YP = (float*)(ws + WS_XN);
  const float* LAM = (const float*)(ws + WS_S5LAM); const bf16_t* BB = (const bf16_t*)(ws + WS_S5BB); const bf16_t* CC = (const bf16_t*)(ws + WS_S5CC);
  const int col = lane & 31, hi = lane >> 5, h16 = lane & 15, q4 = lane >> 4;
  bf16x8 bbf[4], bbb[4], ccf[2][4];
#pragma unroll
  for (int j = 0; j < 4; ++j) { bbf[j] = *(const bf16x8*)(BB + ((size_t)(0 * 32 + g) * 128 + 32 * j + col) * 16 + 8 * hi); bbb[j] = *(const bf16x8*)(BB + ((size_t)(1 * 32 + g) * 128 + 32 * j + col) * 16 + 8 * hi); }
#pragma unroll
  for (int c = 0; c < 2; ++c)
#pragma unroll
    for (int ks = 0; ks < 4; ++ks) ccf[c][ks] = *(const bf16x8*)(CC + ((size_t)(c * 32 + g) * 16 + h16) * 128 + 32 * ks + 8 * q4);
  const float l0r = LAM[((hi * 32 + g) * 64 + col) * 2], l0i = LAM[((hi * 32 + g) * 64 + col) * 2 + 1], l1r = LAM[((hi * 32 + g) * 64 + 32 + col) * 2], l1i = LAM[((hi * 32 + g) * 64 + 32 + col) * 2 + 1];
  const float dsk = dskip_all[g * 16 + h16];
  float s0r = 0.f, s0i = 0.f, s1r = 0.f, s1i = 0.f;
  const int rho = lane & 31, chain_r = (rho >> 2) & 1, tok_r = (rho & 3) + 4 * (rho >> 3);
  const size_t rowb = (size_t)b * RB;
#define S5_POS(chain, sig) ((chain) ? ((sig) < 256 ? 255 - (sig) : 2559 - (sig)) : (sig))
  bf16x8 ua; { const int pos = S5_POS(chain_r, tok_r); ua = *(const bf16x8*)(U + (rowb + pos) * 512 + 16 * g + 8 * hi); }
  for (int s = 0; s < 144; ++s) {
    const bf16x8 zero = {0, 0, 0, 0, 0, 0, 0, 0};
    const bf16x8 a1 = chain_r ? zero : ua, a2 = chain_r ? ua : zero;
    if (s + 1 < 144) { const int pos = S5_POS(chain_r, 16 * (s + 1) + tok_r); ua = *(const bf16x8*)(U + (rowb + pos) * 512 + 16 * g + 8 * hi); }
    f32x16 acc[4];
#pragma unroll
    for (int j = 0; j < 4; ++j) { acc[j] = __builtin_amdgcn_mfma_f32_32x32x16_bf16(a1, bbf[j], f32x16{}, 0, 0, 0); acc[j] = __builtin_amdgcn_mfma_f32_32x32x16_bf16(a2, bbb[j], acc[j], 0, 0, 0); }
    LAS unsigned char* lc = lw + hi * (16 * 272);
#pragma unroll
    for (int r = 0; r < 16; ++r) {
      const float n0r = l0r * s0r - l0i * s0i + acc[0][r], n0i = l0r * s0i + l0i * s0r + acc[1][r]; s0r = n0r; s0i = n0i;
      const float n1r = l1r * s1r - l1i * s1i + acc[2][r], n1i = l1r * s1i + l1i * s1r + acc[3][r]; s1r = n1r; s1i = n1i;
      *(LAS unsigned*)(lc + r * 272 + col * 4) = pk2(s0r, s0i); *(LAS unsigned*)(lc + r * 272 + 128 + col * 4) = pk2(s1r, s1i);
    }
    asm volatile("s_waitcnt lgkmcnt(0)" ::: "memory");
    f32x4 y[2];
#pragma unroll
    for (int c = 0; c < 2; ++c) { y[c] = (f32x4){0.f, 0.f, 0.f, 0.f};
#pragma unroll
      for (int ks = 0; ks < 4; ++ks) { const bf16x8 af = *(const LAS bf16x8*)(lw + c * (16 * 272) + h16 * 272 + (32 * ks + 8 * q4) * 2);
        y[c] = __builtin_amdgcn_mfma_f32_16x16x32_bf16(af, ccf[c][ks], y[c], 0, 0, 0); } }
    const bool second = (s >= 8 && s < 16) || s >= 80;
    if (second) asm volatile("s_waitcnt vmcnt(0)" ::: "memory");
#pragma unroll
    for (int c = 0; c < 2; ++c)
#pragma unroll
      for (int rg = 0; rg < 4; ++rg) { const int sig = 16 * s + 4 * q4 + rg, pos = S5_POS(c, sig);
        float* yp = YP + (((size_t)b * 32 + g) * RB + pos) * 16 + h16;
        if (!second) *yp = y[c][rg];
        else { const float other = __hip_atomic_load(yp, __ATOMIC_RELAXED, __HIP_MEMORY_SCOPE_AGENT); const size_t gi = (rowb + pos) * 512 + 16 * g + h16;
          const float tot = y[c][rg] + other + dsk * bf1(U[gi]); G[gi] = f2bf(gelu_t(tot)); } }
    asm volatile("s_waitcnt lgkmcnt(0)" ::: "memory");
  }
#undef S5_POS
}

#define XB_TMO      128
#define XB_XCNT(j)  (256  + 64 * (j))
#define XB_XSUB(j)  (1280 + 64 * (j))
#define XB_XGEN(j)  (2304 + 64 * (j))
#define XB_TOP      3328
#define XB_TOPGEN   3392
#define XB_SPIN_CAP (1u << 22)
__device__ __forceinline__ unsigned xb_ld(unsigned* p)              { return __hip_atomic_load(p, __ATOMIC_RELAXED, __HIP_MEMORY_SCOPE_AGENT); }
__device__ __forceinline__ unsigned xb_add(unsigned* p, unsigned v) { return __hip_atomic_fetch_add(p, v, __ATOMIC_RELAXED, __HIP_MEMORY_SCOPE_AGENT); }
__device__ __forceinline__ unsigned xb_xcc_id() { return (unsigned)__builtin_amdgcn_s_getreg((3 << 11) | 20) & 0xFu; }
#define XB_SPIN(cond, bar) do { unsigned _sp = 0; while (cond) { __builtin_amdgcn_s_sleep(1); \
    if ((++_sp & 255u) == 0u) { if (xb_ld(&(bar)[XB_TMO])) break; if (_sp > XB_SPIN_CAP) { atomicAdd(&(bar)[XB_TMO], 1u); break; } } } } while (0)
struct XcdBarrier { unsigned* bar; unsigned x; volatile LAS unsigned* st; };
__device__ __forceinline__ XcdBarrier xcd_barrier_post(unsigned* bar, volatile LAS unsigned* st) {
    XcdBarrier b; b.bar = bar; b.x = xb_xcc_id(); b.st = st;
    if (threadIdx.x == 0) (void)xb_add(&bar[XB_XCNT(b.x)], 1u);
    return b;
}
__device__ __forceinline__ void xcd_barrier_complete(unsigned* bar, unsigned x, unsigned& nloc, unsigned& nx) {
    const unsigned G = gridDim.x * gridDim.y * gridDim.z;
    unsigned sum, cnt, mine, sp = 0u;
    for (;;) {
        sum = 0u; cnt = 0u; mine = 0u;
#pragma unroll
        for (unsigned j = 0; j < 16; ++j) { const unsigned c = xb_ld(&bar[XB_XCNT(j)]); sum += c; cnt += (c > 0u) ? 1u : 0u; mine = (j == x) ? c : mine; }
        if (sum == G) break;
        __builtin_amdgcn_s_sleep(1);
        if ((++sp & 255u) == 0u) { if (xb_ld(&bar[XB_TMO])) break; if (sp > XB_SPIN_CAP) { atomicAdd(&bar[XB_TMO], 1u); break; } }
    }
    nloc = mine > 0u ? mine : 1u; nx = cnt > 0u ? cnt : 1u;
}
__device__ __forceinline__ void xcd_barrier(const XcdBarrier& b) {
    asm volatile("s_waitcnt vmcnt(0)" ::: "memory");
    __syncthreads();
    if (threadIdx.x == 0) {
        unsigned* bar = b.bar;
        __builtin_amdgcn_s_waitcnt(0);
        unsigned nloc = b.st[0], nx = b.st[1];
        if (nloc == 0u) { xcd_barrier_complete(bar, b.x, nloc, nx); b.st[0] = nloc; b.st[1] = nx; }
        const unsigned old = xb_add(&bar[XB_XSUB(b.x)], 1u);
        const unsigned gen = old / nloc;
        if (old + 1u == (gen + 1u) * nloc) {
            __builtin_amdgcn_fence(__ATOMIC_RELEASE, "agent");
            asm volatile("s_waitcnt vmcnt(0)" ::: "memory");
            const unsigned og = xb_add(&bar[XB_TOP], 1u);
            const unsigned tg = og / nx;
            if (og + 1u == (tg + 1u) * nx) xb_add(&bar[XB_TOPGEN], 1u);
            else XB_SPIN(xb_ld(&bar[XB_TOPGEN]) == tg, bar);
            __builtin_amdgcn_fence(__ATOMIC_ACQUIRE, "agent");
            xb_add(&bar[XB_XGEN(b.x)], 1u);
            asm volatile("s_waitcnt vmcnt(0)" ::: "memory");
        } else {
            XB_SPIN(xb_ld(&bar[XB_XGEN(b.x)]) == gen, bar);
            __builtin_amdgcn_fence(__ATOMIC_ACQUIRE, "agent");
            asm volatile("s_waitcnt vmcnt(0)" ::: "memory");
        }
    }
    __syncthreads();
}

__device__ __forceinline__ int wt_src(int map, int n, int Nsrc) {
  if (map == 1) { const bool roped = (n < 1024) || (n >= 2048 && n < 2816); if (!roped) return n; const int hb = n & ~127, dp = n & 127; return hb + (dp & 64) + ((dp & 1) ? 32 : 0) + ((dp & 63) >> 1); }
  if (map == 2) { const int pn = n >> 8, bj = (n >> 7) & 1, jj = n & 127; return bj * FFH + 128 * pn + jj; }
  return n < Nsrc ? n : -1;
}
__device__ __forceinline__ void wt_item(const float* W, int K, int Nsrc, int Ndst, bf16_t* WT, int map, const float* kscale, LAS float* scr, int item, int lane) {
  const int nblk = Ndst / 32, kb = item / nblk, nb = item % nblk, k0 = 64 * kb, n0 = 32 * nb;
  const int src = wt_src(map, n0 + (lane & 31), Nsrc);
#pragma unroll 8
  for (int i = 0; i < 32; ++i) { const int kk = 2 * i + (lane >> 5); float v = src >= 0 ? W[(size_t)(k0 + kk) * Nsrc + src] : 0.f; if (kscale) v *= kscale[k0 + kk]; scr[kk * 33 + (lane & 31)] = v; }
  asm volatile("s_waitcnt lgkmcnt(0)" ::: "memory");
  const int c = lane & 7;
#pragma unroll
  for (int j = 0; j < 4; ++j) { const int n = (lane >> 3) + 8 * j; const LAS float* s = scr + (8 * c) * 33 + n;
    u32x4 o; o.x = pk2(s[0 * 33], s[1 * 33]); o.y = pk2(s[2 * 33], s[3 * 33]); o.z = pk2(s[4 * 33], s[5 * 33]); o.w = pk2(s[6 * 33], s[7 * 33]);
    *(u32x4*)(WT + (size_t)(n0 + n) * K + k0 + 8 * c) = o; }
  asm volatile("s_waitcnt lgkmcnt(0)" ::: "memory");
}
__device__ __forceinline__ const float* hrow_ptr(const float* hc, const float* hl, int row) { const int b = row / RB, pos = row - b * RB; return pos < NCTX ? hc + ((size_t)b * NCTX + pos) * DMODEL : hl + ((size_t)b * NLAT + pos - NCTX) * DMODEL; }

template <int ph> __device__ __forceinline__ void run_phase(const MArgs& a, unsigned char* lds, int tid, int lane, int wave, int G, int bx, int vcu) {
  LAS unsigned char* L = (LAS unsigned char*)lds; unsigned char* ws = a.ws;
  const float* x = a.in[0]; const float* ctx = a.in[2];
  float* MODS = (float*)(ws + WS_MODS); float* HC = (float*)(ws + WS_HC); float* HL = a.out;
  const int gw = vcu * NWAVES + wave, NGW = G * NWAVES;
  if (ph == 0) {
    if (bx < 192) {
      LAS float* cond = (LAS float*)L; LAS float* red = (LAS float*)(L + 17 * 1024 * 4);
      for (int i = tid; i < 17 * 1024; i += NWAVES * 64) { const int r = i >> 10, k = i & 1023; const float v = r < 16 ? a.in[1][r * 1024 + k] : a.in[3][k]; cond[i] = v / (1.f + __expf(-v)); }
      __syncthreads();
      const int l = bx / 96, cc = bx % 96; const float* W = a.in[4] + (size_t)l * 1024 * 6144 + cc * 64 + lane;
      float acc[17];
#pragma unroll
      for (int r = 0; r < 17; ++r) acc[r] = 0.f;
      for (int k = wave * 128; k < wave * 128 + 128; ++k) { const float wv = W[(size_t)k * 6144];
#pragma unroll
        for (int r = 0; r < 17; ++r) acc[r] += cond[r * 1024 + k] * wv; }
#pragma unroll
      for (int r = 0; r < 17; ++r) red[(wave * 17 + r) * 64 + lane] = acc[r];
      __syncthreads();
      for (int i = tid; i < 17 * 64; i += NWAVES * 64) { const int r = i >> 6, c = i & 63; float s = a.in[5][l * 6144 + cc * 64 + c];
#pragma unroll
        for (int w = 0; w < 8; ++w) s += red[(w * 17 + r) * 64 + c];
        MODS[((size_t)l * 17 + r) * 6144 + cc * 64 + c] = s; }
      __syncthreads();
    }
    {
      LAS float* scr = (LAS float*)(L + wave * 16384);
      int base = 0;
#define WT_MAT(Wp, K_, Nsrc_, Ndst_, dst_, map_, ks_) do { const int ni = ((K_) / 64) * ((Ndst_) / 32); int it0 = gw - (base % NGW); if (it0 < 0) it0 += NGW; \
        for (int it = it0; it < ni; it += NGW) wt_item((Wp), (K_), (Nsrc_), (Ndst_), (bf16_t*)(ws + (dst_)), (map_), (ks_), scr, it, lane); base += ni; } while (0)
      WT_MAT(a.in[6], 1024, 1216, 1280, W_INAB, 0, (const float*)nullptr);
      WT_MAT(a.in[7], 1024, 1024, 1024, W_OUTAB, 0, (const float*)nullptr);
      WT_MAT(a.in[16], 512, 512, 512, W_GLU, 0, (const float*)nullptr);
      WT_MAT(a.in[19], 384, 768, 768, W_UQ, 0, a.in[18]);
      WT_MAT(a.in[21], 256, 1024, 1024, W_UKV, 0, a.in[20]);
      WT_MAT(a.in[22], 1024, 3072, 3072, W_INCD, 1, (const float*)nullptr);
      WT_MAT(a.in[23], 1024, 1024, 1024, W_OUTCD, 0, (const float*)nullptr);
      WT_MAT(a.in[27], 1024, 5632, 5632, W_UP, 2, (const float*)nullptr);
      WT_MAT(a.in[27] + (size_t)1024 * 5632, 1024, 5632, 5632, W_UP + (size_t)5632 * 1024 * 2, 2, (const float*)nullptr);
      WT_MAT(a.in[30], 2816, 1024, 1024, W_DN, 0, (const float*)nullptr);
      WT_MAT(a.in[30] + (size_t)2816 * 1024, 2816, 1024, 1024, W_DN + (size_t)1024 * 2816 * 2, 0, (const float*)nullptr);
#undef WT_MAT
    }
    { const int gt = vcu * 512 + tid, NT_ = G * 512;
      float* c64 = (float*)(ws + WS_R64C); float* s64 = (float*)(ws + WS_R64S); float* c128 = (float*)(ws + WS_R128C); float* s128 = (float*)(ws + WS_R128S);
      for (int i = gt; i < 2048 * 32; i += NT_) { const int t = i >> 5, j = i & 31, ii = j & 15; const float inv = powf(10000.f, -(float)ii / 16.f), pos = j < 16 ? (float)(t >> 6) : (float)(t & 63);
        float sv, cv; sincosf(pos * inv, &sv, &cv); c64[i] = cv; s64[i] = sv; }
      for (int i = gt; i < 2048 * 64; i += NT_) { const int t = i >> 6, j = i & 63, ii = j & 31; const float inv = powf(10000.f, -(float)ii / 32.f), pos = j < 32 ? (float)(t >> 6) : (float)(t & 63);
        float sv, cv; sincosf(pos * inv, &sv, &cv); c128[i] = cv; s128[i] = sv; }
      float* LAM = (float*)(ws + WS_S5LAM); bf16_t* BB = (bf16_t*)(ws + WS_S5BB); bf16_t* CC = (bf16_t*)(ws + WS_S5CC);
      for (int i = gt; i < 4096; i += NT_) { const int dg = i >> 6, p = i & 63;
        const float lr = a.in[8][i], li = a.in[9][i], dt = expf(a.in[10][dg]);
        const float ar = lr * dt, ai = li * dt, mag = expf(ar); float sv, cv; sincosf(ai, &sv, &cv); const float er = mag * cv, ei = mag * sv;
        const float den = lr * lr + li * li, cr = ((er - 1.f) * lr + ei * li) / den, ci = (ei * lr - (er - 1.f) * li) / den;
        LAM[i * 2] = er; LAM[i * 2 + 1] = ei;
        const int jr = 2 * (p >> 5), colp = p & 31;
        for (int h = 0; h < 16; ++h) { const float br = a.in[11][(size_t)i * 16 + h], bi = a.in[12][(size_t)i * 16 + h];
          BB[((size_t)dg * 128 + 32 * jr + colp) * 16 + h] = f2bf(cr * br - ci * bi); BB[((size_t)dg * 128 + 32 * (jr + 1) + colp) * 16 + h] = f2bf(cr * bi + ci * br);
          CC[((size_t)dg * 16 + h) * 128 + 2 * p] = f2bf(a.in[13][((size_t)dg * 16 + h) * 64 + p]); CC[((size_t)dg * 16 + h) * 128 + 2 * p + 1] = f2bf(-a.in[14][((size_t)dg * 16 + h) * 64 + p]); }
      }
    }
  } else if (ph == 1 || ph == 6 || ph == 10 || ph == 14) {
    const int l = ph >= 10 ? 1 : 0, which = (ph == 6 || ph == 14) ? 1 : 0; const bool latonly = ph == 14;
    const float* hc = ph == 1 ? ctx : HC; const float* hl = ph == 1 ? x : HL; bf16_t* XN = (bf16_t*)(ws + WS_XN);
    for (int row = gw; row < TT; row += NGW) {
      const int b = row / RB, pos = row - b * RB; if (latonly && pos < NCTX) continue;
      const float* hr = hrow_ptr(hc, hl, row); const float* md = MODS + ((size_t)l * 17 + (pos < NCTX ? 16 : b)) * 6144 + which * 3 * 1024;
      f32x4 v[4]; float ss = 0.f;
#pragma unroll
      for (int j = 0; j < 4; ++j) { v[j] = *(const f32x4*)(hr + lane * 4 + 256 * j); ss += (v[j][0] * v[j][0] + v[j][1] * v[j][1]) + (v[j][2] * v[j][2] + v[j][3] * v[j][3]); }
      const float rs = rsqrtf(wave_sum64(ss) * (1.f / 1024.f) + EPS_N);
#pragma unroll
      for (int j = 0; j < 4; ++j) { const f32x4 sh = *(const f32x4*)(md + lane * 4 + 256 * j), sc = *(const f32x4*)(md + 1024 + lane * 4 + 256 * j);
        const f32x4 o = v[j] * rs * (sc + 1.f) + sh; u32x2 w; w.x = pk2(o[0], o[1]); w.y = pk2(o[2], o[3]); *(u32x2*)(XN + (size_t)row * 1024 + lane * 4 + 256 * j) = w; }
    }
  } else if (ph == 2 || ph == 5 || ph == 7 || ph == 9 || ph == 11 || ph == 13 || ph == 15 || ph == 17) {
    const int l = ph >= 10 ? 1 : 0;
    if (ph == 7 || ph == 15) {
      Epi<true> E{}; E.kind = EK_UP; E.ws = ws; E.scr = (LAS float*)(L + SCR_OFF); E.cw = a.in[28] + (size_t)l * 3 * FFH; E.cb = a.in[29] + (size_t)l * FFH;
      pg8::Gemm g{(const bf16_t*)(ws + WS_XN), (const bf16_t*)(ws + W_UP + (size_t)l * 5632 * 1024 * 2), 1024};
      if (ph == 7) { SchedFull S; S.so.init(144, 22, G, bx); pg8::gemm_phase<Epi<true>, SchedFull, true>(L, g, S, E); }
      else { SchedLat S; S.so.init(128, 22, G, bx); pg8::gemm_phase<Epi<true>, SchedLat, true>(L, g, S, E); }
    } else {
      Epi<false> E{}; E.ws = ws; E.scr = (LAS float*)(L + SCR_OFF);
      if (ph == 2) { E.kind = EK_INAB; pg8::Gemm g{(const bf16_t*)(ws + WS_XN), (const bf16_t*)(ws + W_INAB), 1024}; SchedFull S; S.so.init(144, 5, G, bx); pg8::gemm_phase<Epi<false>, SchedFull, false>(L, g, S, E); }
      else if (ph == 11) { E.kind = EK_INCD; E.gq = a.in[25]; E.gk = a.in[26]; pg8::Gemm g{(const bf16_t*)(ws + WS_XN), (const bf16_t*)(ws + W_INCD), 1024};
        SchedInCd S; S.so.init(128, 12, G, bx); S.G = G; S.c = bx; pg8::gemm_phase<Epi<false>, SchedInCd, false>(L, g, S, E); }
      else {
        E.kind = EK_RES; const int which = (ph == 9 || ph == 17) ? 1 : 0; E.gate = MODS + (size_t)l * 17 * 6144 + (which * 3 + 2) * 1024;
        E.hin_c = ph == 5 ? ctx : HC; E.hin_l = ph == 5 ? x : HL; E.hout_c = HC; E.hout_l = HL;
        if (ph == 5) { pg8::Gemm g{(const bf16_t*)(ws + R_CAT), (const bf16_t*)(ws + W_OUTAB), 1024}; SchedFull S; S.so.init(144, 4, G, bx); pg8::gemm_phase<Epi<false>, SchedFull, false>(L, g, S, E); }
        else if (ph == 9) { pg8::Gemm g{(const bf16_t*)(ws + R_HH), (const bf16_t*)(ws + W_DN), 2816}; SchedFull S; S.so.init(144, 4, G, bx); pg8::gemm_phase<Epi<false>, SchedFull, false>(L, g, S, E); }
        else if (ph == 13) { pg8::Gemm g{(const bf16_t*)(ws + R_CAT1), (const bf16_t*)(ws + W_OUTCD), 1024}; SchedLat S; S.so.init(128, 4, G, bx); pg8::gemm_phase<Epi<false>, SchedLat, false>(L, g, S, E); }
        else { pg8::Gemm g{(const bf16_t*)(ws + R_HH), (const bf16_t*)(ws + W_DN + (size_t)1024 * 2816 * 2), 2816}; SchedLat S; S.so.init(128, 4, G, bx); pg8::gemm_phase<Epi<false>, SchedLat, false>(L, g, S, E); }
      }
    }
  } else if (ph == 3) {
    if (bx < 64) { const int id = bx * 8 + wave; s5_wave(ws, a.in[15], id & 31, id >> 5, L + wave * 8704, lane); }
    else {
      Epi<false> E{}; E.ws = ws; E.scr = (LAS float*)(L + SCR_OFF);
      { E.kind = EK_Q; pg8::Gemm g{(const bf16_t*)(ws + R_CQ), (const bf16_t*)(ws + W_UQ), 384}; SchedFull S; S.so.init(144, 3, G - 64, bx - 64); pg8::gemm_phase<Epi<false>, SchedFull, false>(L, g, S, E); }
      { E.kind = EK_KV; pg8::Gemm g{(const bf16_t*)(ws + R_CKV), (const bf16_t*)(ws + W_UKV), 256}; SchedFull S; S.so.init(144, 4, G - 64, bx - 64); pg8::gemm_phase<Epi<false>, SchedFull, false>(L, g, S, E); }
    }
  } else if (ph == 4) {
    const bf16_t* Q = (const bf16_t*)(ws + R_Q); const bf16_t* Kb = (const bf16_t*)(ws + R_K); const bf16_t* Vb = (const bf16_t*)(ws + R_V); bf16_t* CAT = (bf16_t*)(ws + R_CAT);
#pragma unroll 1
    for (int k = 0; k < 2; ++k) { const int u = vcu + 256 * k, bh = u >> 3, qb = u & 7, b = bh >> 2, h = bh & 3; const size_t r0 = (size_t)b * RB + NCTX + 256 * qb;
      att::attn_unit<192, 0, 0, 768, 768, 512, 1024, 0>(Q + r0 * 768 + 192 * h, Kb + (size_t)b * RB * 768 + 192 * h, Vb + (size_t)b * RB * 512 + 128 * h, CAT + r0 * 1024 + 512 + 128 * h, RB, (char*)lds, 0, 0.f, 0.f, nullptr); }
    if (vcu >= 64 && vcu < 128) { const int bh = vcu - 64, b = bh >> 2, h = bh & 3; const size_t r0 = (size_t)b * RB;
      att::attn_unit<192, 0, 0, 768, 768, 512, 1024, 0>(Q + r0 * 768 + 192 * h, Kb + r0 * 768 + 192 * h, Vb + r0 * 512 + 128 * h, CAT + r0 * 1024 + 512 + 128 * h, NCTX, (char*)lds, 0, 0.f, 0.f, nullptr); }
    Epi<false> E{}; E.ws = ws; E.scr = (LAS float*)(L + SCR_OFF); E.kind = EK_GLU; E.bglu = a.in[17];
    pg8::Gemm g{(const bf16_t*)(ws + R_G), (const bf16_t*)(ws + W_GLU), 512}; SchedFull S; S.so.init(144, 2, G, bx); pg8::gemm_phase<Epi<false>, SchedFull, false>(L, g, S, E);
  } else if (ph == 8 || ph == 16) {
    const int l = ph == 16 ? 1 : 0; const float* cw = a.in[28] + (size_t)l * 3 * FFH; bf16_t* HH = (bf16_t*)(ws + R_HH);
    const float* EP = (const float*)(ws + WS_EDGE); const float* EG = EP + EDGE_ARR / 4; const float* EA = EG + EDGE_ARR / 4;
    for (int i = vcu * 512 + tid; i < NBLK128 * 2 * FFH; i += G * 512) { const int j = i % FFH, be = i / FFH, e = be & 1, blk = be >> 1, bi = blk % 18;
      if (l == 1 && bi < 2) continue;
      float cv = EP[i];
      if (e == 0) { if (!(bi == 0 || bi == 2)) cv += cw[j] * EA[((size_t)(blk - 1) * 2 + 1) * FFH + j]; }
      else { if (!(bi == 1 || bi == 17)) cv += cw[2 * FFH + j] * EA[((size_t)(blk + 1) * 2 + 0) * FFH + j]; }
      HH[((size_t)blk * 128 + (e ? 127 : 0)) * FFH + j] = f2bf(gelu_t(cv) * EG[i]); }
  } else if (ph == 12) {
    bf16_t* CAT1 = (bf16_t*)(ws + R_CAT1); const bf16_t* RK = (const bf16_t*)(ws + R_RK); const bf16_t* RV = (const bf16_t*)(ws + R_RV); const bf16_t* RG = (const bf16_t*)(ws + R_RG);
    const bf16_t* GK = (const bf16_t*)(ws + R_GK); const bf16_t* GV = (const bf16_t*)(ws + R_GV);
#pragma unroll 1
    for (int k = 0; k < 2; ++k) { const int u = vcu + 256 * k, bh = u >> 3, qb = u & 7, b = bh >> 2, h = bh & 3; const size_t r0 = (size_t)b * RB + NCTX + 256 * qb, rb = (size_t)b * RB;
      att::attn_unit<128, 0, 1, 1024, 256, 256, 1024, 0>(CAT1 + r0 * 1024 + 512 + 128 * h, GK + rb * 256 + 128 * (h >> 1), GV + rb * 256 + 128 * (h >> 1), CAT1 + r0 * 1024 + 512 + 128 * h, RB, (char*)lds, 0, 0.f, 0.f, nullptr); }
#pragma unroll 1
    for (int k = 0; k < 2; ++k) { const int u = vcu + 256 * k, bh = u >> 3, qb = u & 7, b = bh >> 2, h = bh & 3; const size_t r0 = (size_t)b * RB + NCTX + 256 * qb, rb = (size_t)b * RB;
      const float dl_f = a.in[24][h], dl_b = a.in[24][4 + h]; const float lf2 = __uint_as_float(__builtin_amdgcn_readfirstlane(__float_as_uint(-log1pf(expf(-dl_f)) * LOG2E))), lb2 = __uint_as_float(__builtin_amdgcn_readfirstlane(__float_as_uint(-log1pf(expf(-dl_b)) * LOG2E)));
      att::attn_unit<128, 1, 0, 1024, 512, 512, 1024, 512>(CAT1 + r0 * 1024 + 128 * h, RK + rb * 512 + 128 * h, RV + rb * 512 + 128 * h, CAT1 + r0 * 1024 + 128 * h, RB, (char*)lds, 256 * qb, lf2, lb2, RG + r0 * 512 + 128 * h); }
  } else if (ph == 18) {
    const float* gf = a.in[31];
    for (int row = gw; row < 16 * NLAT; row += NGW) { float* hr = HL + (size_t)row * 1024;
      f32x4 v[4]; float ss = 0.f;
#pragma unroll
      for (int j = 0; j < 4; ++j) { v[j] = *(const f32x4*)(hr + lane * 4 + 256 * j); ss += (v[j][0] * v[j][0] + v[j][1] * v[j][1]) + (v[j][2] * v[j][2] + v[j][3] * v[j][3]); }
      const float rs = rsqrtf(wave_sum64(ss) * (1.f / 1024.f) + EPS_N);
#pragma unroll
      for (int j = 0; j < 4; ++j) *(f32x4*)(hr + lane * 4 + 256 * j) = v[j] * rs * *(const f32x4*)(gf + lane * 4 + 256 * j); }
  }
}

__global__ void __launch_bounds__(NWAVES * 64, 2) mega_fwd(MArgs a) {
  extern __shared__ __attribute__((aligned(16))) unsigned char lds[];
  LAS unsigned char* L = (LAS unsigned char*)lds;
  volatile LAS unsigned* MISC = (volatile LAS unsigned*)(L + MISC_OFF);
  const int tid = threadIdx.x, lane = tid & 63, wave = __builtin_amdgcn_readfirstlane(tid >> 6);
  const int G = gridDim.x, bx = blockIdx.x, vcu = (G % 8 == 0) ? (bx % 8) * (G / 8) + bx / 8 : bx;
  for (int u = tid; u < 64; u += NWAVES * 64) MISC[u] = 0u;
  __syncthreads();
  XcdBarrier bar; bar.bar = (unsigned*)(a.ws + WS_CTL) + 4096; bar.x = 0; bar.st = nullptr;
  const int lo = a.ph_lo, hi = a.ph_hi;
  if (hi - lo > 1) bar = xcd_barrier_post((unsigned*)(a.ws + WS_CTL) + 4096, MISC + 8);
#define RUN(k) do { if (lo <= (k) && (k) < hi) { run_phase<k>(a, lds, tid, lane, wave, G, bx, vcu); if ((k) + 1 < hi) xcd_barrier(bar); } } while (0)
  RUN(0); RUN(1); RUN(2); RUN(3); RUN(4); RUN(5); RUN(6); RUN(7); RUN(8); RUN(9); RUN(10); RUN(11); RUN(12); RUN(13); RUN(14); RUN(15); RUN(16); RUN(17); RUN(18);
#undef RUN
}

#ifndef MK_SINGLE
#define MK_SINGLE 0
#endif
static void mk_launch(void* const* d_in, void* d_out, void* d_ws, hipStream_t stream) {
  static int ok = 0;
  if (!ok) { if (hipFuncSetAttribute((const void*)mega_fwd, hipFuncAttributeMaxDynamicSharedMemorySize, LDS_BYTES) != hipSuccess) { fprintf(stderr, "hipFuncSetAttribute failed\n"); return; } ok = 1; }
  (void)hipMemsetAsync((char*)d_ws + WS_CTL, 0, CTL_BYTES, stream);
  MArgs a{}; for (int i = 0; i < 32; ++i) a.in[i] = (const float*)d_in[i]; a.out = (float*)d_out; a.ws = (unsigned char*)d_ws;
  if (MK_SINGLE) { a.ph_lo = 0; a.ph_hi = 19; hipLaunchKernelGGL(mega_fwd, dim3(256), dim3(512), LDS_BYTES, stream, a); }
  else for (int p = 0; p < 19; ++p) { a.ph_lo = p; a.ph_hi = p + 1; hipLaunchKernelGGL(mega_fwd, dim3(256), dim3(512), LDS_BYTES, stream, a); }
}
extern "C" void kernel_launch(void* const* d_in, const int* in_sizes, int n_in, void* d_out, int out_size, void* d_ws, size_t ws_size, hipStream_t stream) {
  if (ws_size < WS_END) { fprintf(stderr, "kernel_launch: workspace too small (%zu < %zu)\n", ws_size, (size_t)WS_END); return; }
  mk_launch(d_in, d_out, d_ws, stream);
}
```

```cpp
#include <hip/hip_runtime.h>
#include <cstdio>
#include <cstdint>

#define LAS __attribute__((address_space(3)))
#define GAS __attribute__((address_space(1)))
typedef unsigned short bf16_t;
typedef short bf16x8 __attribute__((ext_vector_type(8)));
typedef short s16x4 __attribute__((ext_vector_type(4)));
typedef float f32x2 __attribute__((ext_vector_type(2)));
typedef float f32x4 __attribute__((ext_vector_type(4)));
typedef float f32x16 __attribute__((ext_vector_type(16)));
typedef unsigned u32x2 __attribute__((ext_vector_type(2)));
typedef unsigned u32x4 __attribute__((ext_vector_type(4)));
typedef __bf16 bf16x2_t __attribute__((ext_vector_type(2)));

constexpr int TT = 36864;
constexpr int DMODEL = 1024, RB = 2304, NCTX = 256, NLAT = 2048, FFH = 2816, NBLK128 = TT / 128;
constexpr float EPS_N = 1e-6f, LOG2E = 1.4426950408889634f;

__device__ __forceinline__ unsigned pk2(float lo, float hi) { f32x2 v = {lo, hi}; bf16x2_t b = __builtin_convertvector(v, bf16x2_t); return __builtin_bit_cast(unsigned, b); }
__device__ __forceinline__ float bflo(unsigned u) { return __uint_as_float(u << 16); }
__device__ __forceinline__ float bfhi(unsigned u) { return __uint_as_float(u & 0xffff0000u); }
__device__ __forceinline__ float bf1(bf16_t h) { return __uint_as_float(((unsigned)h) << 16); }
__device__ __forceinline__ bf16_t f2bf(float f) { return (bf16_t)(pk2(f, 0.f) & 0xffffu); }
__device__ __forceinline__ void store8(bf16_t* p, const f32x4& a, const f32x4& b) { u32x4 w; w.x = pk2(a[0], a[1]); w.y = pk2(a[2], a[3]); w.z = pk2(b[0], b[1]); w.w = pk2(b[2], b[3]); *(u32x4*)p = w; }
__device__ __forceinline__ float fast_sigmoid(float x) { return __builtin_amdgcn_rcpf(1.f + __builtin_amdgcn_exp2f(-LOG2E * x)); }
__device__ __forceinline__ float gelu_t(float x) { const float u = x + 0.044715f * x * x * x; return x * __builtin_amdgcn_rcpf(1.f + __builtin_amdgcn_exp2f(-2.302208198f * u)); }
__device__ __forceinline__ float silu_t(float x) { return x * fast_sigmoid(x); }
__device__ __forceinline__ float wave_sum64(float v) {
#pragma unroll
  for (int o = 1; o < 64; o <<= 1) v += __shfl_xor(v, o);
  return v;
}

constexpr size_t MiB = 1u << 20;
constexpr size_t WS_CTL = 0, CTL_BYTES = 32768;
constexpr size_t WS_MODS = 1 * MiB;
constexpr size_t WS_R64C = 2 * MiB, WS_R64S = WS_R64C + 2048 * 32 * 4, WS_R128C = WS_R64S + 2048 * 32 * 4, WS_R128S = WS_R128C + 2048 * 64 * 4;
constexpr size_t WS_S5LAM = 3 * MiB + 512 * 1024;
constexpr size_t WS_PS = 5 * MiB;
constexpr size_t WS_EDGE = 11 * MiB, EDGE_ARR = (size_t)NBLK128 * 2 * FFH * 4;
constexpr size_t WS_S5PB = WS_EDGE, WS_S5MR = WS_S5PB + (size_t)32 * 256 * 256 * 2;
static_assert(WS_S5MR + (size_t)32 * 256 * 512 * 2 <= WS_EDGE + 3 * EDGE_ARR, "s5 matrices");
constexpr size_t WS_W = 31 * MiB;
constexpr size_t W_INAB = WS_W, W_OUTAB = W_INAB + 1280 * 1024 * 2, W_GLU = W_OUTAB + 1024 * 1024 * 2, W_UQ = W_GLU + 512 * 512 * 2, W_UKV = W_UQ + 768 * 384 * 2,
                 W_INCD = W_UKV + 1024 * 256 * 2, W_OUTCD = W_INCD + 3072 * 1024 * 2, W_UP = W_OUTCD + 1024 * 1024 * 2, W_DN = W_UP + 2 * (size_t)5632 * 1024 * 2, W_END = W_DN + 2 * (size_t)1024 * 2816 * 2;
static_assert(W_END <= 79 * MiB, "weights");
constexpr size_t WS_HB = 79 * MiB;
constexpr size_t WS_XN = 151 * MiB;
constexpr size_t WS_R = 223 * MiB;
constexpr size_t R_A5 = WS_R, R_CQ = R_A5 + (size_t)32 * 2304 * 512 * 2, R_CKV = R_CQ + (size_t)TT * 384 * 2, R_CAT = WS_R;
constexpr size_t R_Q = WS_R + 117 * MiB, R_K = R_Q + (size_t)TT * 768 * 2, R_V = R_K + (size_t)TT * 768 * 2, R_G = R_CQ, R_END0 = R_V + (size_t)TT * 512 * 2;
constexpr size_t R_HH = WS_R;
constexpr size_t R_CAT1 = WS_R, R_RK = R_CAT1 + (size_t)TT * 1024 * 2, R_RV = R_RK + (size_t)TT * 512 * 2, R_RG = R_RV + (size_t)TT * 512 * 2, R_GK = R_RG + (size_t)TT * 512 * 2, R_GV = R_GK + (size_t)TT * 256 * 2, R_ST = R_GV + (size_t)TT * 256 * 2;
constexpr size_t WS_END = WS_R + 261 * MiB;
static_assert(R_G + (size_t)TT * 512 * 2 <= R_Q && R_CKV + (size_t)TT * 256 * 2 <= R_Q && R_END0 <= WS_END && R_HH + (size_t)TT * FFH * 2 <= WS_END && R_ST + (size_t)16 * 4 * 2 * 8 * 16384 * 2 <= WS_END && WS_END <= 512 * MiB, "ws map");

namespace pg8 {
constexpr int BM = 256, BK = 64, HALF = 128, HTB = HALF * BK * 2, STAGE_BYTES = 8 * HTB, NXCD = 8, WGM = 8;
__host__ __device__ __forceinline__ int lds_byte(int r, int c) { const int st = (r >> 4) * 2 + (c >> 5), rr = r & 15, cc = c & 31, ob = rr * 64 + cc * 2; return st * 1024 + (ob ^ (((ob >> 9) & 1) << 5)); }
__host__ __device__ __forceinline__ void stage_rc(int b, int& R, int& C) { const int st = b / 1024, sb = b % 1024, swz = sb ^ (((sb >> 9) & 1) << 5); R = (st >> 1) * 16 + swz / 64; C = (st & 1) * 32 + (swz % 64) / 2; }
__host__ __device__ __forceinline__ int perm32(int rho) { const int n = rho >> 4, i = rho & 15; return 8 * (i >> 2) + 4 * n + (i & 3); }
struct Unit { int pm, pn; };
struct Gemm { const bf16_t* A; const bf16_t* Bt; int K; int lda; };
struct StaticOrder {
    int nM, nN, nwg, G, c;
    __host__ __device__ void init(int nM_, int nN_, int G_, int c_) { nM = nM_; nN = nN_; nwg = nM * nN; G = G_; c = c_; }
    __host__ __device__ bool next(int i, Unit& u) const {
        const long L = (long)i * G + c; if (L >= nwg) return false;
        int wgid = (int)L; { const int q = nwg / NXCD, r = nwg % NXCD, xcd = wgid % NXCD, off = wgid / NXCD; wgid = (xcd < r ? xcd * (q + 1) : r * (q + 1) + (xcd - r) * q) + off; }
        const int nig = WGM * nN, gid = wgid / nig, fm = gid * WGM, gsz = (nM - fm) < WGM ? (nM - fm) : WGM;
        u.pm = fm + ((wgid % nig) % gsz); u.pn = (wgid % nig) / gsz; return true;
    }
};
template <class Epi, class Sched, bool APERM, bool ABLK = false>
__device__ __forceinline__ void gemm_phase(LAS unsigned char* lds, const Gemm g, const Sched& S, const Epi& E) {
    const int tid = threadIdx.x, wid = __builtin_amdgcn_readfirstlane(tid >> 6), lane = tid & 63, wr = wid >> 2, wc = wid & 3, fr = lane & 15, fq = lane >> 4;
    const int K = g.K, nt = K / BK, lda = g.lda;
    unsigned voffA[2], voffB[2];
#pragma unroll
    for (int i = 0; i < 2; ++i) { int R, C; stage_rc(tid * 16 + i * 8192, R, C); const int Rb = (R & ~31) + perm32(R & 31);
        const int Ra = APERM ? (128 * (R >> 6) + 8 * (R & 15) + ((R >> 4) & 3)) : R;
        voffA[i] = ABLK ? (unsigned)(((C >> 5) * TT + Ra) * 32 + (C & 31)) * 2u : (unsigned)(Ra * lda + C) * 2u; voffB[i] = (unsigned)(Rb * K + C) * 2u; }
    const size_t kstep = (size_t)(BK * 2), kstepA = ABLK ? (size_t)2 * TT * 32 * 2 : kstep;
    const size_t hstepB = (size_t)HALF * K * 2, hstepA = ABLK ? (size_t)HALF * 32 * 2 : APERM ? (size_t)4 * lda * 2 : (size_t)HALF * lda * 2;
    const size_t tstep = (size_t)256 * K * 2, tstepA = ABLK ? (size_t)256 * 32 * 2 : (size_t)256 * lda * 2;
    const unsigned ldsw = (unsigned)wid * 1024u;
    const int aoff = lds_byte(wr * 64 + fr, fq * 8), boff = lds_byte(wc * 32 + fr, fq * 8);
#define PG8_SA(b, h) (((b) * 2 + (h)) * HTB)
#define PG8_SB(b, h) ((4 + (b) * 2 + (h)) * HTB)
#define PG8_STAGE(bufoff, gbase, voff) do { _Pragma("unroll") for (int _i = 0; _i < 2; ++_i) \
        __builtin_amdgcn_global_load_lds((const unsigned*)((const char*)(gbase) + (voff)[_i]), (LAS unsigned*)(lds + (bufoff) + ldsw + _i * 8192), 16, 0, 0); } while (0)
#define PG8_LDA(dst, b, h) do { _Pragma("unroll") for (int m = 0; m < 4; ++m) _Pragma("unroll") for (int k = 0; k < 2; ++k) dst[m][k] = *(const LAS bf16x8*)(lds + PG8_SA(b, h) + aoff + m * 2048 + k * 1024); } while (0)
#define PG8_LDB(dst, b, h) do { _Pragma("unroll") for (int n = 0; n < 2; ++n) _Pragma("unroll") for (int k = 0; k < 2; ++k) dst[n][k] = *(const LAS bf16x8*)(lds + PG8_SB(b, h) + boff + n * 2048 + k * 1024); } while (0)
#define PG8_MMA(ai, bj, At, Bt) do { __builtin_amdgcn_s_setprio(1); _Pragma("unroll") for (int m = 0; m < 4; ++m) _Pragma("unroll") for (int n = 0; n < 2; ++n) _Pragma("unroll") for (int k = 0; k < 2; ++k) \
        acc[ai][bj][m][n] = __builtin_amdgcn_mfma_f32_16x16x32_bf16(Bt[n][k], At[m][k], acc[ai][bj][m][n], 0, 0, 0); __builtin_amdgcn_s_setprio(0); } while (0)
#define PG8_WAIT_V(n) asm volatile("s_waitcnt vmcnt(" #n ")" ::: "memory")
#define PG8_WAIT_L(n) asm volatile("s_waitcnt lgkmcnt(" #n ")" ::: "memory")
#define PG8_BAR __builtin_amdgcn_s_barrier()
#define PG8_SCHED __builtin_amdgcn_sched_barrier(0)
    Unit cur, nxt; int ui = 0;
    if (!S.next(0, cur)) return;
    f32x4 acc[2][2][4][2];
#pragma unroll
    for (int a = 0; a < 2; ++a)
#pragma unroll
        for (int b = 0; b < 2; ++b)
#pragma unroll
            for (int m = 0; m < 4; ++m)
#pragma unroll
                for (int n = 0; n < 2; ++n) acc[a][b][m][n] = (f32x4){0.f, 0.f, 0.f, 0.f};
    bf16x8 At[4][2], B0[2][2], B1[2][2];
    const char* cA = (const char*)g.A + (size_t)cur.pm * tstepA; const char* cB = (const char*)g.Bt + (size_t)cur.pn * tstep;
    if constexpr (Epi::PREFETCH) E.prefetch(cur, 0);
    PG8_STAGE(PG8_SB(0, 0), cB, voffB); PG8_STAGE(PG8_SB(0, 1), cB + hstepB, voffB); PG8_STAGE(PG8_SA(0, 0), cA, voffA); PG8_STAGE(PG8_SA(0, 1), cA + hstepA, voffA);
    if (wr == 1) PG8_BAR;
    PG8_WAIT_V(2); PG8_BAR;
    PG8_STAGE(PG8_SB(1, 0), cB + kstep, voffB); PG8_STAGE(PG8_SA(1, 0), cA + kstepA, voffA); PG8_STAGE(PG8_SB(1, 1), cB + hstepB + kstep, voffB);
    PG8_WAIT_V(6); PG8_BAR;
    for (;;) {
        const bool has_next = S.next(ui + 1, nxt);
        const char* nA = has_next ? (const char*)g.A + (size_t)nxt.pm * tstepA : cA; const char* nB = has_next ? (const char*)g.Bt + (size_t)nxt.pn * tstep : cB;
        for (int t = 0; t < nt; t += 2) {
            const bool last = (t == nt - 2);
            const char* a1 = cA + (size_t)(t + 1) * kstepA;
            const char* a2 = last ? nA : cA + (size_t)(t + 2) * kstepA; const char* b2 = last ? nB : cB + (size_t)(t + 2) * kstep;
            const char* a3 = a2 + kstepA; const char* b3 = b2 + kstep;
            PG8_LDB(B0, 0, 0); PG8_LDB(B1, 0, 1); PG8_SCHED; PG8_LDA(At, 0, 0); PG8_STAGE(PG8_SA(1, 1), a1 + hstepA, voffA);
            PG8_WAIT_V(8); PG8_WAIT_L(0); PG8_BAR; PG8_MMA(0, 0, At, B0); PG8_MMA(0, 1, At, B1); PG8_BAR; PG8_SCHED;
            PG8_LDA(At, 0, 1); PG8_STAGE(PG8_SB(0, 0), b2, voffB); PG8_STAGE(PG8_SB(0, 1), b2 + hstepB, voffB); PG8_STAGE(PG8_SA(0, 0), a2, voffA);
            PG8_WAIT_V(8); PG8_WAIT_L(0); PG8_BAR; PG8_MMA(1, 0, At, B0); PG8_MMA(1, 1, At, B1); PG8_BAR; PG8_SCHED;
            PG8_LDB(B0, 1, 0); PG8_LDB(B1, 1, 1); PG8_SCHED; PG8_LDA(At, 1, 0); PG8_STAGE(PG8_SA(0, 1), a2 + hstepA, voffA);
            PG8_WAIT_V(8); PG8_WAIT_L(0); PG8_BAR; PG8_MMA(0, 0, At, B0); PG8_MMA(0, 1, At, B1); PG8_BAR; PG8_SCHED;
            PG8_LDA(At, 1, 1); PG8_STAGE(PG8_SB(1, 0), b3, voffB); PG8_STAGE(PG8_SB(1, 1), b3 + hstepB, voffB); PG8_STAGE(PG8_SA(1, 0), a3, voffA);
            PG8_WAIT_V(8); PG8_WAIT_L(0); PG8_BAR; PG8_MMA(1, 0, At, B0); PG8_MMA(1, 1, At, B1); PG8_BAR; PG8_SCHED;
        }
        if (wr == 0) PG8_BAR;
        if constexpr (Epi::PREFETCH) { if (has_next) E.prefetch(nxt, (ui + 1) & 1); }
        E(acc, cur, wr, wc, fr, fq, ui & 1);
        if (!has_next) break;
#pragma unroll
        for (int a = 0; a < 2; ++a)
#pragma unroll
            for (int b = 0; b < 2; ++b)
#pragma unroll
                for (int m = 0; m < 4; ++m)
#pragma unroll
                    for (int n = 0; n < 2; ++n) acc[a][b][m][n] = (f32x4){0.f, 0.f, 0.f, 0.f};
        cur = nxt; cA = nA; cB = nB; ++ui;
        if (wr == 1) PG8_BAR;
    }
    PG8_WAIT_V(0);
    PG8_BAR;
#undef PG8_SA
#undef PG8_SB
#undef PG8_STAGE
#undef PG8_LDA
#undef PG8_LDB
#undef PG8_MMA
#undef PG8_WAIT_V
#undef PG8_WAIT_L
#undef PG8_BAR
#undef PG8_SCHED
}
}
struct MArgs { const float* in[32]; float* out; unsigned char* ws; int ph_lo, ph_hi; };

struct SchedFull { pg8::StaticOrder so; __device__ __forceinline__ bool next(int i, pg8::Unit& u) const { return so.next(i, u); } };
struct SchedLat {
    pg8::StaticOrder so;
    __device__ __forceinline__ bool next(int i, pg8::Unit& u) const { if (!so.next(i, u)) return false; u.pm = (u.pm >> 3) * 9 + 1 + (u.pm & 7); return true; }
};
struct SchedInCd {
    pg8::StaticOrder so; int G, c;
    __device__ __forceinline__ bool next(int i, pg8::Unit& u) const {
        const int L = i * G + c;
        if (L < 1536) { so.next(i, u); u.pm = (u.pm >> 3) * 9 + 1 + (u.pm & 7); return true; }
        const int L2 = L - 1536; if (L2 >= 96) return false;
        const int q = L2 % 6; u.pm = (L2 / 6) * 9; u.pn = q < 4 ? 2 + q : 6 + q; return true;
    }
};

enum { EK_INAB = 0, EK_Q, EK_KV, EK_GLU, EK_RES, EK_UP, EK_INCD, EK_S5E, EK_S5Y };
struct SchedS5 { int G, c; __device__ __forceinline__ bool next(int i, pg8::Unit& u) const { const int L = i * G + c; if (L >= 288) return false; u.pm = L; u.pn = L / 9; return true; } };
template <bool UPK> struct Epi {
    static constexpr bool PREFETCH = UPK;
    int kind;
    unsigned char* ws;
    LAS float* scr;
    const float* hin_c; const float* hin_l; const float* gate;
    const float* cw; const float* cb;
    const float* bglu;
    const float* gq; const float* gk;

    __device__ __forceinline__ void prefetch(const pg8::Unit& u, int buf) const {
        const int t = threadIdx.x, arr = t >> 7, col = t & 127; const float* src = (arr < 3 ? cw + arr * FFH : cb) + u.pn * 128 + col;
        const int wv = __builtin_amdgcn_readfirstlane(t >> 6);
        __builtin_amdgcn_global_load_lds((const unsigned*)src, (LAS unsigned*)(scr + buf * 512 + wv * 64), 4, 0, 0);
    }
    __device__ __forceinline__ void operator()(const f32x4 (&acc)[2][2][4][2], const pg8::Unit& u, int wr, int wc, int fr, int fq, int buf) const {
        const int jt = u.pm % 9, bb = u.pm / 9; const bool lat = jt != 0;
        const int rloc0 = wr * 64 + fr;
        if (!UPK && kind == EK_INAB) {
            bf16_t* A5 = (bf16_t*)(ws + R_A5); bf16_t* CQ = (bf16_t*)(ws + R_CQ); bf16_t* CKV = (bf16_t*)(ws + R_CKV); bf16_t* Kb = (bf16_t*)(ws + R_K);
            float* PS = (float*)(ws + WS_PS); const float* cs = (const float*)(ws + WS_R64C); const float* sn = (const float*)(ws + WS_R64S);
#pragma unroll
            for (int bj = 0; bj < 2; ++bj) {
                const int cbase = u.pn * 256 + bj * 128 + wc * 32;
                if (cbase >= 1216) continue;
                const int c0 = cbase + 8 * fq;
#pragma unroll
                for (int ai = 0; ai < 2; ++ai)
#pragma unroll
                    for (int m = 0; m < 4; ++m) {
                        const int rl = ai * 128 + m * 16 + rloc0; const size_t row = (size_t)u.pm * 256 + rl;
                        f32x4 v0 = acc[ai][bj][m][0], v1 = acc[ai][bj][m][1];
                        if (cbase < 512) { const int pos = jt * 256 + rl; store8(A5 + ((size_t)(c0 >> 4) * 2304 + bb * 144 + (pos >> 4)) * 512 + (pos & 15) * 16 + (c0 & 15), v0, v1); }
                        else if (cbase < 1152) {
                            float s = (v0[0] * v0[0] + v0[1] * v0[1]) + (v0[2] * v0[2] + v0[3] * v0[3]) + (v1[0] * v1[0] + v1[1] * v1[1]) + (v1[2] * v1[2] + v1[3] * v1[3]);
                            s += __shfl_xor(s, 16); s += __shfl_xor(s, 32);
                            if (fq == 0) PS[row * 40 + (cbase >> 5)] = s;
                            if (cbase < 896) store8(CQ + row * 384 + (c0 - 512), v0, v1); else store8(CKV + row * 256 + (c0 - 896), v0, v1);
                        } else {
                            const int wcc = (cbase - 1152) >> 5;
                            if (lat) {
                                const int t = (jt - 1) * 256 + rl;
                                const f32x4 ca = *(const f32x4*)(cs + t * 32 + wcc * 16 + 8 * (fq & 1)), cb2 = *(const f32x4*)(cs + t * 32 + wcc * 16 + 8 * (fq & 1) + 4);
                                const f32x4 sa = *(const f32x4*)(sn + t * 32 + wcc * 16 + 8 * (fq & 1)), sb2 = *(const f32x4*)(sn + t * 32 + wcc * 16 + 8 * (fq & 1) + 4);
                                f32x4 p0, p1;
#pragma unroll
                                for (int j = 0; j < 4; ++j) { p0[j] = __shfl_xor(v0[j], 32); p1[j] = __shfl_xor(v1[j], 32); }
                                const float sg = (fq < 2) ? -1.f : 1.f;
#pragma unroll
                                for (int j = 0; j < 4; ++j) { v0[j] = v0[j] * ca[j] + sg * p0[j] * sa[j]; v1[j] = v1[j] * cb2[j] + sg * p1[j] * sb2[j]; }
                            }
#pragma unroll
                            for (int h = 0; h < 4; ++h) store8(Kb + row * 768 + h * 192 + 128 + wcc * 32 + 8 * fq, v0, v1);
                        }
                    }
            }
        } else if (!UPK && (kind == EK_Q || kind == EK_KV)) {
            const float* PS = (const float*)(ws + WS_PS);
            bf16_t* Q = (bf16_t*)(ws + R_Q); const float* cs = (const float*)(ws + WS_R64C); const float* sn = (const float*)(ws + WS_R64S);
            bf16_t* Kb = (bf16_t*)(ws + R_K); bf16_t* Vb = (bf16_t*)(ws + R_V);
#pragma unroll
            for (int ai = 0; ai < 2; ++ai)
#pragma unroll
                for (int m = 0; m < 4; ++m) {
                    const int rl = ai * 128 + m * 16 + rloc0; const size_t row = (size_t)u.pm * 256 + rl; float rsc;
                    if (kind == EK_Q) { const f32x4 a = *(const f32x4*)(PS + row * 40 + 16), b = *(const f32x4*)(PS + row * 40 + 20), c = *(const f32x4*)(PS + row * 40 + 24);
                        const float s = ((a[0] + a[1]) + (a[2] + a[3])) + ((b[0] + b[1]) + (b[2] + b[3])) + ((c[0] + c[1]) + (c[2] + c[3])); rsc = rsqrtf(s * (1.f / 384.f) + EPS_N); }
                    else { const f32x4 a = *(const f32x4*)(PS + row * 40 + 28), b = *(const f32x4*)(PS + row * 40 + 32);
                        const float s = ((a[0] + a[1]) + (a[2] + a[3])) + ((b[0] + b[1]) + (b[2] + b[3])); rsc = rsqrtf(s * (1.f / 256.f) + EPS_N); }
#pragma unroll
                    for (int bj = 0; bj < 2; ++bj) {
                        f32x4 v0 = acc[ai][bj][m][0] * rsc, v1 = acc[ai][bj][m][1] * rsc;
                        if (kind == EK_Q) {
                            const int cbase = u.pn * 256 + bj * 128 + wc * 32, d0 = cbase % 192; const bool rp = d0 >= 128; const int wcc = (d0 - 128) >> 5;
                            if (rp && lat) {
                                const int t = (jt - 1) * 256 + rl; const int to = t * 32 + wcc * 16 + 8 * (fq & 1); const float sg = (fq < 2) ? -1.f : 1.f;
                                { const f32x4 ca = *(const f32x4*)(cs + to), sa = *(const f32x4*)(sn + to);
#pragma unroll
                                  for (int j = 0; j < 4; ++j) { const float pp = __shfl_xor(v0[j], 32); v0[j] = v0[j] * ca[j] + sg * pp * sa[j]; } }
                                { const f32x4 ca = *(const f32x4*)(cs + to + 4), sa = *(const f32x4*)(sn + to + 4);
#pragma unroll
                                  for (int j = 0; j < 4; ++j) { const float pp = __shfl_xor(v1[j], 32); v1[j] = v1[j] * ca[j] + sg * pp * sa[j]; } }
                            }
                            store8(Q + row * 768 + cbase + 8 * fq, v0, v1);
                        } else {
                            if (bj == 0) store8(Kb + row * 768 + u.pn * 192 + wc * 32 + 8 * fq, v0, v1); else store8(Vb + row * 512 + u.pn * 128 + wc * 32 + 8 * fq, v0, v1);
                        }
                    }
                    __builtin_amdgcn_sched_barrier(0);
                }
        } else if (!UPK && kind == EK_GLU) {
            const bf16_t* G = (const bf16_t*)(ws + R_G); bf16_t* CAT = (bf16_t*)(ws + R_CAT);
#pragma unroll
            for (int bj = 0; bj < 2; ++bj) {
                const int c0 = u.pn * 256 + bj * 128 + wc * 32 + 8 * fq; const f32x4 b0 = *(const f32x4*)(bglu + c0), b1 = *(const f32x4*)(bglu + c0 + 4);
#pragma unroll
                for (int ai = 0; ai < 2; ++ai)
#pragma unroll
                    for (int m = 0; m < 4; ++m) { const size_t row = (size_t)u.pm * 256 + ai * 128 + m * 16 + rloc0;
                        const u32x4 gw = *(const u32x4*)(G + row * 512 + c0); f32x4 v0 = acc[ai][bj][m][0] + b0, v1 = acc[ai][bj][m][1] + b1;
                        v0[0] = bflo(gw.x) * fast_sigmoid(v0[0]); v0[1] = bfhi(gw.x) * fast_sigmoid(v0[1]); v0[2] = bflo(gw.y) * fast_sigmoid(v0[2]); v0[3] = bfhi(gw.y) * fast_sigmoid(v0[3]);
                        v1[0] = bflo(gw.z) * fast_sigmoid(v1[0]); v1[1] = bfhi(gw.z) * fast_sigmoid(v1[1]); v1[2] = bflo(gw.w) * fast_sigmoid(v1[2]); v1[3] = bfhi(gw.w) * fast_sigmoid(v1[3]);
                        store8(CAT + row * 1024 + c0, v0, v1); }
            }
        } else if (!UPK && kind == EK_RES) {
            const float* hi_ = lat ? hin_l + ((size_t)bb * NLAT + (jt - 1) * 256) * DMODEL : hin_c + (size_t)bb * NCTX * DMODEL;
            bf16_t* HB = (bf16_t*)(ws + WS_HB) + (size_t)u.pm * 256 * DMODEL; const bool first = hin_l != nullptr;
            const float* gt = gate + (size_t)(lat ? bb : 16) * 6144;
#pragma unroll
            for (int bj = 0; bj < 2; ++bj) {
                const int c0 = u.pn * 256 + bj * 128 + wc * 32 + 8 * fq; const f32x4 g0 = *(const f32x4*)(gt + c0), g1 = *(const f32x4*)(gt + c0 + 4);
#pragma unroll
                for (int ai = 0; ai < 2; ++ai)
#pragma unroll
                    for (int m = 0; m < 4; ++m) { const size_t off = (size_t)(ai * 128 + m * 16 + rloc0) * DMODEL + c0; f32x4 h0, h1;
                        if (first) { h0 = *(const f32x4*)(hi_ + off); h1 = *(const f32x4*)(hi_ + off + 4); }
                        else { const u32x4 hw = *(const u32x4*)(HB + off); h0 = (f32x4){bflo(hw.x), bfhi(hw.x), bflo(hw.y), bfhi(hw.y)}; h1 = (f32x4){bflo(hw.z), bfhi(hw.z), bflo(hw.w), bfhi(hw.w)}; }
                        store8(HB + off, h0 + g0 * acc[ai][bj][m][0], h1 + g1 * acc[ai][bj][m][1]); }
            }
        } else if (UPK) {
            bf16_t* HH = (bf16_t*)(ws + R_HH); float* EP = (float*)(ws + WS_EDGE); float* EG = EP + EDGE_ARR / 4; float* EA = EG + EDGE_ARR / 4;
            const int jc = u.pn * 128 + wc * 32 + 8 * fq;
            float w0[8], w1[8], w2[8], cbv[8], pvv[8], nxx[8]; const LAS float* cl = scr + buf * 512 + wc * 32 + 8 * fq;
#pragma unroll
            for (int c = 0; c < 8; ++c) { w0[c] = cl[c]; w1[c] = cl[128 + c]; w2[c] = cl[256 + c]; cbv[c] = cl[384 + c];
                const float pv_ = __shfl_up(acc[1][0][3][c >> 2][c & 3], 1, 16), nx_ = __shfl_down(acc[0][0][0][c >> 2][c & 3], 1, 16);
                pvv[c] = fr == 0 ? 0.f : pv_; nxx[c] = fr == 15 ? 0.f : nx_; }
            const size_t tok0 = (size_t)u.pm * 256 + wr * 128 + 8 * fr; const int blk = 2 * u.pm + wr;
#pragma unroll
            for (int ai = 0; ai < 2; ++ai)
#pragma unroll
                for (int m = 0; m < 4; ++m) {
                    const int idx = 4 * ai + m; float hv[8], av[8], gv[8];
#pragma unroll
                    for (int c = 0; c < 8; ++c) { const int n = c >> 2, jj = c & 3;
                        const float cur = acc[ai][0][m][n][jj];
                        const float prev = idx == 0 ? pvv[c] : (m > 0 ? acc[ai][0][m - 1][n][jj] : acc[0][0][3][n][jj]);
                        const float next = idx == 7 ? nxx[c] : (m < 3 ? acc[ai][0][m + 1][n][jj] : acc[1][0][0][n][jj]);
                        const float cv = cbv[c] + w0[c] * prev + w1[c] * cur + w2[c] * next;
                        av[c] = cur; gv[c] = acc[ai][1][m][n][jj]; hv[c] = cv; }
                    const bool edge0 = (idx == 0 && fr == 0), edge1 = (idx == 7 && fr == 15);
                    if (edge0 || edge1) { const size_t eo = ((size_t)blk * 2 + (edge1 ? 1 : 0)) * FFH + jc;
#pragma unroll
                        for (int c = 0; c < 8; ++c) { EP[eo + c] = hv[c]; EG[eo + c] = gv[c]; EA[eo + c] = av[c]; }
                    } else { f32x4 o0, o1;
#pragma unroll
                        for (int c = 0; c < 4; ++c) { o0[c] = gelu_t(hv[c]) * gv[c]; o1[c] = gelu_t(hv[4 + c]) * gv[4 + c]; }
                        store8(HH + ((size_t)(u.pn * 4 + wc) * TT + tok0 + idx) * 32 + 8 * fq, o0, o1); }
                }
        } else if (!UPK && kind == EK_S5E) {
            float* E = (float*)(ws + WS_XN);
#pragma unroll
            for (int bj = 0; bj < 2; ++bj)
#pragma unroll
                for (int ai = 0; ai < 2; ++ai)
#pragma unroll
                    for (int m = 0; m < 4; ++m) { float* d = E + ((size_t)u.pm * 256 + ai * 128 + m * 16 + rloc0) * 256 + bj * 128 + wc * 32 + 8 * fq;
                        *(f32x4*)d = acc[ai][bj][m][0]; *(f32x4*)(d + 4) = acc[ai][bj][m][1]; }
        } else if (!UPK && kind == EK_S5Y) {
            bf16_t* G = (bf16_t*)(ws + R_G); const int g = u.pn, j9 = u.pm - 9 * g;
#pragma unroll
            for (int bj = 0; bj < 2; ++bj) { const int n0 = bj * 128 + wc * 32 + 8 * fq, t = n0 >> 4, h0 = n0 & 15;
#pragma unroll
                for (int ai = 0; ai < 2; ++ai)
#pragma unroll
                    for (int m = 0; m < 4; ++m) { const int cr = j9 * 256 + ai * 128 + m * 16 + rloc0, b = cr / 144, c = cr - b * 144;
                        f32x4 v0 = acc[ai][bj][m][0], v1 = acc[ai][bj][m][1];
#pragma unroll
                        for (int q = 0; q < 4; ++q) { v0[q] = gelu_t(v0[q]); v1[q] = gelu_t(v1[q]); }
                        store8(G + ((size_t)b * RB + 16 * c + t) * 512 + 16 * g + h0, v0, v1); } }
        } else if (!UPK && kind == EK_INCD) {
            const int pn = u.pn; const int grp = pn < 2 ? 0 : pn < 4 ? 1 : pn < 6 ? 2 : pn < 8 ? 3 : pn < 10 ? 4 : pn == 10 ? 5 : 6;
            const bool roped = (grp == 0 || grp == 1 || grp == 4 || grp == 5), hnorm = (grp == 4 || grp == 5);
            bf16_t* CAT1 = (bf16_t*)(ws + R_CAT1); const float* cs = (const float*)(ws + WS_R128C); const float* sn = (const float*)(ws + WS_R128S);
            float rs[2][2][4];
            if (hnorm) {
#pragma unroll
                for (int bj = 0; bj < 2; ++bj)
#pragma unroll
                    for (int ai = 0; ai < 2; ++ai)
#pragma unroll
                        for (int m = 0; m < 4; ++m) { const f32x4 v0 = acc[ai][bj][m][0], v1 = acc[ai][bj][m][1];
                            float s = (v0[0] * v0[0] + v0[1] * v0[1]) + (v0[2] * v0[2] + v0[3] * v0[3]) + (v1[0] * v1[0] + v1[1] * v1[1]) + (v1[2] * v1[2] + v1[3] * v1[3]);
                            s += __shfl_xor(s, 16); s += __shfl_xor(s, 32);
                            if (fq == 0) scr[(((wr * 2 + bj) * 8 + ai * 4 + m) * 16 + fr) * 4 + wc] = s; }
                asm volatile("s_waitcnt lgkmcnt(0)" ::: "memory"); __builtin_amdgcn_s_barrier(); asm volatile("" ::: "memory");
#pragma unroll
                for (int bj = 0; bj < 2; ++bj)
#pragma unroll
                    for (int ai = 0; ai < 2; ++ai)
#pragma unroll
                        for (int m = 0; m < 4; ++m) { const f32x4 p = *(const LAS f32x4*)(scr + (((wr * 2 + bj) * 8 + ai * 4 + m) * 16 + fr) * 4);
                            rs[bj][ai][m] = rsqrtf(((p[0] + p[1]) + (p[2] + p[3])) * (1.f / 128.f) + EPS_N); }
                asm volatile("s_waitcnt lgkmcnt(0)" ::: "memory"); __builtin_amdgcn_s_barrier(); asm volatile("" ::: "memory");
            }
            const int dloc = 32 * wc + 8 * fq;
            bf16_t* dbase; int dld;
            if (grp == 0) { dbase = CAT1; dld = 1024; } else if (grp == 1) { dbase = (bf16_t*)(ws + R_RK); dld = 512; } else if (grp == 2) { dbase = (bf16_t*)(ws + R_RV); dld = 512; }
            else if (grp == 3) { dbase = (bf16_t*)(ws + R_RG); dld = 512; } else if (grp == 4) { dbase = CAT1 + 512; dld = 1024; } else if (grp == 5) { dbase = (bf16_t*)(ws + R_GK); dld = 256; } else { dbase = (bf16_t*)(ws + R_GV); dld = 256; }
            float gw[8];
            if (hnorm) {
#pragma unroll
                for (int c = 0; c < 8; ++c) { const int dp = dloc + c, orig = (dp & 64) + ((dp & 1) ? 32 : 0) + ((dp & 63) >> 1); gw[c] = (grp == 4 ? gq : gk)[orig]; }
            }
#pragma unroll
            for (int bj = 0; bj < 2; ++bj) {
                const int hh = (grp >= 5) ? bj : (pn & 1) * 2 + bj;
#pragma unroll
                for (int ai = 0; ai < 2; ++ai)
#pragma unroll
                    for (int m = 0; m < 4; ++m) {
                        const int rl = ai * 128 + m * 16 + rloc0; const size_t row = (size_t)u.pm * 256 + rl;
                        f32x4 v0 = acc[ai][bj][m][0], v1 = acc[ai][bj][m][1];
                        if (hnorm) { const float r = rs[bj][ai][m];
#pragma unroll
                            for (int c = 0; c < 4; ++c) { v0[c] = v0[c] * r * gw[c]; v1[c] = v1[c] * r * gw[4 + c]; } }
                        if (grp == 1) { v0 = v0 * 0.08838834764831845f; v1 = v1 * 0.08838834764831845f; }
                        if (roped && lat) {
                            const int t = (jt - 1) * 256 + rl; const int ti = t * 64 + 32 * (wc >> 1) + 16 * (wc & 1) + 4 * fq;
                            const f32x4 c4 = *(const f32x4*)(cs + ti), s4 = *(const f32x4*)(sn + ti);
                            f32x4 o0, o1;
                            o0[0] = v0[0] * c4[0] - v0[1] * s4[0]; o0[1] = v0[1] * c4[0] + v0[0] * s4[0]; o0[2] = v0[2] * c4[1] - v0[3] * s4[1]; o0[3] = v0[3] * c4[1] + v0[2] * s4[1];
                            o1[0] = v1[0] * c4[2] - v1[1] * s4[2]; o1[1] = v1[1] * c4[2] + v1[0] * s4[2]; o1[2] = v1[2] * c4[3] - v1[3] * s4[3]; o1[3] = v1[3] * c4[3] + v1[2] * s4[3];
                            v0 = o0; v1 = o1;
                        }
                        bf16_t* dst = dbase + row * dld + 128 * hh + dloc;
                        store8(dst, v0, v1);
                    }
            }
        }
    }
};
namespace att {
constexpr int NW = 8, QBLK = 32, KVBLK = 64;
constexpr float THR = 8.f;
#define SBAR() __builtin_amdgcn_sched_barrier(0)
__device__ __forceinline__ int crow(int r, int hi) { return (r & 3) + 8 * (r >> 2) + 4 * hi; }
__device__ __forceinline__ int v_st(int k, int c) { const int kk = (k & ~0xC) | ((k & 4) << 1) | ((k & 8) >> 1); return ((kk >> 3) * 4 + (c >> 5)) * 512 + ((kk & 7) * 32 + (c & 31)) * 2; }
__device__ __forceinline__ int v_rd_base(int lane) { return ((lane & 3) << 3) | (((lane >> 2) & 3) << 6) | (((lane >> 4) & 1) << 5) | (((lane >> 5) & 1) << 8); }
constexpr int v_rd_off(int d0, int ks, int half) { return d0 * 512 + ks * 4096 + half * 2048; }
template <int OFF> __device__ __forceinline__ s16x4 tr_read(int vb) { s16x4 r; asm volatile("ds_read_b64_tr_b16 %0, %1 offset:%2" : "=&v"(r) : "v"(vb), "i"(OFF) : "memory"); return r; }
template <int D0> __device__ __forceinline__ void pv_one(f32x16& od, int vb, bf16x8 pa0, bf16x8 pa1, bf16x8 pa2, bf16x8 pa3) {
  const s16x4 l0 = tr_read<v_rd_off(D0, 0, 0)>(vb), h0 = tr_read<v_rd_off(D0, 0, 1)>(vb), l1 = tr_read<v_rd_off(D0, 1, 0)>(vb), h1 = tr_read<v_rd_off(D0, 1, 1)>(vb);
  const s16x4 l2 = tr_read<v_rd_off(D0, 2, 0)>(vb), h2 = tr_read<v_rd_off(D0, 2, 1)>(vb), l3 = tr_read<v_rd_off(D0, 3, 0)>(vb), h3 = tr_read<v_rd_off(D0, 3, 1)>(vb);
  asm volatile("s_waitcnt lgkmcnt(0)" ::: "memory"); SBAR();
#define PK(L, H) (bf16x8){L[0], L[1], L[2], L[3], H[0], H[1], H[2], H[3]}
  od = __builtin_amdgcn_mfma_f32_32x32x16_bf16(pa0, PK(l0, h0), od, 0, 0, 0);
  od = __builtin_amdgcn_mfma_f32_32x32x16_bf16(pa1, PK(l1, h1), od, 0, 0, 0);
  od = __builtin_amdgcn_mfma_f32_32x32x16_bf16(pa2, PK(l2, h2), od, 0, 0, 0);
  od = __builtin_amdgcn_mfma_f32_32x32x16_bf16(pa3, PK(l3, h3), od, 0, 0, 0);
#undef PK
}
__device__ __forceinline__ void pv_d0(f32x16* o, int vb, bf16x8 pa0, bf16x8 pa1, bf16x8 pa2, bf16x8 pa3) {
  pv_one<0>(o[0], vb, pa0, pa1, pa2, pa3); pv_one<1>(o[1], vb, pa0, pa1, pa2, pa3); pv_one<2>(o[2], vb, pa0, pa1, pa2, pa3); pv_one<3>(o[3], vb, pa0, pa1, pa2, pa3);
}
__device__ __forceinline__ void pack_p(const f32x16& p0, const f32x16& p1, bf16x8& pa0, bf16x8& pa1, bf16x8& pa2, bf16x8& pa3) {
#define PK4(P, BASE, OUT) do { unsigned a0 = pk2(P[BASE + 0], P[BASE + 1]), a1 = pk2(P[BASE + 2], P[BASE + 3]);   \
    unsigned b0 = pk2(P[BASE + 4], P[BASE + 5]), b1 = pk2(P[BASE + 6], P[BASE + 7]);                              \
    auto r0 = __builtin_amdgcn_permlane32_swap(a0, b0, false, false); auto r1 = __builtin_amdgcn_permlane32_swap(a1, b1, false, false); \
    u32x4 w = {r0[0], r1[0], r0[1], r1[1]}; OUT = __builtin_bit_cast(bf16x8, w); } while (0)
  PK4(p0, 0, pa0); PK4(p0, 8, pa1); PK4(p1, 0, pa2); PK4(p1, 8, pa3);
#undef PK4
}
template <int DQK>
__device__ __forceinline__ void partialSM(f32x16& p0, f32x16& p1, float& m_reg, float& mn, float& alpha) {
  constexpr float SCALE = DQK == 128 ? 0.088388347648318440f : 0.072168783648703220f;
  constexpr float C = SCALE * LOG2E;
  float pmax = p0[0];
#pragma unroll
  for (int r = 1; r < 16; ++r) pmax = fmaxf(pmax, p0[r]);
#pragma unroll
  for (int r = 0; r < 16; ++r) pmax = fmaxf(pmax, p1[r]);
  { auto rr = __builtin_amdgcn_permlane32_swap(__float_as_uint(pmax), __float_as_uint(pmax), false, false);
    pmax = fmaxf(__uint_as_float(rr[0]), __uint_as_float(rr[1])); }
  if (__builtin_expect(__all(pmax - m_reg <= THR / SCALE), 1)) { mn = m_reg; alpha = 1.f; }
  else { mn = fmaxf(m_reg, pmax); alpha = __builtin_amdgcn_exp2f((m_reg - mn) * C); m_reg = mn; }
  const float mnC = -mn * C;
#pragma unroll
  for (int r = 0; r < 16; ++r) p0[r] = fmaf(p0[r], C, mnC);
#pragma unroll
  for (int r = 0; r < 16; ++r) p1[r] = fmaf(p1[r], C, mnC);
#pragma unroll
  for (int r = 0; r < 16; ++r) p0[r] = __builtin_amdgcn_exp2f(p0[r]);
}
__device__ __forceinline__ void finishSM(f32x16& p0, f32x16& p1, float alpha, float& l_reg, bf16x8& pa0, bf16x8& pa1, bf16x8& pa2, bf16x8& pa3) {
#pragma unroll
  for (int r = 0; r < 16; ++r) p1[r] = __builtin_amdgcn_exp2f(p1[r]);
  float ps = 0;
#pragma unroll
  for (int r = 0; r < 16; ++r) ps += p0[r];
#pragma unroll
  for (int r = 0; r < 16; ++r) ps += p1[r];
  { auto rr = __builtin_amdgcn_permlane32_swap(__float_as_uint(ps), __float_as_uint(ps), false, false);
    ps = __uint_as_float(rr[0]) + __uint_as_float(rr[1]); }
  l_reg = l_reg * alpha + ps;
  pack_p(p0, p1, pa0, pa1, pa2, pa3);
}
__device__ __forceinline__ void ret_weights(f32x16& p0, f32x16& p1, int kind, float dnb  , float lf2, float lb2) {
  if (kind == 0) {
    const float a = lf2 * dnb;
#pragma unroll
    for (int r = 0; r < 16; ++r) { const float c = (float)((r & 3) + 8 * (r >> 2));
      p0[r] *= __builtin_amdgcn_exp2f(fmaf(-lf2, c, a)); p1[r] *= __builtin_amdgcn_exp2f(fmaf(-lf2, c + 32.f, a)); }
  } else if (kind == 1) {
    const float a = -lb2 * dnb;
#pragma unroll
    for (int r = 0; r < 16; ++r) { const float c = (float)((r & 3) + 8 * (r >> 2));
      p0[r] *= __builtin_amdgcn_exp2f(fmaf(lb2, c, a)); p1[r] *= __builtin_amdgcn_exp2f(fmaf(lb2, c + 32.f, a)); }
  } else if (kind == 2) {
#pragma unroll
    for (int r = 0; r < 16; ++r) { const float c = (float)((r & 3) + 8 * (r >> 2));
      const float d0 = dnb - c, d1 = dnb - c - 32.f;
      const float w0 = (d0 >= 0.f ? __builtin_amdgcn_exp2f(lf2 * d0) : 0.f) + (d0 <= 0.f ? __builtin_amdgcn_exp2f(-lb2 * d0) : 0.f);
      const float w1 = (d1 >= 0.f ? __builtin_amdgcn_exp2f(lf2 * d1) : 0.f) + (d1 <= 0.f ? __builtin_amdgcn_exp2f(-lb2 * d1) : 0.f);
      p0[r] *= w0; p1[r] *= w1; }
  } else {
#pragma unroll
    for (int r = 0; r < 16; ++r) { const float c = (float)((r & 3) + 8 * (r >> 2));
      const float d0 = dnb - c, d1 = dnb - c - 32.f;
      p0[r] *= __builtin_amdgcn_exp2f(lf2 * d0) + __builtin_amdgcn_exp2f(lb2 * (2304.f - d0));
      p1[r] *= __builtin_amdgcn_exp2f(lf2 * d1) + __builtin_amdgcn_exp2f(lb2 * (2304.f - d1)); }
  }
}

template <int DQK> struct Shm { static constexpr int V = KVBLK * 128 * 2, K = KVBLK * DQK * 2, WSO = 2 * V + 2 * K, TOTAL = WSO + NW * 64 * 4; };

template <int DQK, int MODE, int SDEPTH, int ldq, int ldk, int ldv, int ldo, int ldg>
__device__ __forceinline__ void attn_unit(const bf16_t* Qb, const bf16_t* __restrict__ Kh, const bf16_t* __restrict__ Vh, bf16_t* Ob, int seq, char* lds,
                                          int n0, float lf2, float lb2, const bf16_t* Gb) {
  using SH = Shm<DQK>;
  constexpr int ND = DQK / 16, NKC = DQK / 8, KPT = DQK / 64, NLD = 2 + KPT;
#define KSWZ(row, colB) ((row) * (DQK * 2) + ((colB) ^ (((row) & 7) << 4)))
  int tid_ = threadIdx.x; asm volatile("" : "+v"(tid_));
  const int tid = tid_, wid = tid >> 6, lane = tid & 63, r32 = lane & 31, hi = lane >> 5;
  char* V_lds = lds; char* K_lds = lds + 2 * SH::V;
  float* ws = (float*)(lds + SH::WSO) + wid * 64; float* li_l = ws; float* al_l = ws + 32;
  float m_reg = -1e30f, l_reg = 0; f32x16 o[4] = {}; bf16x8 qr[ND];
  const bf16_t* Qw = Qb + (long)(wid * QBLK + r32) * ldq + hi * 8;
#pragma unroll
  for (int d0 = 0; d0 < ND; ++d0) qr[d0] = *reinterpret_cast<const bf16x8*>(Qw + d0 * 16);
  const int sr = tid >> 4, sc = (tid & 15) * 8, vst0 = v_st(sr, sc), vst1 = v_st(32 + sr, sc);
  int krow[KPT], kcol[KPT];
#pragma unroll
  for (int i = 0; i < KPT; ++i) { const int id = tid + 512 * i; krow[i] = id / NKC; kcol[i] = (id % NKC) * 8; }
  const int vb0 = (int)(uintptr_t)V_lds + v_rd_base(lane);
  struct { bf16x8 vs0, vs1, ks[KPT]; } sr_[SDEPTH == 0 ? 1 : SDEPTH];
  constexpr int SE = 0, SO = SDEPTH == 2 ? 1 : 0;
#define SLOAD(i, k0) do { sr_[i].vs0 = *reinterpret_cast<const bf16x8*>(&Vh[(long)((k0) + sr) * ldv + sc]); sr_[i].vs1 = *reinterpret_cast<const bf16x8*>(&Vh[(long)((k0) + 32 + sr) * ldv + sc]); \
    _Pragma("unroll") for (int q_ = 0; q_ < KPT; ++q_) sr_[i].ks[q_] = *reinterpret_cast<const bf16x8*>(&Kh[(long)((k0) + krow[q_]) * ldk + kcol[q_]]); } while (0)
#define SWRITE(b, i) do { *(bf16x8*)(V_lds + (b) * SH::V + vst0) = sr_[i].vs0; *(bf16x8*)(V_lds + (b) * SH::V + vst1) = sr_[i].vs1; \
    _Pragma("unroll") for (int q_ = 0; q_ < KPT; ++q_) *(bf16x8*)(K_lds + (b) * SH::K + KSWZ(krow[q_], kcol[q_] * 2)) = sr_[i].ks[q_]; } while (0)
#define SWAIT() do { if constexpr (SDEPTH == 1) asm volatile("s_waitcnt vmcnt(0)" ::: "memory"); else if constexpr (NLD == 4) asm volatile("s_waitcnt vmcnt(4)" ::: "memory"); else asm volatile("s_waitcnt vmcnt(5)" ::: "memory"); } while (0)
#define RESC(a) do { if (__any((a) < 1.f)) { if (hi == 0) al_l[r32] = (a); asm volatile("s_waitcnt lgkmcnt(0)" ::: "memory"); \
    _Pragma("unroll") for (int d = 0; d < 4; ++d) _Pragma("unroll") for (int r = 0; r < 16; ++r) o[d][r] *= al_l[crow(r, hi)]; } } while (0)
#define QKT(P0, P1, Kbuf) do { P0 = f32x16{}; P1 = f32x16{}; _Pragma("unroll") for (int d0 = 0; d0 < ND; ++d0) { const int cb = (d0 * 16 + hi * 8) * 2; \
    const bf16x8 b0 = *reinterpret_cast<const bf16x8*>((Kbuf) + KSWZ(r32, cb)); const bf16x8 b1 = *reinterpret_cast<const bf16x8*>((Kbuf) + KSWZ(32 + r32, cb)); \
    P0 = __builtin_amdgcn_mfma_f32_32x32x16_bf16(b0, qr[d0], P0, 0, 0, 0); P1 = __builtin_amdgcn_mfma_f32_32x32x16_bf16(b1, qr[d0], P1, 0, 0, 0); } } while (0)
  const int qb4 = n0 >> 6;
  const float nlane = (float)(n0 + wid * QBLK + r32 - 4 * hi);
#define TKIND(tj) ((tj) < 4 ? 3 : ((tj) - 4 < qb4 ? 0 : ((tj) - 4 >= qb4 + 4 ? 1 : 2)))
#define PART(P0, P1, tj, MN, AL) do { if constexpr (MODE == 0) partialSM<DQK>(P0, P1, m_reg, MN, AL); else ret_weights(P0, P1, TKIND(tj), nlane - (float)(64 * (tj) - 256), lf2, lb2); } while (0)
#define FIN(P0, P1, AL) do { if constexpr (MODE == 0) finishSM(P0, P1, AL, l_reg, pa0, pa1, pa2, pa3); else pack_p(P0, P1, pa0, pa1, pa2, pa3); } while (0)
  f32x16 pA0, pA1, pB0, pB1; float mnA = 0.f, mnB = 0.f, alA = 1.f, alB = 1.f; bf16x8 pa0, pa1, pa2, pa3; const int NT = seq / KVBLK;
  if constexpr (SDEPTH == 0) {
    SLOAD(0, 0); asm volatile("s_waitcnt vmcnt(0)" ::: "memory"); SWRITE(0, 0); __syncthreads();
    if (__builtin_amdgcn_readfirstlane(wid) >= 4) __builtin_amdgcn_s_setprio(2);
#pragma unroll 1
    for (int j = 0; j < NT; ++j) {
      const int bsel = j & 1;
      if (j + 1 < NT) SLOAD(0, (j + 1) * KVBLK);
      SBAR(); QKT(pA0, pA1, K_lds + bsel * SH::K);
      PART(pA0, pA1, j, mnA, alA);
      if constexpr (MODE == 0) RESC(alA);
      FIN(pA0, pA1, alA); SBAR();
      pv_d0(o, vb0 + bsel * SH::V, pa0, pa1, pa2, pa3);
      if (j + 1 < NT) { asm volatile("s_waitcnt vmcnt(0)" ::: "memory"); SWRITE(bsel ^ 1, 0); }
      __syncthreads();
    }
    __builtin_amdgcn_s_setprio(0);
  } else {
    SLOAD(SE, 0); asm volatile("s_waitcnt vmcnt(0)" ::: "memory"); SWRITE(0, SE); __syncthreads();
    QKT(pA0, pA1, K_lds); PART(pA0, pA1, 0, mnA, alA);
    SLOAD(SO, KVBLK); if constexpr (SDEPTH == 2) { if (2 < NT) SLOAD(SE, 2 * KVBLK); }
    SWAIT(); SWRITE(1, SO); __syncthreads();
#pragma unroll 1
    for (int j = 1; j + 1 < NT; j += 2) {
      SBAR(); QKT(pB0, pB1, K_lds + SH::K);
      FIN(pA0, pA1, alA); SBAR();
      SLOAD(SO, (j + SDEPTH) * KVBLK); SBAR();
      pv_d0(o, vb0, pa0, pa1, pa2, pa3); PART(pB0, pB1, j, mnB, alB);
      __syncthreads(); SWAIT(); SWRITE(0, SE);
      if constexpr (MODE == 0) RESC(alB);
      __syncthreads();
      SBAR(); QKT(pA0, pA1, K_lds);
      FIN(pB0, pB1, alB); SBAR();
      if (SDEPTH == 1 || j + 3 < NT) SLOAD(SE, (j + 1 + SDEPTH) * KVBLK); SBAR();
      pv_d0(o, vb0 + SH::V, pa0, pa1, pa2, pa3); PART(pA0, pA1, j + 1, mnA, alA);
      __syncthreads(); SWAIT(); SWRITE(1, SO);
      if constexpr (MODE == 0) RESC(alA);
      __syncthreads();
    }
    SBAR(); QKT(pB0, pB1, K_lds + SH::K);
    FIN(pA0, pA1, alA); SBAR();
    pv_d0(o, vb0, pa0, pa1, pa2, pa3); PART(pB0, pB1, NT - 1, mnB, alB);
    __syncthreads();
    if constexpr (MODE == 0) RESC(alB);
    FIN(pB0, pB1, alB); SBAR();
    pv_d0(o, vb0 + SH::V, pa0, pa1, pa2, pa3);
  }
  bf16_t* Ow = Ob + (long)(wid * QBLK) * ldo;
  if constexpr (MODE == 0) {
    if (hi == 0) li_l[r32] = l_reg; asm volatile("s_waitcnt lgkmcnt(0)" ::: "memory");
    float rli[16];
#pragma unroll
    for (int r = 0; r < 16; ++r) rli[r] = __builtin_amdgcn_rcpf(li_l[crow(r, hi)]);
    __syncthreads();
    bf16_t* stg = (bf16_t*)(lds + wid * 8192);
#pragma unroll
    for (int r = 0; r < 16; ++r) { const int orow = crow(r, hi);
#pragma unroll
      for (int d0 = 0; d0 < 4; ++d0) stg[orow * 128 + d0 * 32 + r32] = f2bf(o[d0][r] * rli[r]); }
    asm volatile("s_waitcnt lgkmcnt(0)" ::: "memory");
#pragma unroll
    for (int i = 0; i < 8; ++i) { const int row = i * 4 + (lane >> 4), ch = lane & 15; const u32x4 v = *(const u32x4*)(stg + row * 128 + ch * 8); *(u32x4*)(Ow + (long)row * ldo + ch * 8) = v; }
  } else {
    const bf16_t* Gw = Gb + (long)(wid * QBLK) * ldg;
#pragma unroll
    for (int r = 0; r < 16; ++r) {
      float ss = (o[0][r] * o[0][r] + o[1][r] * o[1][r]) + (o[2][r] * o[2][r] + o[3][r] * o[3][r]);
#pragma unroll
      for (int off = 1; off < 32; off <<= 1) ss += __shfl_xor(ss, off);
      const float rs = rsqrtf(ss * (1.f / 128.f) + EPS_N); const int orow = crow(r, hi);
#pragma unroll
      for (int d0 = 0; d0 < 4; ++d0) { const float g = bf1(Gw[(long)orow * ldg + d0 * 32 + r32]); Ow[(long)orow * ldo + d0 * 32 + r32] = f2bf(o[d0][r] * rs * silu_t(g)); }
      SBAR();
    }
  }
  __syncthreads();
#undef KSWZ
#undef SLOAD
#undef SWRITE
#undef SWAIT
#undef RESC
#undef QKT
#undef TKIND
#undef PART
#undef FIN
}

__device__ __forceinline__ void ret_state_unit(const bf16_t* __restrict__ Kh, const bf16_t* __restrict__ Vh, bf16_t* ST  , int dir, int hf  , float l2, char* lds) {
  int tid_ = threadIdx.x; asm volatile("" : "+v"(tid_));
  const int tid = tid_, wid = tid >> 6, lane = tid & 63, r32 = lane & 31, hi = lane >> 5, d0k = wid & 3, dvp = wid >> 2;
  constexpr int SHV = KVBLK * 128 * 2; char* K_lds = lds; char* V_lds = lds + 2 * SHV;
  const int sr = tid >> 4, sc = (tid & 15) * 8, vst0 = v_st(sr, sc), vst1 = v_st(32 + sr, sc);
  const float w0 = dir ? __builtin_amdgcn_exp2f(l2 * (float)sr) : __builtin_amdgcn_exp2f(l2 * (float)(63 - sr)), w1 = dir ? __builtin_amdgcn_exp2f(l2 * (float)(32 + sr)) : __builtin_amdgcn_exp2f(l2 * (float)(31 - sr));
  const float dec64 = __builtin_amdgcn_exp2f(64.f * l2);
  const int kb = (int)(uintptr_t)K_lds + v_rd_base(lane) + d0k * 512, vb = (int)(uintptr_t)V_lds + v_rd_base(lane) + (2 * hf + dvp) * 512;
  f32x16 o0 = {};
  bf16x8 ks0, ks1, vs0, vs1;
#define RS_TILE(s) (dir ? ((s) < 4 ? 3 - (s) : 39 - (s)) : (s))
#define RS_LOAD(s) do { const long k0 = 64L * RS_TILE(s); ks0 = *reinterpret_cast<const bf16x8*>(&Kh[(k0 + sr) * 512 + sc]); ks1 = *reinterpret_cast<const bf16x8*>(&Kh[(k0 + 32 + sr) * 512 + sc]); \
    vs0 = *reinterpret_cast<const bf16x8*>(&Vh[(k0 + sr) * 512 + sc]); vs1 = *reinterpret_cast<const bf16x8*>(&Vh[(k0 + 32 + sr) * 512 + sc]); } while (0)
#define RS_SCALE(VV, SCL) do { const u32x4 u_ = __builtin_bit_cast(u32x4, VV); u32x4 r_; r_[0] = pk2(bflo(u_[0]) * (SCL), bfhi(u_[0]) * (SCL)); r_[1] = pk2(bflo(u_[1]) * (SCL), bfhi(u_[1]) * (SCL)); \
    r_[2] = pk2(bflo(u_[2]) * (SCL), bfhi(u_[2]) * (SCL)); r_[3] = pk2(bflo(u_[3]) * (SCL), bfhi(u_[3]) * (SCL)); VV = __builtin_bit_cast(bf16x8, r_); } while (0)
#define RS_WRITE(b) do { *(bf16x8*)(K_lds + (b) * SHV + vst0) = ks0; *(bf16x8*)(K_lds + (b) * SHV + vst1) = ks1; RS_SCALE(vs0, w0); RS_SCALE(vs1, w1); \
    *(bf16x8*)(V_lds + (b) * SHV + vst0) = vs0; *(bf16x8*)(V_lds + (b) * SHV + vst1) = vs1; } while (0)
  RS_LOAD(0); asm volatile("s_waitcnt vmcnt(0)" ::: "memory"); RS_WRITE(0); __syncthreads();
#pragma unroll 1
  for (int s = 0; s < 36; ++s) {
    const int bsel = s & 1;
    if (s + 1 < 36) RS_LOAD(s + 1);
    if (s >= 4 && ((s - 4) & 3) == 0) {
      const int uq = dir ? 7 - ((s - 4) >> 2) : ((s - 4) >> 2); bf16_t* dst = ST + (size_t)uq * 16384 + (size_t)(32 * d0k) * 128 + 32 * (2 * hf + dvp) + r32;
#pragma unroll
      for (int r = 0; r < 16; ++r) { const int row = crow(r, hi); dst[row * 128] = f2bf(o0[r]); }
    }
#pragma unroll
    for (int r = 0; r < 16; ++r) o0[r] *= dec64;
    const int kbb = kb + bsel * SHV, vbb = vb + bsel * SHV;
#define RS_STEP(KS) do { const s16x4 al = tr_read<(KS) * 4096>(kbb), ah = tr_read<(KS) * 4096 + 2048>(kbb); \
      const s16x4 b0l = tr_read<(KS) * 4096>(vbb), b0h = tr_read<(KS) * 4096 + 2048>(vbb); \
      asm volatile("s_waitcnt lgkmcnt(0)" ::: "memory"); SBAR(); \
      const bf16x8 af = (bf16x8){al[0], al[1], al[2], al[3], ah[0], ah[1], ah[2], ah[3]}; \
      o0 = __builtin_amdgcn_mfma_f32_32x32x16_bf16(af, (bf16x8){b0l[0], b0l[1], b0l[2], b0l[3], b0h[0], b0h[1], b0h[2], b0h[3]}, o0, 0, 0, 0); } while (0)
    RS_STEP(0); RS_STEP(1); RS_STEP(2); RS_STEP(3);
#undef RS_STEP
    if (s + 1 < 36) { asm volatile("s_waitcnt vmcnt(0)" ::: "memory"); RS_WRITE(bsel ^ 1); }
    __syncthreads();
  }
#undef RS_TILE
#undef RS_LOAD
#undef RS_SCALE
#undef RS_WRITE
}

__device__ __forceinline__ void ret_out_unit(bf16_t* Qb  , const bf16_t* __restrict__ Kh, const bf16_t* __restrict__ Vh, const bf16_t* __restrict__ Sf, const bf16_t* __restrict__ Sb,
                                             const bf16_t* Gb, float lf2, float lb2, char* lds) {
  using SH = Shm<128>;
  int tid_ = threadIdx.x; asm volatile("" : "+v"(tid_));
  const int tid = tid_, wid = tid >> 6, lane = tid & 63, r32 = lane & 31, hi = lane >> 5;
  char* V_lds = lds; char* K_lds = lds + 2 * SH::V;
  f32x16 o[4] = {}; bf16x8 qr[8];
  const bf16_t* Qw = Qb + (long)(wid * QBLK + r32) * 1024 + hi * 8;
#pragma unroll
  for (int d0 = 0; d0 < 8; ++d0) qr[d0] = *reinterpret_cast<const bf16x8*>(Qw + d0 * 16);
  const int sr = tid >> 4, sc = (tid & 15) * 8, vst0 = v_st(sr, sc), vst1 = v_st(32 + sr, sc);
  const int vb0 = (int)(uintptr_t)V_lds + v_rd_base(lane);
  const float nrel = (float)(wid * QBLK + r32), nlane = nrel - 4.f * (float)hi;
  const float ff = __builtin_amdgcn_exp2f(lf2 * (nrel + 1.f)), fb = __builtin_amdgcn_exp2f(lb2 * (256.f - nrel));
  bf16x8 vs0, vs1, ks0, ks1;
#define KSWZ(row, colB) ((row) * 256 + ((colB) ^ (((row) & 7) << 4)))
#define RO_LOAD(j) do { if ((j) < 4) { const long k0 = 64L * (j); vs0 = *reinterpret_cast<const bf16x8*>(&Vh[(k0 + sr) * 512 + sc]); vs1 = *reinterpret_cast<const bf16x8*>(&Vh[(k0 + 32 + sr) * 512 + sc]); \
      ks0 = *reinterpret_cast<const bf16x8*>(&Kh[(k0 + sr) * 512 + sc]); ks1 = *reinterpret_cast<const bf16x8*>(&Kh[(k0 + 32 + sr) * 512 + sc]); } \
    else { const bf16_t* S_ = ((j) < 6 ? Sf : Sb) + (size_t)(((j) & 1) * 64) * 128; vs0 = *reinterpret_cast<const bf16x8*>(&S_[sr * 128 + sc]); vs1 = *reinterpret_cast<const bf16x8*>(&S_[(32 + sr) * 128 + sc]); } } while (0)
#define RO_WRITE(b, j) do { *(bf16x8*)(V_lds + (b) * SH::V + vst0) = vs0; *(bf16x8*)(V_lds + (b) * SH::V + vst1) = vs1; \
    if ((j) < 4) { *(bf16x8*)(K_lds + (b) * SH::K + KSWZ(sr, sc * 2)) = ks0; *(bf16x8*)(K_lds + (b) * SH::K + KSWZ(32 + sr, sc * 2)) = ks1; } } while (0)
#define RO_SCALE(QQ, SCL) ({ const u32x4 u_ = __builtin_bit_cast(u32x4, QQ); u32x4 r_; r_[0] = pk2(bflo(u_[0]) * (SCL), bfhi(u_[0]) * (SCL)); r_[1] = pk2(bflo(u_[1]) * (SCL), bfhi(u_[1]) * (SCL)); \
    r_[2] = pk2(bflo(u_[2]) * (SCL), bfhi(u_[2]) * (SCL)); r_[3] = pk2(bflo(u_[3]) * (SCL), bfhi(u_[3]) * (SCL)); __builtin_bit_cast(bf16x8, r_); })
  RO_LOAD(0); asm volatile("s_waitcnt vmcnt(0)" ::: "memory"); RO_WRITE(0, 0); __syncthreads();
#pragma unroll 1
  for (int j = 0; j < 8; ++j) {
    const int bsel = j & 1; bf16x8 pa0, pa1, pa2, pa3;
    if (j + 1 < 8) RO_LOAD(j + 1);
    if (j < 4) {
      f32x16 p0 = {}, p1 = {}; const char* Kbuf = K_lds + bsel * SH::K;
#pragma unroll
      for (int d0 = 0; d0 < 8; ++d0) { const int cb = (d0 * 16 + hi * 8) * 2;
        const bf16x8 b0 = *reinterpret_cast<const bf16x8*>(Kbuf + KSWZ(r32, cb)); const bf16x8 b1 = *reinterpret_cast<const bf16x8*>(Kbuf + KSWZ(32 + r32, cb));
        p0 = __builtin_amdgcn_mfma_f32_32x32x16_bf16(b0, qr[d0], p0, 0, 0, 0); p1 = __builtin_amdgcn_mfma_f32_32x32x16_bf16(b1, qr[d0], p1, 0, 0, 0); }
      ret_weights(p0, p1, 2, nlane - (float)(64 * j), lf2, lb2);
      pack_p(p0, p1, pa0, pa1, pa2, pa3);
    } else {
      const float w = j < 6 ? ff : fb; const bool od = (j & 1) != 0;
      if (od) { pa0 = RO_SCALE(qr[4], w); pa1 = RO_SCALE(qr[5], w); pa2 = RO_SCALE(qr[6], w); pa3 = RO_SCALE(qr[7], w); }
      else { pa0 = RO_SCALE(qr[0], w); pa1 = RO_SCALE(qr[1], w); pa2 = RO_SCALE(qr[2], w); pa3 = RO_SCALE(qr[3], w); }
    }
    SBAR();
    pv_d0(o, vb0 + bsel * SH::V, pa0, pa1, pa2, pa3);
    if (j + 1 < 8) { asm volatile("s_waitcnt vmcnt(0)" ::: "memory"); RO_WRITE(bsel ^ 1, j + 1); }
    __syncthreads();
  }
  bf16_t* Ow = Qb + (long)(wid * QBLK) * 1024; const bf16_t* Gw = Gb + (long)(wid * QBLK) * 512;
#pragma unroll
  for (int r = 0; r < 16; ++r) {
    float ss = (o[0][r] * o[0][r] + o[1][r] * o[1][r]) + (o[2][r] * o[2][r] + o[3][r] * o[3][r]);
#pragma unroll
    for (int off = 1; off < 32; off <<= 1) ss += __shfl_xor(ss, off);
    const float rs = rsqrtf(ss * (1.f / 128.f) + EPS_N); const int orow = crow(r, hi);
#pragma unroll
    for (int d0 = 0; d0 < 4; ++d0) { const float g = bf1(Gw[(long)orow * 512 + d0 * 32 + r32]); Ow[(long)orow * 1024 + d0 * 32 + r32] = f2bf(o[d0][r] * rs * silu_t(g)); }
    SBAR();
  }
  __syncthreads();
#undef KSWZ
#undef RO_LOAD
#undef RO_WRITE
#undef RO_SCALE
}
#undef SBAR
}
constexpr int NWAVES = 8;
constexpr int RING_BYTES = 131072, SCR_OFF = RING_BYTES, MISC_OFF = SCR_OFF + 8192, LDS_BYTES = 147456;

__device__ __forceinline__ void s5_chunk_scan(unsigned char* ws, int g, int b, int dir, int p) {
  const float* E = (const float*)(ws + WS_XN) + ((size_t)g * 2304 + (size_t)b * 144) * 256 + dir * 128 + 2 * p;
  bf16_t* A5 = (bf16_t*)(ws + R_A5) + ((size_t)g * 2304 + (size_t)b * 144) * 512 + 256 + dir * 128 + 2 * p;
  const float* LAM = (const float*)(ws + WS_S5LAM) + ((size_t)(dir * 32 + g) * 64 + p) * 2; const float lr = LAM[0], li = LAM[1];
  float sr = 0.f, si = 0.f;
#define S5_CH(sig) (dir ? ((sig) < 16 ? 15 - (sig) : 159 - (sig)) : (sig))
#pragma unroll 1
  for (int s0 = 0; s0 < 144; s0 += 16) { f32x2 e[16];
#pragma unroll
    for (int q = 0; q < 16; ++q) e[q] = *(const f32x2*)(E + (size_t)S5_CH(s0 + q) * 256);
#pragma unroll
    for (int q = 0; q < 16; ++q) { *(unsigned*)(A5 + (size_t)S5_CH(s0 + q) * 512) = pk2(sr, si);
      const float nr = lr * sr - li * si + e[q][0], ni = lr * si + li * sr + e[q][1]; sr = nr; si = ni; } }
#undef S5_CH
}

#define XB_TMO      128
#define XB_XCNT(j)  (256  + 64 * (j))
#define XB_XSUB(j)  (1280 + 64 * (j))
#define XB_XGEN(j)  (2304 + 64 * (j))
#define XB_TOP      3328
#define XB_TOPGEN   3392
#define XB_SPIN_CAP (1u << 22)
__device__ __forceinline__ unsigned xb_ld(unsigned* p)              { return __hip_atomic_load(p, __ATOMIC_RELAXED, __HIP_MEMORY_SCOPE_AGENT); }
__device__ __forceinline__ unsigned xb_add(unsigned* p, unsigned v) { return __hip_atomic_fetch_add(p, v, __ATOMIC_RELAXED, __HIP_MEMORY_SCOPE_AGENT); }
__device__ __forceinline__ unsigned xb_xcc_id() { return (unsigned)__builtin_amdgcn_s_getreg((3 << 11) | 20) & 0xFu; }
#define XB_SPIN(cond, bar) do { unsigned _sp = 0; while (cond) { __builtin_amdgcn_s_sleep(1); \
    if ((++_sp & 255u) == 0u) { if (xb_ld(&(bar)[XB_TMO])) break; if (_sp > XB_SPIN_CAP) { atomicAdd(&(bar)[XB_TMO], 1u); break; } } } } while (0)
struct XcdBarrier { unsigned* bar; unsigned x; volatile LAS unsigned* st; };
__device__ __forceinline__ XcdBarrier xcd_barrier_post(unsigned* bar, volatile LAS unsigned* st) {
    XcdBarrier b; b.bar = bar; b.x = xb_xcc_id(); b.st = st;
    if (threadIdx.x == 0) (void)xb_add(&bar[XB_XCNT(b.x)], 1u);
    return b;
}
__device__ __forceinline__ void xcd_barrier_complete(unsigned* bar, unsigned x, unsigned& nloc, unsigned& nx) {
    const unsigned G = gridDim.x * gridDim.y * gridDim.z;
    unsigned sum, cnt, mine, sp = 0u;
    for (;;) {
        sum = 0u; cnt = 0u; mine = 0u;
#pragma unroll
        for (unsigned j = 0; j < 16; ++j) { const unsigned c = xb_ld(&bar[XB_XCNT(j)]); sum += c; cnt += (c > 0u) ? 1u : 0u; mine = (j == x) ? c : mine; }
        if (sum == G) break;
        __builtin_amdgcn_s_sleep(1);
        if ((++sp & 255u) == 0u) { if (xb_ld(&bar[XB_TMO])) break; if (sp > XB_SPIN_CAP) { atomicAdd(&bar[XB_TMO], 1u); break; } }
    }
    nloc = mine > 0u ? mine : 1u; nx = cnt > 0u ? cnt : 1u;
}
__device__ __forceinline__ void xcd_barrier(const XcdBarrier& b) {
    asm volatile("s_waitcnt vmcnt(0)" ::: "memory");
    __syncthreads();
    if (threadIdx.x == 0) {
        unsigned* bar = b.bar;
        __builtin_amdgcn_s_waitcnt(0);
        unsigned nloc = b.st[0], nx = b.st[1];
        if (nloc == 0u) { xcd_barrier_complete(bar, b.x, nloc, nx); b.st[0] = nloc; b.st[1] = nx; }
        const unsigned old = xb_add(&bar[XB_XSUB(b.x)], 1u);
        const unsigned gen = old / nloc;
        if (old + 1u == (gen + 1u) * nloc) {
            __builtin_amdgcn_fence(__ATOMIC_RELEASE, "agent");
            asm volatile("s_waitcnt vmcnt(0)" ::: "memory");
            const unsigned og = xb_add(&bar[XB_TOP], 1u);
            const unsigned tg = og / nx;
            if (og + 1u == (tg + 1u) * nx) xb_add(&bar[XB_TOPGEN], 1u);
            else XB_SPIN(xb_ld(&bar[XB_TOPGEN]) == tg, bar);
            __builtin_amdgcn_fence(__ATOMIC_ACQUIRE, "agent");
            xb_add(&bar[XB_XGEN(b.x)], 1u);
            asm volatile("s_waitcnt vmcnt(0)" ::: "memory");
        } else {
            XB_SPIN(xb_ld(&bar[XB_XGEN(b.x)]) == gen, bar);
            __builtin_amdgcn_fence(__ATOMIC_ACQUIRE, "agent");
            asm volatile("s_waitcnt vmcnt(0)" ::: "memory");
        }
    }
    __syncthreads();
}

__device__ __forceinline__ int wt_src(int map, int n, int Nsrc) {
  if (map == 1) { const bool roped = (n < 1024) || (n >= 2048 && n < 2816); if (!roped) return n; const int hb = n & ~127, dp = n & 127; return hb + (dp & 64) + ((dp & 1) ? 32 : 0) + ((dp & 63) >> 1); }
  if (map == 2) { const int pn = n >> 8, bj = (n >> 7) & 1, jj = n & 127; return bj * FFH + 128 * pn + jj; }
  return n < Nsrc ? n : -1;
}
__device__ __forceinline__ void wt_item(const float* W, int K, int Nsrc, int Ndst, bf16_t* WT, int map, const float* kscale, LAS float* scr, int item, int lane) {
  const int nblk = Ndst / 32, kb = item / nblk, nb = item % nblk, k0 = 64 * kb, n0 = 32 * nb;
  const int src = wt_src(map, n0 + (lane & 31), Nsrc);
  float wv[32];
  const float* Wp = W + (size_t)(k0 + (lane >> 5)) * Nsrc + (src >= 0 ? src : 0);
#pragma unroll
  for (int i = 0; i < 32; ++i) wv[i] = Wp[(size_t)(2 * i) * Nsrc];
#pragma unroll
  for (int i = 0; i < 32; ++i) { const int kk = 2 * i + (lane >> 5); float v = src >= 0 ? wv[i] : 0.f; if (kscale) v *= kscale[k0 + kk]; scr[kk * 33 + (lane & 31)] = v; }
  asm volatile("s_waitcnt lgkmcnt(0)" ::: "memory");
  const int c = lane & 7;
#pragma unroll
  for (int j = 0; j < 4; ++j) { const int n = (lane >> 3) + 8 * j; const LAS float* s = scr + (8 * c) * 33 + n;
    u32x4 o; o.x = pk2(s[0 * 33], s[1 * 33]); o.y = pk2(s[2 * 33], s[3 * 33]); o.z = pk2(s[4 * 33], s[5 * 33]); o.w = pk2(s[6 * 33], s[7 * 33]);
    *(u32x4*)(WT + (size_t)(n0 + n) * K + k0 + 8 * c) = o; }
  asm volatile("s_waitcnt lgkmcnt(0)" ::: "memory");
}
__device__ __forceinline__ const float* hrow_ptr(const float* hc, const float* hl, int row) { const int b = row / RB, pos = row - b * RB; return pos < NCTX ? hc + ((size_t)b * NCTX + pos) * DMODEL : hl + ((size_t)b * NLAT + pos - NCTX) * DMODEL; }

__device__ __forceinline__ void fixup_tile(unsigned char* ws, const float* cw, int pm, int l, int tid) {
  bf16_t* HH = (bf16_t*)(ws + R_HH); const float* EP = (const float*)(ws + WS_EDGE); const float* EG = EP + EDGE_ARR / 4; const float* EA = EG + EDGE_ARR / 4;
#pragma unroll 11
  for (int it = 0; it < 22; ++it) { const int idx = tid + it * (NWAVES * 64); const int e4 = idx / FFH, j = idx - e4 * FFH, blk = 2 * pm + (e4 >> 1), e = e4 & 1, bi = blk % 18; const size_t i = ((size_t)blk * 2 + e) * FFH + j;
    if (l == 1 && bi < 2) continue;
    float cv = EP[i];
    if (e == 0) { if (!(bi == 0 || bi == 2)) cv += cw[j] * EA[((size_t)(blk - 1) * 2 + 1) * FFH + j]; }
    else { if (!(bi == 1 || bi == 17)) cv += cw[2 * FFH + j] * EA[((size_t)(blk + 1) * 2 + 0) * FFH + j]; }
    HH[((size_t)(j >> 5) * TT + (size_t)blk * 128 + (e ? 127 : 0)) * 32 + (j & 31)] = f2bf(gelu_t(cv) * EG[i]); }
}
__device__ __forceinline__ void norm_rows(unsigned char* ws, const float* x, const float* ctx, bool first, int l, int which, int sel, int w0, int wstride, int lane) {
  const float* MODS = (const float*)(ws + WS_MODS); const bf16_t* HB = (const bf16_t*)(ws + WS_HB); bf16_t* XN = (bf16_t*)(ws + WS_XN);
  const int nrows = sel == 0 ? TT : sel == 1 ? 16 * NLAT : 16 * NCTX;
  for (int i = w0; i < nrows; i += wstride) {
    int b, pos; if (sel == 0) { b = i / RB; pos = i - b * RB; } else if (sel == 1) { b = i >> 11; pos = NCTX + (i & 2047); } else { b = i >> 8; pos = i & 255; }
    const int row = b * RB + pos;
    const float* md = MODS + ((size_t)l * 17 + (pos < NCTX ? 16 : b)) * 6144 + which * 3 * 1024;
    f32x4 v[4]; float ss = 0.f;
    if (first) { const float* hr = hrow_ptr(ctx, x, row);
#pragma unroll
      for (int j = 0; j < 4; ++j) v[j] = *(const f32x4*)(hr + lane * 4 + 256 * j); }
    else { const bf16_t* hr = HB + (size_t)row * 1024;
#pragma unroll
      for (int j = 0; j < 4; ++j) { const u32x2 w = *(const u32x2*)(hr + lane * 4 + 256 * j); v[j] = (f32x4){bflo(w.x), bfhi(w.x), bflo(w.y), bfhi(w.y)}; } }
#pragma unroll
    for (int j = 0; j < 4; ++j) ss += (v[j][0] * v[j][0] + v[j][1] * v[j][1]) + (v[j][2] * v[j][2] + v[j][3] * v[j][3]);
    const float rs = rsqrtf(wave_sum64(ss) * (1.f / 1024.f) + EPS_N);
#pragma unroll
    for (int j = 0; j < 4; ++j) { const f32x4 sh = *(const f32x4*)(md + lane * 4 + 256 * j), sc = *(const f32x4*)(md + 1024 + lane * 4 + 256 * j);
      const f32x4 o = v[j] * rs * (sc + 1.f) + sh; u32x2 w; w.x = pk2(o[0], o[1]); w.y = pk2(o[2], o[3]); *(u32x2*)(XN + (size_t)row * 1024 + lane * 4 + 256 * j) = w; }
  }
}
struct SchedCtx { int c; __device__ __forceinline__ bool next(int i, pg8::Unit& u) const { if (i > 0) return false; u.pm = 9 * (c >> 2); u.pn = c & 3; return true; } };
template <int ph> __device__ __forceinline__ void run_phase(const MArgs& a, unsigned char* lds, int tid, int lane, int wave, int G, int bx, int vcu) {
  LAS unsigned char* L = (LAS unsigned char*)lds; unsigned char* ws = a.ws;
  const float* x = a.in[0]; const float* ctx = a.in[2];
  float* MODS = (float*)(ws + WS_MODS); const bf16_t* HB = (const bf16_t*)(ws + WS_HB);
  const int gw = vcu * NWAVES + wave, NGW = G * NWAVES;
  if (ph == 0) {
    if (bx < 192) {
      LAS float* cond = (LAS float*)L; LAS float* red = (LAS float*)(L + 17 * 1024 * 4);
      for (int i = tid; i < 17 * 1024; i += NWAVES * 64) { const int r = i >> 10, k = i & 1023; const float v = r < 16 ? a.in[1][r * 1024 + k] : a.in[3][k]; cond[i] = v / (1.f + __expf(-v)); }
      __syncthreads();
      const int l = bx / 96, cc = bx % 96; const float* W = a.in[4] + (size_t)l * 1024 * 6144 + cc * 64 + lane;
      float acc[17];
#pragma unroll
      for (int r = 0; r < 17; ++r) acc[r] = 0.f;
      for (int k0 = wave * 128; k0 < wave * 128 + 128; k0 += 16) { float wv[16];
#pragma unroll
        for (int q = 0; q < 16; ++q) wv[q] = W[(size_t)(k0 + q) * 6144];
#pragma unroll
        for (int q = 0; q < 16; ++q)
#pragma unroll
          for (int r = 0; r < 17; ++r) acc[r] += cond[r * 1024 + k0 + q] * wv[q]; }
#pragma unroll
      for (int r = 0; r < 17; ++r) red[(wave * 17 + r) * 64 + lane] = acc[r];
      __syncthreads();
      for (int i = tid; i < 17 * 64; i += NWAVES * 64) { const int r = i >> 6, c = i & 63; float s = a.in[5][l * 6144 + cc * 64 + c];
#pragma unroll
        for (int w = 0; w < 8; ++w) s += red[(w * 17 + r) * 64 + c];
        MODS[((size_t)l * 17 + r) * 6144 + cc * 64 + c] = s; }
      __syncthreads();
    }
    else if (bx < 224) {
      const int g = bx - 192;
      LAS float* POW = (LAS float*)L; LAS float* BBc = POW + 2 * 17 * 64 * 2; LAS float* CCc = BBc + 2 * 64 * 16 * 2; LAS float* KT = CCc + 2 * 16 * 64 * 2;
      if (tid < 128) { const int d = tid >> 6, p = tid & 63, i = (d * 32 + g) * 64 + p;
        const float lr = a.in[8][i], li = a.in[9][i], dt = expf(a.in[10][d * 32 + g]); const float ar = lr * dt, ai = li * dt;
        for (int k = 0; k <= 16; ++k) { const float mag = expf(ar * (float)k); float sv, cv; sincosf(ai * (float)k, &sv, &cv); POW[((d * 17 + k) * 64 + p) * 2] = mag * cv; POW[((d * 17 + k) * 64 + p) * 2 + 1] = mag * sv; }
        const float er = POW[((d * 17 + 1) * 64 + p) * 2], ei = POW[((d * 17 + 1) * 64 + p) * 2 + 1];
        const float den = lr * lr + li * li, cr = ((er - 1.f) * lr + ei * li) / den, ci = (ei * lr - (er - 1.f) * li) / den;
        for (int h = 0; h < 16; ++h) { const float br = a.in[11][(size_t)i * 16 + h], bi = a.in[12][(size_t)i * 16 + h];
          BBc[((d * 64 + p) * 16 + h) * 2] = cr * br - ci * bi; BBc[((d * 64 + p) * 16 + h) * 2 + 1] = cr * bi + ci * br;
          CCc[((d * 16 + h) * 64 + p) * 2] = a.in[13][((size_t)(d * 32 + g) * 16 + h) * 64 + p]; CCc[((d * 16 + h) * 64 + p) * 2 + 1] = a.in[14][((size_t)(d * 32 + g) * 16 + h) * 64 + p]; }
        float* LAM = (float*)(ws + WS_S5LAM); LAM[(size_t)i * 2] = POW[((d * 17 + 16) * 64 + p) * 2]; LAM[(size_t)i * 2 + 1] = POW[((d * 17 + 16) * 64 + p) * 2 + 1]; }
      __syncthreads();
      for (int e = tid; e < 2 * 16 * 256; e += NWAVES * 64) { const int d = e >> 12, k = (e >> 8) & 15, hp = (e >> 4) & 15, h = e & 15; float s = 0.f;
        for (int p = 0; p < 64; ++p) { const float cr = CCc[((d * 16 + hp) * 64 + p) * 2], ci = CCc[((d * 16 + hp) * 64 + p) * 2 + 1], pr = POW[((d * 17 + k) * 64 + p) * 2], pi = POW[((d * 17 + k) * 64 + p) * 2 + 1];
          const float xr = cr * pr - ci * pi, xi = cr * pi + ci * pr; s += xr * BBc[((d * 64 + p) * 16 + h) * 2] - xi * BBc[((d * 64 + p) * 16 + h) * 2 + 1]; }
        KT[e] = s; }
      __syncthreads();
      bf16_t* PB = (bf16_t*)(ws + WS_S5PB) + (size_t)g * 256 * 256;
      for (int e = tid; e < 256 * 256; e += NWAVES * 64) { const int n = e >> 8, col = e & 255, d = n >> 7, nn = n & 127, p = nn >> 1, ri = nn & 1, tau = col >> 4, h = col & 15, kp = d ? tau : 15 - tau;
        const float pr = POW[((d * 17 + kp) * 64 + p) * 2], pi = POW[((d * 17 + kp) * 64 + p) * 2 + 1], br = BBc[((d * 64 + p) * 16 + h) * 2], bi = BBc[((d * 64 + p) * 16 + h) * 2 + 1];
        PB[e] = f2bf(ri ? pr * bi + pi * br : pr * br - pi * bi); }
      bf16_t* MR = (bf16_t*)(ws + WS_S5MR) + (size_t)g * 256 * 512;
      for (int e = tid; e < 256 * 512; e += NWAVES * 64) { const int r = e >> 9, k = e & 511, t = r >> 4, hp = r & 15; float v;
        if (k < 256) { const int tau = k >> 4, h = k & 15; v = 0.f; if (tau <= t) v += KT[((0 * 16 + (t - tau)) * 16 + hp) * 16 + h]; if (tau >= t) v += KT[((1 * 16 + (tau - t)) * 16 + hp) * 16 + h];
          if (tau == t && h == hp) v += a.in[15][g * 16 + h]; }
        else { const int kk = k - 256, d = kk >> 7, nn = kk & 127, p = nn >> 1, ri = nn & 1, kp = d ? 16 - t : t + 1;
          const float pr = POW[((d * 17 + kp) * 64 + p) * 2], pi = POW[((d * 17 + kp) * 64 + p) * 2 + 1], cr = CCc[((d * 16 + hp) * 64 + p) * 2], ci = CCc[((d * 16 + hp) * 64 + p) * 2 + 1];
          v = ri ? -(cr * pi + ci * pr) : (cr * pr - ci * pi); }
        MR[e] = f2bf(v); }
      __syncthreads();
    }
    {
      LAS float* scr = (LAS float*)(L + wave * 16384);
      int base = 0;
#define WT_MAT(Wp, K_, Nsrc_, Ndst_, dst_, map_, ks_) do { const int ni = ((K_) / 64) * ((Ndst_) / 32); int it0 = gw - (base % NGW); if (it0 < 0) it0 += NGW; \
        for (int it = it0; it < ni; it += NGW) wt_item((Wp), (K_), (Nsrc_), (Ndst_), (bf16_t*)(ws + (dst_)), (map_), (ks_), scr, it, lane); base += ni; } while (0)
      WT_MAT(a.in[6], 1024, 1216, 1280, W_INAB, 0, (const float*)nullptr);
      WT_MAT(a.in[7], 1024, 1024, 1024, W_OUTAB, 0, (const float*)nullptr);
      WT_MAT(a.in[16], 512, 512, 512, W_GLU, 0, (const float*)nullptr);
      WT_MAT(a.in[19], 384, 768, 768, W_UQ, 0, a.in[18]);
      WT_MAT(a.in[21], 256, 1024, 1024, W_UKV, 0, a.in[20]);
      WT_MAT(a.in[27], 1024, 5632, 5632, W_UP, 2, (const float*)nullptr);
      WT_MAT(a.in[30], 2816, 1024, 1024, W_DN, 0, (const float*)nullptr);
#undef WT_MAT
    }
    { const int gt = vcu * 512 + tid, NT_ = G * 512;
      float* c64 = (float*)(ws + WS_R64C); float* s64 = (float*)(ws + WS_R64S); float* c128 = (float*)(ws + WS_R128C); float* s128 = (float*)(ws + WS_R128S);
      for (int i = gt; i < 2048 * 32; i += NT_) { const int t = i >> 5, j = i & 31, ii = j & 15; const float inv = powf(10000.f, -(float)ii / 16.f), pos = j < 16 ? (float)(t >> 6) : (float)(t & 63);
        float sv, cv; sincosf(pos * inv, &sv, &cv); c64[i] = cv; s64[i] = sv; }
      for (int i = gt; i < 2048 * 64; i += NT_) { const int t = i >> 6, j = i & 63, ii = j & 31; const float inv = powf(10000.f, -(float)ii / 32.f), pos = j < 32 ? (float)(t >> 6) : (float)(t & 63);
        float sv, cv; sincosf(pos * inv, &sv, &cv); c128[i] = cv; s128[i] = sv; }
    }
  } else if (ph == 1) {
    norm_rows(ws, x, ctx, true, 0, 0, 0, gw, NGW, lane);
  } else if (ph == 16) {
    norm_rows(ws, x, ctx, false, 1, 1, 1, gw, NGW, lane);
  } else if (ph == 24 || ph == 26) {
    norm_rows(ws, x, ctx, false, ph == 24 ? 0 : 1, ph == 24 ? 1 : 0, 2, gw, NGW, lane);
  } else if (ph == 23 || ph == 25) {
    if (bx < 64) {
      Epi<false> E{}; E.ws = ws; E.scr = (LAS float*)(L + SCR_OFF); E.kind = EK_RES; E.gate = MODS + (ph == 23 ? 2 : 5) * 1024; E.hin_c = ph == 23 ? ctx : nullptr; E.hin_l = ph == 23 ? x : nullptr;
      SchedCtx S; S.c = bx;
      if (ph == 23) { pg8::Gemm g{(const bf16_t*)(ws + R_CAT), (const bf16_t*)(ws + W_OUTAB), 1024, 1024}; pg8::gemm_phase<Epi<false>, SchedCtx, false>(L, g, S, E); }
      else { pg8::Gemm g{(const bf16_t*)(ws + R_HH), (const bf16_t*)(ws + W_DN), 2816, 2816}; pg8::gemm_phase<Epi<false>, SchedCtx, false, true>(L, g, S, E); }
    } else {
      const int gw2 = (bx - 64) * NWAVES + wave, NGW2 = (G - 64) * NWAVES;
      norm_rows(ws, x, ctx, false, ph == 23 ? 0 : 1, ph == 23 ? 1 : 0, 1, gw2, NGW2, lane);
      if (ph == 25) {
        LAS float* scr = (LAS float*)(L + wave * 16384); int base = 0;
#define WT_MAT(Wp, K_, Nsrc_, Ndst_, dst_, map_, ks_) do { const int ni = ((K_) / 64) * ((Ndst_) / 32); int it0 = gw2 - (base % NGW2); if (it0 < 0) it0 += NGW2; \
          for (int it = it0; it < ni; it += NGW2) wt_item((Wp), (K_), (Nsrc_), (Ndst_), (bf16_t*)(ws + (dst_)), (map_), (ks_), scr, it, lane); base += ni; } while (0)
        WT_MAT(a.in[22], 1024, 3072, 3072, W_INCD, 1, (const float*)nullptr);
        WT_MAT(a.in[23], 1024, 1024, 1024, W_OUTCD, 0, (const float*)nullptr);
        WT_MAT(a.in[27] + (size_t)1024 * 5632, 1024, 5632, 5632, W_UP + (size_t)5632 * 1024 * 2, 2, (const float*)nullptr);
        WT_MAT(a.in[30] + (size_t)2816 * 1024, 2816, 1024, 1024, W_DN + (size_t)1024 * 2816 * 2, 0, (const float*)nullptr);
#undef WT_MAT
      }
    }
  } else if (ph == 2 || ph == 7 || ph == 9 || ph == 11 || ph == 13 || ph == 15 || ph == 17 || ph == 19) {
    const int l = ph >= 12 ? 1 : 0;
    if (ph == 9 || ph == 17) {
      Epi<true> E{}; E.kind = EK_UP; E.ws = ws; E.scr = (LAS float*)(L + SCR_OFF); E.cw = a.in[28] + (size_t)l * 3 * FFH; E.cb = a.in[29] + (size_t)l * FFH;
      pg8::Gemm g{(const bf16_t*)(ws + WS_XN), (const bf16_t*)(ws + W_UP + (size_t)l * 5632 * 1024 * 2), 1024, 1024};
      if (ph == 9) { SchedFull S; S.so.init(144, 22, G, bx); pg8::gemm_phase<Epi<true>, SchedFull, true>(L, g, S, E); }
      else { SchedLat S; S.so.init(128, 22, G, bx); pg8::gemm_phase<Epi<true>, SchedLat, true>(L, g, S, E); }
    } else {
      Epi<false> E{}; E.ws = ws; E.scr = (LAS float*)(L + SCR_OFF);
      if (ph == 2) { E.kind = EK_INAB; pg8::Gemm g{(const bf16_t*)(ws + WS_XN), (const bf16_t*)(ws + W_INAB), 1024, 1024}; SchedFull S; S.so.init(144, 5, G, bx); pg8::gemm_phase<Epi<false>, SchedFull, false>(L, g, S, E); }
      else if (ph == 13) { E.kind = EK_INCD; E.gq = a.in[25]; E.gk = a.in[26]; pg8::Gemm g{(const bf16_t*)(ws + WS_XN), (const bf16_t*)(ws + W_INCD), 1024, 1024};
        SchedInCd S; S.so.init(128, 12, G, bx); S.G = G; S.c = bx; pg8::gemm_phase<Epi<false>, SchedInCd, false>(L, g, S, E); }
      else {
        E.kind = EK_RES; const int which = (ph == 11 || ph == 19) ? 1 : 0; E.gate = MODS + (size_t)l * 17 * 6144 + (which * 3 + 2) * 1024;
        E.hin_c = ph == 7 ? ctx : nullptr; E.hin_l = ph == 7 ? x : nullptr;
        if (ph == 7) { pg8::Gemm g{(const bf16_t*)(ws + R_CAT), (const bf16_t*)(ws + W_OUTAB), 1024, 1024}; SchedLat S; S.so.init(128, 4, G, bx); pg8::gemm_phase<Epi<false>, SchedLat, false>(L, g, S, E); }
        else if (ph == 11) { pg8::Gemm g{(const bf16_t*)(ws + R_HH), (const bf16_t*)(ws + W_DN), 2816, 2816}; SchedLat S; S.so.init(128, 4, G, bx); pg8::gemm_phase<Epi<false>, SchedLat, false, true>(L, g, S, E); }
        else if (ph == 15) { pg8::Gemm g{(const bf16_t*)(ws + R_CAT1), (const bf16_t*)(ws + W_OUTCD), 1024, 1024}; SchedLat S; S.so.init(128, 4, G, bx); pg8::gemm_phase<Epi<false>, SchedLat, false>(L, g, S, E); }
        else { pg8::Gemm g{(const bf16_t*)(ws + R_HH), (const bf16_t*)(ws + W_DN + (size_t)1024 * 2816 * 2), 2816, 2816}; SchedLat S; S.so.init(128, 4, G, bx); pg8::gemm_phase<Epi<false>, SchedLat, false, true>(L, g, S, E); }
      }
    }
  } else if (ph == 3) {
    Epi<false> E{}; E.ws = ws; E.scr = (LAS float*)(L + SCR_OFF);
    { E.kind = EK_S5E; pg8::Gemm g{(const bf16_t*)(ws + R_A5), (const bf16_t*)(ws + WS_S5PB), 256, 512}; SchedS5 S; S.G = G; S.c = bx; pg8::gemm_phase<Epi<false>, SchedS5, false>(L, g, S, E); }
    { E.kind = EK_Q; pg8::Gemm g{(const bf16_t*)(ws + R_CQ), (const bf16_t*)(ws + W_UQ), 384, 384}; SchedFull S; S.so.init(144, 3, G, bx); pg8::gemm_phase<Epi<false>, SchedFull, false>(L, g, S, E); }
    { E.kind = EK_KV; pg8::Gemm g{(const bf16_t*)(ws + R_CKV), (const bf16_t*)(ws + W_UKV), 256, 256}; SchedFull S; S.so.init(144, 4, G, bx); pg8::gemm_phase<Epi<false>, SchedFull, false>(L, g, S, E); }
  } else if (ph == 4) {
    for (int w = gw; w < 1024; w += NGW) s5_chunk_scan(ws, w & 31, (w >> 5) & 15, w >> 9, lane);
  } else if (ph == 5) {
    Epi<false> E{}; E.ws = ws; E.scr = (LAS float*)(L + SCR_OFF); E.kind = EK_S5Y;
    pg8::Gemm g{(const bf16_t*)(ws + R_A5), (const bf16_t*)(ws + WS_S5MR), 512, 512}; SchedS5 S; S.G = G; S.c = bx; pg8::gemm_phase<Epi<false>, SchedS5, false>(L, g, S, E);
  } else if (ph == 6) {
    const bf16_t* Q = (const bf16_t*)(ws + R_Q); const bf16_t* Kb = (const bf16_t*)(ws + R_K); const bf16_t* Vb = (const bf16_t*)(ws + R_V); bf16_t* CAT = (bf16_t*)(ws + R_CAT);
#pragma unroll 1
    for (int k = 0; k < 2; ++k) { const int u = vcu + 256 * k, bh = u >> 3, qb = u & 7, b = bh >> 2, h = bh & 3; const size_t r0 = (size_t)b * RB + NCTX + 256 * qb;
      att::attn_unit<192, 0, 0, 768, 768, 512, 1024, 0>(Q + r0 * 768 + 192 * h, Kb + (size_t)b * RB * 768 + 192 * h, Vb + (size_t)b * RB * 512 + 128 * h, CAT + r0 * 1024 + 512 + 128 * h, RB, (char*)lds, 0, 0.f, 0.f, nullptr); }
    if (vcu >= 64 && vcu < 128) { const int bh = vcu - 64, b = bh >> 2, h = bh & 3; const size_t r0 = (size_t)b * RB;
      att::attn_unit<192, 0, 0, 768, 768, 512, 1024, 0>(Q + r0 * 768 + 192 * h, Kb + r0 * 768 + 192 * h, Vb + r0 * 512 + 128 * h, CAT + r0 * 1024 + 512 + 128 * h, NCTX, (char*)lds, 0, 0.f, 0.f, nullptr); }
    Epi<false> E{}; E.ws = ws; E.scr = (LAS float*)(L + SCR_OFF); E.kind = EK_GLU; E.bglu = a.in[17];
    pg8::Gemm g{(const bf16_t*)(ws + R_G), (const bf16_t*)(ws + W_GLU), 512, 512}; SchedFull S; S.so.init(144, 2, G, bx); pg8::gemm_phase<Epi<false>, SchedFull, false>(L, g, S, E);
  } else if (ph == 10 || ph == 18) {
    const int l = ph == 18 ? 1 : 0; const float* cw = a.in[28] + (size_t)l * 3 * FFH; bf16_t* HH = (bf16_t*)(ws + R_HH);
    const float* EP = (const float*)(ws + WS_EDGE); const float* EG = EP + EDGE_ARR / 4; const float* EA = EG + EDGE_ARR / 4;
    for (int i = vcu * 512 + tid; i < NBLK128 * 2 * FFH; i += G * 512) { const int j = i % FFH, be = i / FFH, e = be & 1, blk = be >> 1, bi = blk % 18;
      if (l == 1 && bi < 2) continue;
      float cv = EP[i];
      if (e == 0) { if (!(bi == 0 || bi == 2)) cv += cw[j] * EA[((size_t)(blk - 1) * 2 + 1) * FFH + j]; }
      else { if (!(bi == 1 || bi == 17)) cv += cw[2 * FFH + j] * EA[((size_t)(blk + 1) * 2 + 0) * FFH + j]; }
      HH[((size_t)(j >> 5) * TT + (size_t)blk * 128 + (e ? 127 : 0)) * 32 + (j & 31)] = f2bf(gelu_t(cv) * EG[i]); }
  } else if (ph == 14) {
    bf16_t* CAT1 = (bf16_t*)(ws + R_CAT1); const bf16_t* RK = (const bf16_t*)(ws + R_RK); const bf16_t* RV = (const bf16_t*)(ws + R_RV); const bf16_t* RG = (const bf16_t*)(ws + R_RG);
    const bf16_t* GK = (const bf16_t*)(ws + R_GK); const bf16_t* GV = (const bf16_t*)(ws + R_GV);
    { const int bh = vcu >> 2, dir = (vcu >> 1) & 1, hf = vcu & 1, b = bh >> 2, h = bh & 3; const float dl = a.in[24][dir * 4 + h];
      const float l2 = __uint_as_float(__builtin_amdgcn_readfirstlane(__float_as_uint(-log1pf(expf(-dl)) * LOG2E)));
      att::ret_state_unit(RK + (size_t)b * RB * 512 + 128 * h, RV + (size_t)b * RB * 512 + 128 * h, (bf16_t*)(ws + R_ST) + (size_t)(bh * 2 + dir) * 8 * 16384, dir, hf, l2, (char*)lds); }
#pragma unroll 1
    for (int k = 0; k < 2; ++k) { const int u = vcu + 256 * k, bh = u >> 3, qb = u & 7, b = bh >> 2, h = bh & 3; const size_t r0 = (size_t)b * RB + NCTX + 256 * qb, rb = (size_t)b * RB;
      att::attn_unit<128, 0, 1, 1024, 256, 256, 1024, 0>(CAT1 + r0 * 1024 + 512 + 128 * h, GK + rb * 256 + 128 * (h >> 1), GV + rb * 256 + 128 * (h >> 1), CAT1 + r0 * 1024 + 512 + 128 * h, RB, (char*)lds, 0, 0.f, 0.f, nullptr); }
  } else if (ph == 22) {
    bf16_t* CAT1 = (bf16_t*)(ws + R_CAT1); const bf16_t* RK = (const bf16_t*)(ws + R_RK); const bf16_t* RV = (const bf16_t*)(ws + R_RV); const bf16_t* RG = (const bf16_t*)(ws + R_RG); const bf16_t* ST = (const bf16_t*)(ws + R_ST);
#pragma unroll 1
    for (int k = 0; k < 2; ++k) { const int u = vcu + 256 * k, bh = u >> 3, qb = u & 7, b = bh >> 2, h = bh & 3; const size_t r0 = (size_t)b * RB + NCTX + 256 * qb;
      const float dl_f = a.in[24][h], dl_b = a.in[24][4 + h]; const float lf2 = __uint_as_float(__builtin_amdgcn_readfirstlane(__float_as_uint(-log1pf(expf(-dl_f)) * LOG2E))), lb2 = __uint_as_float(__builtin_amdgcn_readfirstlane(__float_as_uint(-log1pf(expf(-dl_b)) * LOG2E)));
      att::ret_out_unit(CAT1 + r0 * 1024 + 128 * h, RK + r0 * 512 + 128 * h, RV + r0 * 512 + 128 * h, ST + ((size_t)(bh * 2 + 0) * 8 + qb) * 16384, ST + ((size_t)(bh * 2 + 1) * 8 + qb) * 16384, RG + r0 * 512 + 128 * h, lf2, lb2, (char*)lds); }
  } else if (ph == 20) {
    const float* gf = a.in[31];
    for (int row = gw; row < 16 * NLAT; row += NGW) { const bf16_t* hr = HB + ((size_t)(row >> 11) * RB + NCTX + (row & 2047)) * 1024; float* orow = a.out + (size_t)row * 1024;
      f32x4 v[4]; float ss = 0.f;
#pragma unroll
      for (int j = 0; j < 4; ++j) { const u32x2 w = *(const u32x2*)(hr + lane * 4 + 256 * j); v[j] = (f32x4){bflo(w.x), bfhi(w.x), bflo(w.y), bfhi(w.y)}; ss += (v[j][0] * v[j][0] + v[j][1] * v[j][1]) + (v[j][2] * v[j][2] + v[j][3] * v[j][3]); }
      const float rs = rsqrtf(wave_sum64(ss) * (1.f / 1024.f) + EPS_N);
#pragma unroll
      for (int j = 0; j < 4; ++j) *(f32x4*)(orow + lane * 4 + 256 * j) = v[j] * rs * *(const f32x4*)(gf + lane * 4 + 256 * j); }
  }
}

__global__ void __launch_bounds__(NWAVES * 64, 2) mega_fwd(MArgs a) {
  extern __shared__ __attribute__((aligned(16))) unsigned char lds[];
  LAS unsigned char* L = (LAS unsigned char*)lds;
  volatile LAS unsigned* MISC = (volatile LAS unsigned*)(L + MISC_OFF);
  const int tid = threadIdx.x, lane = tid & 63, wave = __builtin_amdgcn_readfirstlane(tid >> 6);
  const int G = gridDim.x, bx = blockIdx.x, vcu = (G % 8 == 0) ? (bx % 8) * (G / 8) + bx / 8 : bx;
  for (int u = tid; u < 64; u += NWAVES * 64) MISC[u] = 0u;
  __syncthreads();
  XcdBarrier bar; bar.bar = (unsigned*)(a.ws + WS_CTL) + 4096; bar.x = 0; bar.st = nullptr;
  const int lo = a.ph_lo, hi = a.ph_hi;
  if (hi - lo > 1) bar = xcd_barrier_post((unsigned*)(a.ws + WS_CTL) + 4096, MISC + 8);
#ifndef MK_DUP
#define MK_DUP 0
#endif
#define RUN(k) do { if (lo <= (k) && (k) < hi) { run_phase<k>(a, lds, tid, lane, wave, G, bx, vcu); if ((k) != 20 && hi - lo > 1) xcd_barrier(bar); \
    if constexpr (((MK_DUP) >> (k)) & 1) { run_phase<k>(a, lds, tid, lane, wave, G, bx, vcu); xcd_barrier(bar); } } } while (0)
  RUN(0); RUN(1); RUN(2); RUN(3); RUN(4); RUN(5); RUN(6); RUN(7); RUN(23); RUN(24); RUN(9); RUN(10); RUN(11); RUN(25); RUN(26); RUN(13); RUN(14); RUN(22); RUN(15); RUN(16); RUN(17); RUN(18); RUN(19); RUN(20);
#ifdef MK_XBAR
  for (int i = 0; i < MK_XBAR; ++i) xcd_barrier(bar);
#endif
#undef RUN
}

#ifndef MK_SINGLE
#define MK_SINGLE 1
#endif
static void mk_launch(void* const* d_in, void* d_out, void* d_ws, hipStream_t stream) {
  static int ok = 0;
  if (!ok) { if (hipFuncSetAttribute((const void*)mega_fwd, hipFuncAttributeMaxDynamicSharedMemorySize, LDS_BYTES) != hipSuccess) { fprintf(stderr, "hipFuncSetAttribute failed\n"); return; } ok = 1; }
  (void)hipMemsetAsync((char*)d_ws + WS_CTL, 0, CTL_BYTES, stream);
  MArgs a{}; for (int i = 0; i < 32; ++i) a.in[i] = (const float*)d_in[i]; a.out = (float*)d_out; a.ws = (unsigned char*)d_ws;
  if (MK_SINGLE) { a.ph_lo = 0; a.ph_hi = 27; hipLaunchKernelGGL(mega_fwd, dim3(256), dim3(512), LDS_BYTES, stream, a); }
  else for (int p = 0; p < 21; ++p) { a.ph_lo = p; a.ph_hi = p + 1; hipLaunchKernelGGL(mega_fwd, dim3(256), dim3(512), LDS_BYTES, stream, a); }
}
extern "C" void kernel_launch(void* const* d_in, const int* in_sizes, int n_in, void* d_out, int out_size, void* d_ws, size_t ws_size, hipStream_t stream) {
  if (ws_size < WS_END) { fprintf(stderr, "kernel_launch: workspace too small (%zu < %zu)\n", ws_size, (size_t)WS_END); return; }
  mk_launch(d_in, d_out, d_ws, stream);
}
```

```cpp
#include <hip/hip_runtime.h>
#include <cstdio>
#include <cstdint>

#define LAS __attribute__((address_space(3)))
#define GAS __attribute__((address_space(1)))
typedef unsigned short bf16_t;
typedef short bf16x8 __attribute__((ext_vector_type(8)));
typedef short s16x4 __attribute__((ext_vector_type(4)));
typedef float f32x2 __attribute__((ext_vector_type(2)));
typedef float f32x4 __attribute__((ext_vector_type(4)));
typedef float f32x16 __attribute__((ext_vector_type(16)));
typedef unsigned u32x2 __attribute__((ext_vector_type(2)));
typedef unsigned u32x4 __attribute__((ext_vector_type(4)));
typedef __bf16 bf16x2_t __attribute__((ext_vector_type(2)));

constexpr int TT = 36864;
constexpr int DMODEL = 1024, RB = 2304, NCTX = 256, NLAT = 2048, FFH = 2816, NBLK128 = TT / 128;
constexpr float EPS_N = 1e-6f, LOG2E = 1.4426950408889634f;

__device__ __forceinline__ unsigned pk2(float lo, float hi) { f32x2 v = {lo, hi}; bf16x2_t b = __builtin_convertvector(v, bf16x2_t); return __builtin_bit_cast(unsigned, b); }
__device__ __forceinline__ float bflo(unsigned u) { return __uint_as_float(u << 16); }
__device__ __forceinline__ float bfhi(unsigned u) { return __uint_as_float(u & 0xffff0000u); }
__device__ __forceinline__ float bf1(bf16_t h) { return __uint_as_float(((unsigned)h) << 16); }
__device__ __forceinline__ bf16_t f2bf(float f) { return (bf16_t)(pk2(f, 0.f) & 0xffffu); }
__device__ __forceinline__ void store8(bf16_t* p, const f32x4& a, const f32x4& b) { u32x4 w; w.x = pk2(a[0], a[1]); w.y = pk2(a[2], a[3]); w.z = pk2(b[0], b[1]); w.w = pk2(b[2], b[3]); *(u32x4*)p = w; }
__device__ __forceinline__ float fast_sigmoid(float x) { return __builtin_amdgcn_rcpf(1.f + __builtin_amdgcn_exp2f(-LOG2E * x)); }
__device__ __forceinline__ float gelu_t(float x) { const float u = x + 0.044715f * x * x * x; return x * __builtin_amdgcn_rcpf(1.f + __builtin_amdgcn_exp2f(-2.302208198f * u)); }
__device__ __forceinline__ float silu_t(float x) { return x * fast_sigmoid(x); }
__device__ __forceinline__ float wave_sum64(float v) {
#pragma unroll
  for (int o = 1; o < 64; o <<= 1) v += __shfl_xor(v, o);
  return v;
}

constexpr size_t MiB = 1u << 20;
constexpr size_t WS_CTL = 0, CTL_BYTES = 32768;
constexpr size_t WS_MODS = 1 * MiB;
constexpr size_t WS_R64C = 2 * MiB, WS_R64S = WS_R64C + 2048 * 32 * 4, WS_R128C = WS_R64S + 2048 * 32 * 4, WS_R128S = WS_R128C + 2048 * 64 * 4;
constexpr size_t WS_S5LAM = 3 * MiB + 512 * 1024;
constexpr size_t WS_PS = 5 * MiB;
constexpr size_t WS_EDGE = 11 * MiB, EDGE_ARR = (size_t)NBLK128 * 2 * FFH * 4;
constexpr size_t WS_S5PB = WS_EDGE, WS_S5MR = WS_S5PB + (size_t)32 * 256 * 256 * 2;
static_assert(WS_S5MR + (size_t)32 * 256 * 512 * 2 <= WS_EDGE + 3 * EDGE_ARR, "s5 matrices");
constexpr size_t WS_W = 31 * MiB;
constexpr size_t W_INAB = WS_W, W_OUTAB = W_INAB + 1280 * 1024 * 2, W_GLU = W_OUTAB + 1024 * 1024 * 2, W_UQ = W_GLU + 512 * 512 * 2, W_UKV = W_UQ + 768 * 384 * 2,
                 W_INCD = W_UKV + 1024 * 256 * 2, W_OUTCD = W_INCD + 3072 * 1024 * 2, W_UP = W_OUTCD + 1024 * 1024 * 2, W_DN = W_UP + 2 * (size_t)5632 * 1024 * 2, W_END = W_DN + 2 * (size_t)1024 * 2816 * 2;
static_assert(W_END <= 79 * MiB, "weights");
constexpr size_t WS_HB = 79 * MiB;
constexpr size_t WS_XN = 151 * MiB;
constexpr size_t WS_R = 223 * MiB;
constexpr size_t R_A5 = WS_HB  , R_CQ = WS_R + (size_t)32 * 2304 * 512 * 2, R_CKV = R_CQ + (size_t)TT * 384 * 2, R_CAT = WS_R;
constexpr size_t R_Q = WS_R + 117 * MiB, R_K = R_Q + (size_t)TT * 768 * 2, R_V = R_K + (size_t)TT * 768 * 2, R_G = R_CQ, R_END0 = R_V + (size_t)TT * 512 * 2;
constexpr size_t R_HH = WS_R;
constexpr size_t R_CAT1 = WS_R, R_RK = R_CAT1 + (size_t)TT * 1024 * 2, R_RV = R_RK + (size_t)TT * 512 * 2, R_RG = R_RV + (size_t)TT * 512 * 2, R_GK = R_RG + (size_t)TT * 512 * 2, R_GV = R_GK + (size_t)TT * 256 * 2, R_ST = R_GV + (size_t)TT * 256 * 2;
constexpr size_t WS_END = WS_R + 261 * MiB;
static_assert(R_G + (size_t)TT * 512 * 2 <= R_Q && R_CKV + (size_t)TT * 256 * 2 <= R_Q && R_END0 <= WS_END && R_HH + (size_t)TT * FFH * 2 <= WS_END && R_ST + (size_t)16 * 4 * 2 * 8 * 16384 * 2 <= WS_END && WS_END <= 512 * MiB, "ws map");

namespace pg8 {
constexpr int BM = 256, BK = 64, HALF = 128, HTB = HALF * BK * 2, STAGE_BYTES = 8 * HTB, NXCD = 8, WGM = 6;
__host__ __device__ __forceinline__ int lds_byte(int r, int c) { const int st = (r >> 4) * 2 + (c >> 5), rr = r & 15, cc = c & 31, ob = rr * 64 + cc * 2; return st * 1024 + (ob ^ (((ob >> 9) & 1) << 5)); }
__host__ __device__ __forceinline__ void stage_rc(int b, int& R, int& C) { const int st = b / 1024, sb = b % 1024, swz = sb ^ (((sb >> 9) & 1) << 5); R = (st >> 1) * 16 + swz / 64; C = (st & 1) * 32 + (swz % 64) / 2; }
__host__ __device__ __forceinline__ int perm32(int rho) { const int n = rho >> 4, i = rho & 15; return 8 * (i >> 2) + 4 * n + (i & 3); }
struct Unit { int pm, pn; };
struct Gemm { const bf16_t* A; const bf16_t* Bt; int K; int lda; int ldb; };
constexpr int PG8_FLAG_OFF = 131072 + 8192 + 1024;
struct StaticOrder {
    int nM, nN, nwg, G, c;
    __host__ __device__ void init(int nM_, int nN_, int G_, int c_) { nM = nM_; nN = nN_; nwg = nM * nN; G = G_; c = c_; }
    __host__ __device__ bool next(int i, Unit& u) const {
        const long L = (long)i * G + c; if (L >= nwg) return false;
        int wgid = (int)L; { const int q = nwg / NXCD, r = nwg % NXCD, xcd = wgid % NXCD, off = wgid / NXCD; wgid = (xcd < r ? xcd * (q + 1) : r * (q + 1) + (xcd - r) * q) + off; }
        const int nig = WGM * nN, gid = wgid / nig, fm = gid * WGM, gsz = (nM - fm) < WGM ? (nM - fm) : WGM;
        u.pm = fm + ((wgid % nig) % gsz); u.pn = (wgid % nig) / gsz; return true;
    }
};
template <class Epi, class Sched, bool APERM, bool ABLK = false, bool RELAX = true>
__device__ __forceinline__ void gemm_phase(LAS unsigned char* lds, const Gemm g, const Sched& S, const Epi& E) {
    int tid_l = threadIdx.x; asm volatile("" : "+v"(tid_l));
    const int tid = tid_l, wid = __builtin_amdgcn_readfirstlane(tid >> 6), lane = tid & 63, wr = wid >> 2, wc = wid & 3, fr = lane & 15, fq = lane >> 4;
    const int K = g.K, nt = K / BK, lda = g.lda, ldb = g.ldb ? g.ldb : g.K;
    unsigned voffA[2], voffB[2];
#pragma unroll
    for (int i = 0; i < 2; ++i) { int R, C; stage_rc(tid * 16 + i * 8192, R, C); const int Rb = (R & ~31) + perm32(R & 31);
        const int Ra = APERM ? (128 * (R >> 6) + 8 * (R & 15) + ((R >> 4) & 3)) : R;
        voffA[i] = ABLK ? (unsigned)(((C >> 5) * TT + Ra) * 32 + (C & 31)) * 2u : (unsigned)(Ra * lda + C) * 2u; voffB[i] = (unsigned)(Rb * ldb + C) * 2u; }
    const size_t kstep = (size_t)(BK * 2), kstepA = ABLK ? (size_t)2 * TT * 32 * 2 : kstep;
    const size_t hstepB = (size_t)HALF * ldb * 2, hstepA = ABLK ? (size_t)HALF * 32 * 2 : APERM ? (size_t)4 * lda * 2 : (size_t)HALF * lda * 2;
    const size_t tstep = (size_t)256 * ldb * 2, tstepA = ABLK ? (size_t)256 * 32 * 2 : (size_t)256 * lda * 2;
    const unsigned ldsw = (unsigned)wid * 1024u;
    const int aoff = lds_byte(wr * 64 + fr, fq * 8), boff = lds_byte(wc * 32 + fr, fq * 8);
#define PG8_SA(b, h) (((b) * 2 + (h)) * HTB)
#define PG8_SB(b, h) ((4 + (b) * 2 + (h)) * HTB)
#define PG8_STAGE(bufoff, gbase, voff) do { _Pragma("unroll") for (int _i = 0; _i < 2; ++_i) \
        __builtin_amdgcn_global_load_lds((const unsigned*)((const char*)(gbase) + (voff)[_i]), (LAS unsigned*)(lds + (bufoff) + ldsw + _i * 8192), 16, 0, 0); } while (0)
#define PG8_LDA(dst, b, h) do { _Pragma("unroll") for (int m = 0; m < 4; ++m) _Pragma("unroll") for (int k = 0; k < 2; ++k) dst[m][k] = *(const LAS bf16x8*)(lds + PG8_SA(b, h) + aoff + m * 2048 + k * 1024); } while (0)
#define PG8_LDB(dst, b, h) do { _Pragma("unroll") for (int n = 0; n < 2; ++n) _Pragma("unroll") for (int k = 0; k < 2; ++k) dst[n][k] = *(const LAS bf16x8*)(lds + PG8_SB(b, h) + boff + n * 2048 + k * 1024); } while (0)
#define PG8_MMA(ai, bj, At, Bt) do { __builtin_amdgcn_s_setprio(1); _Pragma("unroll") for (int m = 0; m < 4; ++m) _Pragma("unroll") for (int n = 0; n < 2; ++n) _Pragma("unroll") for (int k = 0; k < 2; ++k) \
        acc[ai][bj][m][n] = __builtin_amdgcn_mfma_f32_16x16x32_bf16(Bt[n][k], At[m][k], acc[ai][bj][m][n], 0, 0, 0); __builtin_amdgcn_s_setprio(0); } while (0)
#define PG8_WAIT_V(n) asm volatile("s_waitcnt vmcnt(" #n ")" ::: "memory")
#define PG8_WAIT_L(n) asm volatile("s_waitcnt lgkmcnt(" #n ")" ::: "memory")
#define PG8_BAR __builtin_amdgcn_s_barrier()
#define PG8_FLAG(v) do { } while (0)
#define PG8_WAIT_V8R do { if constexpr (!RELAX) PG8_WAIT_V(8); else asm volatile("s_cmp_lg_u32 %0, 0\n\ts_cbranch_scc1 .Lrn%=\n\ts_cmp_eq_u32 %1, 0\n\ts_cbranch_scc1 .Lrn%=\n\ts_waitcnt vmcnt(24)\n\ts_branch .Lre%=\n.Lrn%=:\n\ts_waitcnt vmcnt(8)\n.Lre%=:" \
        :: "s"(__builtin_amdgcn_readfirstlane(t)), "s"(__builtin_amdgcn_readfirstlane(ui)) : "memory", "scc"); } while (0)
#define PG8_SCHED __builtin_amdgcn_sched_barrier(0)
    Unit cur, nxt; int ui = 0;
    if (!S.next(0, cur)) return;
    f32x4 acc[2][2][4][2];
#pragma unroll
    for (int a = 0; a < 2; ++a)
#pragma unroll
        for (int b = 0; b < 2; ++b)
#pragma unroll
            for (int m = 0; m < 4; ++m)
#pragma unroll
                for (int n = 0; n < 2; ++n) acc[a][b][m][n] = (f32x4){0.f, 0.f, 0.f, 0.f};
    bf16x8 At[4][2], B0[2][2], B1[2][2];
    const char* cA = (const char*)g.A + (size_t)cur.pm * tstepA; const char* cB = (const char*)g.Bt + (size_t)cur.pn * tstep;
    PG8_FLAG(0u);
    if constexpr (Epi::PREFETCH) E.prefetch(cur, 0);
    PG8_STAGE(PG8_SB(0, 0), cB, voffB); PG8_STAGE(PG8_SB(0, 1), cB + hstepB, voffB); PG8_STAGE(PG8_SA(0, 0), cA, voffA); PG8_STAGE(PG8_SA(0, 1), cA + hstepA, voffA);
    if (wr == 1) PG8_BAR;
    PG8_WAIT_V(2); PG8_BAR;
    PG8_STAGE(PG8_SB(1, 0), cB + kstep, voffB); PG8_STAGE(PG8_SA(1, 0), cA + kstepA, voffA); PG8_STAGE(PG8_SB(1, 1), cB + hstepB + kstep, voffB);
    PG8_WAIT_V(6); PG8_BAR;
    for (;;) {
        const bool has_next = S.next(ui + 1, nxt);
        const char* nA = has_next ? (const char*)g.A + (size_t)nxt.pm * tstepA : cA; const char* nB = has_next ? (const char*)g.Bt + (size_t)nxt.pn * tstep : cB;
        for (int t = 0; t < nt; t += 2) {
            const bool last = (t == nt - 2);
            const char* a1 = cA + (size_t)(t + 1) * kstepA;
            const char* a2 = last ? nA : cA + (size_t)(t + 2) * kstepA; const char* b2 = last ? nB : cB + (size_t)(t + 2) * kstep;
            const char* a3 = a2 + kstepA; const char* b3 = b2 + kstep;
            PG8_LDB(B0, 0, 0); PG8_LDB(B1, 0, 1); PG8_SCHED; PG8_LDA(At, 0, 0); PG8_STAGE(PG8_SA(1, 1), a1 + hstepA, voffA);
            PG8_WAIT_V8R; PG8_WAIT_L(0); PG8_BAR; PG8_MMA(0, 0, At, B0); PG8_MMA(0, 1, At, B1); PG8_BAR; PG8_SCHED;
            PG8_LDA(At, 0, 1); PG8_STAGE(PG8_SB(0, 0), b2, voffB); PG8_STAGE(PG8_SB(0, 1), b2 + hstepB, voffB); PG8_STAGE(PG8_SA(0, 0), a2, voffA);
            PG8_WAIT_V8R; PG8_FLAG(0u); PG8_WAIT_L(0); PG8_BAR; PG8_MMA(1, 0, At, B0); PG8_MMA(1, 1, At, B1); PG8_BAR; PG8_SCHED;
            PG8_LDB(B0, 1, 0); PG8_LDB(B1, 1, 1); PG8_SCHED; PG8_LDA(At, 1, 0); PG8_STAGE(PG8_SA(0, 1), a2 + hstepA, voffA);
            PG8_WAIT_V(8); PG8_WAIT_L(0); PG8_BAR; PG8_MMA(0, 0, At, B0); PG8_MMA(0, 1, At, B1); PG8_BAR; PG8_SCHED;
            PG8_LDA(At, 1, 1); PG8_STAGE(PG8_SB(1, 0), b3, voffB); PG8_STAGE(PG8_SB(1, 1), b3 + hstepB, voffB); PG8_STAGE(PG8_SA(1, 0), a3, voffA);
            PG8_WAIT_V(8); PG8_WAIT_L(0); PG8_BAR; PG8_MMA(1, 0, At, B0); PG8_MMA(1, 1, At, B1); PG8_BAR; PG8_SCHED;
        }
        if (wr == 0) PG8_BAR;
        if constexpr (Epi::PREFETCH) { if (has_next) E.prefetch(nxt, (ui + 1) & 1); }
        { int frl = fr, fql = fq; asm volatile("" : "+v"(frl), "+v"(fql));
          E(acc, cur, wr, wc, frl, fql, ui & 1); }
        if (!has_next) break;
        PG8_FLAG(1u);
#pragma unroll
        for (int a = 0; a < 2; ++a)
#pragma unroll
            for (int b = 0; b < 2; ++b)
#pragma unroll
                for (int m = 0; m < 4; ++m)
#pragma unroll
                    for (int n = 0; n < 2; ++n) acc[a][b][m][n] = (f32x4){0.f, 0.f, 0.f, 0.f};
        cur = nxt; cA = nA; cB = nB; ++ui;
        if (wr == 1) PG8_BAR;
    }
    PG8_WAIT_V(0);
    PG8_BAR;
#undef PG8_SA
#undef PG8_SB
#undef PG8_STAGE
#undef PG8_LDA
#undef PG8_LDB
#undef PG8_MMA
#undef PG8_WAIT_V
#undef PG8_WAIT_L
#undef PG8_BAR
#undef PG8_FLAG
#undef PG8_WAIT_V8R
#undef PG8_SCHED
}
}
struct MArgs { const float* in[32]; float* out; unsigned char* ws; int ph_lo, ph_hi; };

struct SchedFull { pg8::StaticOrder so; __device__ __forceinline__ bool next(int i, pg8::Unit& u) const { return so.next(i, u); } };
struct SchedLat {
    pg8::StaticOrder so;
    __device__ __forceinline__ bool next(int i, pg8::Unit& u) const { if (!so.next(i, u)) return false; u.pm = (u.pm >> 3) * 9 + 1 + (u.pm & 7); return true; }
};
struct SchedInCd {
    pg8::StaticOrder so; int G, c;
    __device__ __forceinline__ bool next(int i, pg8::Unit& u) const {
        const int L = i * G + c;
        if (L < 1536) { so.next(i, u); u.pm = (u.pm >> 3) * 9 + 1 + (u.pm & 7); return true; }
        const int L2 = L - 1536; if (L2 >= 96) return false;
        const int q = L2 % 6; u.pm = (L2 / 6) * 9; u.pn = q < 4 ? 2 + q : 6 + q; return true;
    }
};

enum { EK_INAB = 0, EK_Q, EK_KV, EK_GLU, EK_RES, EK_UP, EK_INCD, EK_S5E, EK_S5Y };
struct SchedS5 { int G, c; __device__ __forceinline__ bool next(int i, pg8::Unit& u) const { const int L = i * G + c; if (L >= 288) return false; u.pm = L; u.pn = L / 9; return true; } };
template <bool UPK> struct Epi {
    static constexpr bool PREFETCH = UPK;
    int kind;
    unsigned char* ws;
    LAS float* scr;
    unsigned* wflag;
    const float* hin_c; const float* hin_l; const float* gate;
    const float* cw; const float* cb;
    const float* bglu;
    const float* gq; const float* gk;

    __device__ __forceinline__ void prefetch(const pg8::Unit& u, int buf) const {
        const int t = threadIdx.x, arr = t >> 7, col = t & 127; const float* src = (arr < 3 ? cw + arr * FFH : cb) + u.pn * 128 + col;
        const int wv = __builtin_amdgcn_readfirstlane(t >> 6);
        __builtin_amdgcn_global_load_lds((const unsigned*)src, (LAS unsigned*)(scr + buf * 512 + wv * 64), 4, 0, 0);
    }
    __device__ __forceinline__ void operator()(const f32x4 (&acc)[2][2][4][2], const pg8::Unit& u, int wr, int wc, int fr, int fq, int buf) const {
        const int jt = u.pm % 9, bb = u.pm / 9; const bool lat = jt != 0;
        const int rloc0 = wr * 64 + fr;
        if (!UPK && kind == EK_INAB) {
            bf16_t* A5 = (bf16_t*)(ws + R_A5); bf16_t* CQ = (bf16_t*)(ws + R_CQ); bf16_t* CKV = (bf16_t*)(ws + R_CKV); bf16_t* Kb = (bf16_t*)(ws + R_K);
            float* PS = (float*)(ws + WS_PS); const float* cs = (const float*)(ws + WS_R64C); const float* sn = (const float*)(ws + WS_R64S);
#pragma unroll
            for (int bj = 0; bj < 2; ++bj) {
                const int cbase = u.pn * 256 + bj * 128 + wc * 32;
                if (cbase >= 1216) continue;
                const int c0 = cbase + 8 * fq;
#pragma unroll
                for (int ai = 0; ai < 2; ++ai)
#pragma unroll
                    for (int m = 0; m < 4; ++m) {
                        const int rl = ai * 128 + m * 16 + rloc0; const size_t row = (size_t)u.pm * 256 + rl;
                        f32x4 v0 = acc[ai][bj][m][0], v1 = acc[ai][bj][m][1];
                        if (cbase < 512) { const int pos = jt * 256 + rl; store8(A5 + ((size_t)(c0 >> 4) * 2304 + bb * 144 + (pos >> 4)) * 512 + (pos & 15) * 16 + (c0 & 15), v0, v1); }
                        else if (cbase < 1152) {
                            float s = (v0[0] * v0[0] + v0[1] * v0[1]) + (v0[2] * v0[2] + v0[3] * v0[3]) + (v1[0] * v1[0] + v1[1] * v1[1]) + (v1[2] * v1[2] + v1[3] * v1[3]);
                            s += __shfl_xor(s, 16); s += __shfl_xor(s, 32);
                            if (fq == 0) PS[row * 40 + (cbase >> 5)] = s;
                            if (cbase < 896) store8(CQ + row * 384 + (c0 - 512), v0, v1); else store8(CKV + row * 256 + (c0 - 896), v0, v1);
                        } else {
                            const int wcc = (cbase - 1152) >> 5;
                            if (lat) {
                                const int t = (jt - 1) * 256 + rl;
                                const f32x4 ca = *(const f32x4*)(cs + t * 32 + wcc * 16 + 8 * (fq & 1)), cb2 = *(const f32x4*)(cs + t * 32 + wcc * 16 + 8 * (fq & 1) + 4);
                                const f32x4 sa = *(const f32x4*)(sn + t * 32 + wcc * 16 + 8 * (fq & 1)), sb2 = *(const f32x4*)(sn + t * 32 + wcc * 16 + 8 * (fq & 1) + 4);
                                f32x4 p0, p1;
#pragma unroll
                                for (int j = 0; j < 4; ++j) { p0[j] = __shfl_xor(v0[j], 32); p1[j] = __shfl_xor(v1[j], 32); }
                                const float sg = (fq < 2) ? -1.f : 1.f;
#pragma unroll
                                for (int j = 0; j < 4; ++j) { v0[j] = v0[j] * ca[j] + sg * p0[j] * sa[j]; v1[j] = v1[j] * cb2[j] + sg * p1[j] * sb2[j]; }
                            }
#pragma unroll
                            for (int h = 0; h < 4; ++h) store8(Kb + row * 768 + h * 192 + 128 + wcc * 32 + 8 * fq, v0, v1);
                        }
                    }
            }
        } else if (!UPK && (kind == EK_Q || kind == EK_KV)) {
            const float* PS = (const float*)(ws + WS_PS);
            bf16_t* Q = (bf16_t*)(ws + R_Q); const float* cs = (const float*)(ws + WS_R64C); const float* sn = (const float*)(ws + WS_R64S);
            bf16_t* Kb = (bf16_t*)(ws + R_K); bf16_t* Vb = (bf16_t*)(ws + R_V);
            if (wr == 0) { const int r = wc * 64 + fq * 16 + fr; const size_t row = (size_t)u.pm * 256 + r; float rq;
                if (kind == EK_Q) { const f32x4 a = *(const f32x4*)(PS + row * 40 + 16), b = *(const f32x4*)(PS + row * 40 + 20), c = *(const f32x4*)(PS + row * 40 + 24);
                    const float s = ((a[0] + a[1]) + (a[2] + a[3])) + ((b[0] + b[1]) + (b[2] + b[3])) + ((c[0] + c[1]) + (c[2] + c[3])); rq = rsqrtf(s * (1.f / 384.f) + EPS_N); }
                else { const f32x4 a = *(const f32x4*)(PS + row * 40 + 28), b = *(const f32x4*)(PS + row * 40 + 32);
                    const float s = ((a[0] + a[1]) + (a[2] + a[3])) + ((b[0] + b[1]) + (b[2] + b[3])); rq = rsqrtf(s * (1.f / 256.f) + EPS_N); }
                scr[r] = rq; }
            asm volatile("s_waitcnt lgkmcnt(0)" ::: "memory"); __builtin_amdgcn_s_barrier(); asm volatile("" ::: "memory");
#pragma unroll
            for (int ai = 0; ai < 2; ++ai)
#pragma unroll
                for (int m = 0; m < 4; ++m) {
                    const int rl = ai * 128 + m * 16 + rloc0; const size_t row = (size_t)u.pm * 256 + rl; const float rsc = scr[rl];
#pragma unroll
                    for (int bj = 0; bj < 2; ++bj) {
                        f32x4 v0 = acc[ai][bj][m][0] * rsc, v1 = acc[ai][bj][m][1] * rsc;
                        if (kind == EK_Q) {
                            const int cbase = u.pn * 256 + bj * 128 + wc * 32, d0 = cbase % 192; const bool rp = d0 >= 128; const int wcc = (d0 - 128) >> 5;
                            if (rp && lat) {
                                const int t = (jt - 1) * 256 + rl; const int to = t * 32 + wcc * 16 + 8 * (fq & 1); const float sg = (fq < 2) ? -1.f : 1.f;
                                { const f32x4 ca = *(const f32x4*)(cs + to), sa = *(const f32x4*)(sn + to);
#pragma unroll
                                  for (int j = 0; j < 4; ++j) { const float pp = __shfl_xor(v0[j], 32); v0[j] = v0[j] * ca[j] + sg * pp * sa[j]; } }
                                { const f32x4 ca = *(const f32x4*)(cs + to + 4), sa = *(const f32x4*)(sn + to + 4);
#pragma unroll
                                  for (int j = 0; j < 4; ++j) { const float pp = __shfl_xor(v1[j], 32); v1[j] = v1[j] * ca[j] + sg * pp * sa[j]; } }
                            }
                            store8(Q + row * 768 + cbase + 8 * fq, v0, v1);
                        } else {
                            if (bj == 0) store8(Kb + row * 768 + u.pn * 192 + wc * 32 + 8 * fq, v0, v1); else store8(Vb + row * 512 + u.pn * 128 + wc * 32 + 8 * fq, v0, v1);
                        }
                    }
                    __builtin_amdgcn_sched_barrier(0);
                }
        } else if (!UPK && kind == EK_GLU) {
            const bf16_t* G = (const bf16_t*)(ws + R_G); bf16_t* CAT = (bf16_t*)(ws + R_CAT);
#pragma unroll
            for (int bj = 0; bj < 2; ++bj) {
                const int c0 = u.pn * 256 + bj * 128 + wc * 32 + 8 * fq; const f32x4 b0 = *(const f32x4*)(bglu + c0), b1 = *(const f32x4*)(bglu + c0 + 4);
                u32x4 gwq[8];
#pragma unroll
                for (int q = 0; q < 8; ++q) { const size_t row = (size_t)u.pm * 256 + (q >> 2) * 128 + (q & 3) * 16 + rloc0; gwq[q] = *(const u32x4*)(G + row * 512 + c0); }
                __builtin_amdgcn_sched_barrier(0);
#pragma unroll
                for (int ai = 0; ai < 2; ++ai)
#pragma unroll
                    for (int m = 0; m < 4; ++m) { const size_t row = (size_t)u.pm * 256 + ai * 128 + m * 16 + rloc0;
                        const u32x4 gw = gwq[ai * 4 + m]; f32x4 v0 = acc[ai][bj][m][0] + b0, v1 = acc[ai][bj][m][1] + b1;
                        v0[0] = bflo(gw.x) * fast_sigmoid(v0[0]); v0[1] = bfhi(gw.x) * fast_sigmoid(v0[1]); v0[2] = bflo(gw.y) * fast_sigmoid(v0[2]); v0[3] = bfhi(gw.y) * fast_sigmoid(v0[3]);
                        v1[0] = bflo(gw.z) * fast_sigmoid(v1[0]); v1[1] = bfhi(gw.z) * fast_sigmoid(v1[1]); v1[2] = bflo(gw.w) * fast_sigmoid(v1[2]); v1[3] = bfhi(gw.w) * fast_sigmoid(v1[3]);
                        store8(CAT + row * 1024 + c0, v0, v1); }
            }
        } else if (!UPK && kind == EK_RES) {
            if (wflag) {
                if (wr == 0 && wc == 0 && fr == 0 && fq == 0) { unsigned sp_ = 0; while (__hip_atomic_load(wflag, __ATOMIC_RELAXED, __HIP_MEMORY_SCOPE_AGENT) == 0u && ++sp_ < (1u << 22)) __builtin_amdgcn_s_sleep(1);
                    __builtin_amdgcn_fence(__ATOMIC_ACQUIRE, "agent"); }
                __builtin_amdgcn_s_barrier(); asm volatile("" ::: "memory");
            }
            const float* hi_ = lat ? hin_l + ((size_t)bb * NLAT + (jt - 1) * 256) * DMODEL : hin_c + (size_t)bb * NCTX * DMODEL;
            bf16_t* HB = (bf16_t*)(ws + WS_HB) + (size_t)u.pm * 256 * DMODEL; const bool first = hin_l != nullptr;
            const float* gt = gate + (size_t)(lat ? bb : 16) * 6144;
#pragma unroll
            for (int bj = 0; bj < 2; ++bj) {
                const int c0 = u.pn * 256 + bj * 128 + wc * 32 + 8 * fq; const f32x4 g0 = *(const f32x4*)(gt + c0), g1 = *(const f32x4*)(gt + c0 + 4);
                if (first) { f32x4 h0[8], h1[8];
#pragma unroll
                    for (int q = 0; q < 8; ++q) { const size_t off = (size_t)((q >> 2) * 128 + (q & 3) * 16 + rloc0) * DMODEL + c0; h0[q] = *(const f32x4*)(hi_ + off); h1[q] = *(const f32x4*)(hi_ + off + 4); }
                    __builtin_amdgcn_sched_barrier(0);
#pragma unroll
                    for (int q = 0; q < 8; ++q) { const size_t off = (size_t)((q >> 2) * 128 + (q & 3) * 16 + rloc0) * DMODEL + c0;
                        store8(HB + off, h0[q] + g0 * acc[q >> 2][bj][q & 3][0], h1[q] + g1 * acc[q >> 2][bj][q & 3][1]); }
                } else { u32x4 hw[8];
#pragma unroll
                    for (int q = 0; q < 8; ++q) { const size_t off = (size_t)((q >> 2) * 128 + (q & 3) * 16 + rloc0) * DMODEL + c0; hw[q] = *(const u32x4*)(HB + off); }
                    __builtin_amdgcn_sched_barrier(0);
#pragma unroll
                    for (int q = 0; q < 8; ++q) { const size_t off = (size_t)((q >> 2) * 128 + (q & 3) * 16 + rloc0) * DMODEL + c0;
                        const f32x4 h0 = (f32x4){bflo(hw[q].x), bfhi(hw[q].x), bflo(hw[q].y), bfhi(hw[q].y)}, h1 = (f32x4){bflo(hw[q].z), bfhi(hw[q].z), bflo(hw[q].w), bfhi(hw[q].w)};
                        store8(HB + off, h0 + g0 * acc[q >> 2][bj][q & 3][0], h1 + g1 * acc[q >> 2][bj][q & 3][1]); }
                }
                __builtin_amdgcn_sched_barrier(0);
            }
        } else if (UPK) {
            bf16_t* HH = (bf16_t*)(ws + R_HH); float* EP = (float*)(ws + WS_EDGE); float* EG = EP + EDGE_ARR / 4; float* EA = EG + EDGE_ARR / 4;
            const int jc = u.pn * 128 + wc * 32 + 8 * fq;
            float w0[8], w1[8], w2[8], cbv[8], pvv[8], nxx[8]; const LAS float* cl = scr + buf * 512 + wc * 32 + 8 * fq;
#pragma unroll
            for (int c = 0; c < 8; ++c) { w0[c] = cl[c]; w1[c] = cl[128 + c]; w2[c] = cl[256 + c]; cbv[c] = cl[384 + c];
                const float pv_ = __shfl_up(acc[1][0][3][c >> 2][c & 3], 1, 16), nx_ = __shfl_down(acc[0][0][0][c >> 2][c & 3], 1, 16);
                pvv[c] = fr == 0 ? 0.f : pv_; nxx[c] = fr == 15 ? 0.f : nx_; }
            const size_t tok0 = (size_t)u.pm * 256 + wr * 128 + 8 * fr; const int blk = 2 * u.pm + wr;
#pragma unroll
            for (int ai = 0; ai < 2; ++ai)
#pragma unroll
                for (int m = 0; m < 4; ++m) {
                    const int idx = 4 * ai + m; float hv[8], av[8], gv[8];
#pragma unroll
                    for (int c = 0; c < 8; ++c) { const int n = c >> 2, jj = c & 3;
                        const float cur = acc[ai][0][m][n][jj];
                        const float prev = idx == 0 ? pvv[c] : (m > 0 ? acc[ai][0][m - 1][n][jj] : acc[0][0][3][n][jj]);
                        const float next = idx == 7 ? nxx[c] : (m < 3 ? acc[ai][0][m + 1][n][jj] : acc[1][0][0][n][jj]);
                        const float cv = cbv[c] + w0[c] * prev + w1[c] * cur + w2[c] * next;
                        av[c] = cur; gv[c] = acc[ai][1][m][n][jj]; hv[c] = cv; }
                    const bool edge0 = (idx == 0 && fr == 0), edge1 = (idx == 7 && fr == 15);
                    if (edge0 || edge1) { const size_t eo = ((size_t)blk * 2 + (edge1 ? 1 : 0)) * FFH + jc;
#pragma unroll
                        for (int c = 0; c < 8; ++c) { EP[eo + c] = hv[c]; EG[eo + c] = gv[c]; EA[eo + c] = av[c]; }
                    } else { f32x4 o0, o1;
#pragma unroll
                        for (int c = 0; c < 4; ++c) { o0[c] = gelu_t(hv[c]) * gv[c]; o1[c] = gelu_t(hv[4 + c]) * gv[4 + c]; }
                        store8(HH + ((size_t)(u.pn * 4 + wc) * TT + tok0 + idx) * 32 + 8 * fq, o0, o1); }
                }
        } else if (!UPK && kind == EK_S5E) {
            bf16_t* E = (bf16_t*)(ws + WS_XN);
#pragma unroll
            for (int bj = 0; bj < 2; ++bj)
#pragma unroll
                for (int ai = 0; ai < 2; ++ai)
#pragma unroll
                    for (int m = 0; m < 4; ++m) store8(E + ((size_t)u.pm * 256 + ai * 128 + m * 16 + rloc0) * 256 + bj * 128 + wc * 32 + 8 * fq, acc[ai][bj][m][0], acc[ai][bj][m][1]);
        } else if (!UPK && kind == EK_S5Y) {
            bf16_t* G = (bf16_t*)(ws + R_G); const int g = u.pn, j9 = u.pm - 9 * g;
#pragma unroll
            for (int bj = 0; bj < 2; ++bj) { const int n0 = bj * 128 + wc * 32 + 8 * fq, t = n0 >> 4, h0 = n0 & 15;
#pragma unroll
                for (int ai = 0; ai < 2; ++ai)
#pragma unroll
                    for (int m = 0; m < 4; ++m) { const int cr = j9 * 256 + ai * 128 + m * 16 + rloc0, b = cr / 144, c = cr - b * 144;
                        f32x4 v0 = acc[ai][bj][m][0], v1 = acc[ai][bj][m][1];
#pragma unroll
                        for (int q = 0; q < 4; ++q) { v0[q] = gelu_t(v0[q]); v1[q] = gelu_t(v1[q]); }
                        store8(G + ((size_t)b * RB + 16 * c + t) * 512 + 16 * g + h0, v0, v1); } }
        } else if (!UPK && kind == EK_INCD) {
            const int pn = u.pn; const int grp = pn < 2 ? 0 : pn < 4 ? 1 : pn < 6 ? 2 : pn < 8 ? 3 : pn < 10 ? 4 : pn == 10 ? 5 : 6;
            const bool roped = (grp == 0 || grp == 1 || grp == 4 || grp == 5), hnorm = (grp == 4 || grp == 5);
            bf16_t* CAT1 = (bf16_t*)(ws + R_CAT1); const float* cs = (const float*)(ws + WS_R128C); const float* sn = (const float*)(ws + WS_R128S);
            float rs[2][2][4];
            if (hnorm) {
#pragma unroll
                for (int bj = 0; bj < 2; ++bj)
#pragma unroll
                    for (int ai = 0; ai < 2; ++ai)
#pragma unroll
                        for (int m = 0; m < 4; ++m) { const f32x4 v0 = acc[ai][bj][m][0], v1 = acc[ai][bj][m][1];
                            float s = (v0[0] * v0[0] + v0[1] * v0[1]) + (v0[2] * v0[2] + v0[3] * v0[3]) + (v1[0] * v1[0] + v1[1] * v1[1]) + (v1[2] * v1[2] + v1[3] * v1[3]);
                            s += __shfl_xor(s, 16); s += __shfl_xor(s, 32);
                            if (fq == 0) scr[(((wr * 2 + bj) * 8 + ai * 4 + m) * 16 + fr) * 4 + wc] = s; }
                asm volatile("s_waitcnt lgkmcnt(0)" ::: "memory"); __builtin_amdgcn_s_barrier(); asm volatile("" ::: "memory");
#pragma unroll
                for (int bj = 0; bj < 2; ++bj)
#pragma unroll
                    for (int ai = 0; ai < 2; ++ai)
#pragma unroll
                        for (int m = 0; m < 4; ++m) { const f32x4 p = *(const LAS f32x4*)(scr + (((wr * 2 + bj) * 8 + ai * 4 + m) * 16 + fr) * 4);
                            rs[bj][ai][m] = rsqrtf(((p[0] + p[1]) + (p[2] + p[3])) * (1.f / 128.f) + EPS_N); }
                asm volatile("s_waitcnt lgkmcnt(0)" ::: "memory"); __builtin_amdgcn_s_barrier(); asm volatile("" ::: "memory");
            }
            const int dloc = 32 * wc + 8 * fq;
            bf16_t* dbase; int dld;
            if (grp == 0) { dbase = CAT1; dld = 1024; } else if (grp == 1) { dbase = (bf16_t*)(ws + R_RK); dld = 512; } else if (grp == 2) { dbase = (bf16_t*)(ws + R_RV); dld = 512; }
            else if (grp == 3) { dbase = (bf16_t*)(ws + R_RG); dld = 512; } else if (grp == 4) { dbase = CAT1 + 512; dld = 1024; } else if (grp == 5) { dbase = (bf16_t*)(ws + R_GK); dld = 256; } else { dbase = (bf16_t*)(ws + R_GV); dld = 256; }
            float gw[8];
            if (hnorm) {
#pragma unroll
                for (int c = 0; c < 8; ++c) { const int dp = dloc + c, orig = (dp & 64) + ((dp & 1) ? 32 : 0) + ((dp & 63) >> 1); gw[c] = (grp == 4 ? gq : gk)[orig]; }
            }
#pragma unroll
            for (int ai = 0; ai < 2; ++ai)
#pragma unroll
                for (int m = 0; m < 4; ++m) {
                    const int rl = ai * 128 + m * 16 + rloc0; const size_t row = (size_t)u.pm * 256 + rl;
                    f32x4 c4 = {}, s4 = {};
                    if (roped && lat) { const int t = (jt - 1) * 256 + rl; const int ti = t * 64 + 32 * (wc >> 1) + 16 * (wc & 1) + 4 * fq; c4 = *(const f32x4*)(cs + ti); s4 = *(const f32x4*)(sn + ti); }
#pragma unroll
                    for (int bj = 0; bj < 2; ++bj) {
                        const int hh = (grp >= 5) ? bj : (pn & 1) * 2 + bj;
                        f32x4 v0 = acc[ai][bj][m][0], v1 = acc[ai][bj][m][1];
                        if (hnorm) { const float r = rs[bj][ai][m];
#pragma unroll
                            for (int c = 0; c < 4; ++c) { v0[c] = v0[c] * r * gw[c]; v1[c] = v1[c] * r * gw[4 + c]; } }
                        if (grp == 1) { v0 = v0 * 0.08838834764831845f; v1 = v1 * 0.08838834764831845f; }
                        if (roped && lat) {
                            f32x4 o0, o1;
                            o0[0] = v0[0] * c4[0] - v0[1] * s4[0]; o0[1] = v0[1] * c4[0] + v0[0] * s4[0]; o0[2] = v0[2] * c4[1] - v0[3] * s4[1]; o0[3] = v0[3] * c4[1] + v0[2] * s4[1];
                            o1[0] = v1[0] * c4[2] - v1[1] * s4[2]; o1[1] = v1[1] * c4[2] + v1[0] * s4[2]; o1[2] = v1[2] * c4[3] - v1[3] * s4[3]; o1[3] = v1[3] * c4[3] + v1[2] * s4[3];
                            v0 = o0; v1 = o1;
                        }
                        bf16_t* dst = dbase + row * dld + 128 * hh + dloc;
                        store8(dst, v0, v1);
                    }
            }
        }
    }
};
namespace att {
constexpr int NW = 8, QBLK = 32, KVBLK = 64;
constexpr float THR = 8.f;
#define SBAR() __builtin_amdgcn_sched_barrier(0)
__device__ __forceinline__ int crow(int r, int hi) { return (r & 3) + 8 * (r >> 2) + 4 * hi; }
__device__ __forceinline__ int v_st(int k, int c) { const int kk = (k & ~0xC) | ((k & 4) << 1) | ((k & 8) >> 1); return ((kk >> 3) * 4 + (c >> 5)) * 512 + ((kk & 7) * 32 + (c & 31)) * 2; }
__device__ __forceinline__ int v_rd_base(int lane) { return ((lane & 3) << 3) | (((lane >> 2) & 3) << 6) | (((lane >> 4) & 1) << 5) | (((lane >> 5) & 1) << 8); }
constexpr int v_rd_off(int d0, int ks, int half) { return d0 * 512 + ks * 4096 + half * 2048; }
template <int OFF> __device__ __forceinline__ s16x4 tr_read(int vb) { s16x4 r; asm volatile("ds_read_b64_tr_b16 %0, %1 offset:%2" : "=&v"(r) : "v"(vb), "i"(OFF) : "memory"); return r; }
template <int D0> __device__ __forceinline__ void pv_one(f32x16& od, int vb, bf16x8 pa0, bf16x8 pa1, bf16x8 pa2, bf16x8 pa3) {
  const s16x4 l0 = tr_read<v_rd_off(D0, 0, 0)>(vb), h0 = tr_read<v_rd_off(D0, 0, 1)>(vb), l1 = tr_read<v_rd_off(D0, 1, 0)>(vb), h1 = tr_read<v_rd_off(D0, 1, 1)>(vb);
  const s16x4 l2 = tr_read<v_rd_off(D0, 2, 0)>(vb), h2 = tr_read<v_rd_off(D0, 2, 1)>(vb), l3 = tr_read<v_rd_off(D0, 3, 0)>(vb), h3 = tr_read<v_rd_off(D0, 3, 1)>(vb);
  asm volatile("s_waitcnt lgkmcnt(0)" ::: "memory"); SBAR();
#define PK(L, H) (bf16x8){L[0], L[1], L[2], L[3], H[0], H[1], H[2], H[3]}
  od = __builtin_amdgcn_mfma_f32_32x32x16_bf16(pa0, PK(l0, h0), od, 0, 0, 0);
  od = __builtin_amdgcn_mfma_f32_32x32x16_bf16(pa1, PK(l1, h1), od, 0, 0, 0);
  od = __builtin_amdgcn_mfma_f32_32x32x16_bf16(pa2, PK(l2, h2), od, 0, 0, 0);
  od = __builtin_amdgcn_mfma_f32_32x32x16_bf16(pa3, PK(l3, h3), od, 0, 0, 0);
#undef PK
}
__device__ __forceinline__ void pv_d0(f32x16* o, int vb, bf16x8 pa0, bf16x8 pa1, bf16x8 pa2, bf16x8 pa3) {
  pv_one<0>(o[0], vb, pa0, pa1, pa2, pa3); pv_one<1>(o[1], vb, pa0, pa1, pa2, pa3); pv_one<2>(o[2], vb, pa0, pa1, pa2, pa3); pv_one<3>(o[3], vb, pa0, pa1, pa2, pa3);
}
__device__ __forceinline__ void pack_p(const f32x16& p0, const f32x16& p1, bf16x8& pa0, bf16x8& pa1, bf16x8& pa2, bf16x8& pa3) {
#define PK4(P, BASE, OUT) do { unsigned a0 = pk2(P[BASE + 0], P[BASE + 1]), a1 = pk2(P[BASE + 2], P[BASE + 3]);   \
    unsigned b0 = pk2(P[BASE + 4], P[BASE + 5]), b1 = pk2(P[BASE + 6], P[BASE + 7]);                              \
    auto r0 = __builtin_amdgcn_permlane32_swap(a0, b0, false, false); auto r1 = __builtin_amdgcn_permlane32_swap(a1, b1, false, false); \
    u32x4 w = {r0[0], r1[0], r0[1], r1[1]}; OUT = __builtin_bit_cast(bf16x8, w); } while (0)
  PK4(p0, 0, pa0); PK4(p0, 8, pa1); PK4(p1, 0, pa2); PK4(p1, 8, pa3);
#undef PK4
}
template <int DQK>
__device__ __forceinline__ void partialSM(f32x16& p0, f32x16& p1, float& m_reg, float& mn, float& alpha) {
  constexpr float SCALE = DQK == 128 ? 0.088388347648318440f : 0.072168783648703220f;
  constexpr float C = SCALE * LOG2E;
  float pmax = p0[0];
#pragma unroll
  for (int r = 1; r < 16; ++r) pmax = fmaxf(pmax, p0[r]);
#pragma unroll
  for (int r = 0; r < 16; ++r) pmax = fmaxf(pmax, p1[r]);
  { auto rr = __builtin_amdgcn_permlane32_swap(__float_as_uint(pmax), __float_as_uint(pmax), false, false);
    pmax = fmaxf(__uint_as_float(rr[0]), __uint_as_float(rr[1])); }
  if (__builtin_expect(__all(pmax - m_reg <= THR / SCALE), 1)) { mn = m_reg; alpha = 1.f; }
  else { mn = fmaxf(m_reg, pmax); alpha = __builtin_amdgcn_exp2f((m_reg - mn) * C); m_reg = mn; }
  const float mnC = -mn * C;
#pragma unroll
  for (int r = 0; r < 16; ++r) p0[r] = fmaf(p0[r], C, mnC);
#pragma unroll
  for (int r = 0; r < 16; ++r) p1[r] = fmaf(p1[r], C, mnC);
#pragma unroll
  for (int r = 0; r < 16; ++r) p0[r] = __builtin_amdgcn_exp2f(p0[r]);
}
__device__ __forceinline__ void finishSM(f32x16& p0, f32x16& p1, float alpha, float& l_reg, bf16x8& pa0, bf16x8& pa1, bf16x8& pa2, bf16x8& pa3) {
#pragma unroll
  for (int r = 0; r < 16; ++r) p1[r] = __builtin_amdgcn_exp2f(p1[r]);
  float ps = 0;
#pragma unroll
  for (int r = 0; r < 16; ++r) ps += p0[r];
#pragma unroll
  for (int r = 0; r < 16; ++r) ps += p1[r];
  { auto rr = __builtin_amdgcn_permlane32_swap(__float_as_uint(ps), __float_as_uint(ps), false, false);
    ps = __uint_as_float(rr[0]) + __uint_as_float(rr[1]); }
  l_reg = l_reg * alpha + ps;
  pack_p(p0, p1, pa0, pa1, pa2, pa3);
}
__device__ __forceinline__ void ret_weights(f32x16& p0, f32x16& p1, int kind, float dnb  , float lf2, float lb2) {
  if (kind == 0) {
    const float a = lf2 * dnb;
#pragma unroll
    for (int r = 0; r < 16; ++r) { const float c = (float)((r & 3) + 8 * (r >> 2));
      p0[r] *= __builtin_amdgcn_exp2f(fmaf(-lf2, c, a)); p1[r] *= __builtin_amdgcn_exp2f(fmaf(-lf2, c + 32.f, a)); }
  } else if (kind == 1) {
    const float a = -lb2 * dnb;
#pragma unroll
    for (int r = 0; r < 16; ++r) { const float c = (float)((r & 3) + 8 * (r >> 2));
      p0[r] *= __builtin_amdgcn_exp2f(fmaf(lb2, c, a)); p1[r] *= __builtin_amdgcn_exp2f(fmaf(lb2, c + 32.f, a)); }
  } else if (kind == 2) {
#pragma unroll
    for (int r = 0; r < 16; ++r) { const float c = (float)((r & 3) + 8 * (r >> 2));
      const float d0 = dnb - c, d1 = dnb - c - 32.f;
      const float w0 = (d0 >= 0.f ? __builtin_amdgcn_exp2f(lf2 * d0) : 0.f) + (d0 <= 0.f ? __builtin_amdgcn_exp2f(-lb2 * d0) : 0.f);
      const float w1 = (d1 >= 0.f ? __builtin_amdgcn_exp2f(lf2 * d1) : 0.f) + (d1 <= 0.f ? __builtin_amdgcn_exp2f(-lb2 * d1) : 0.f);
      p0[r] *= w0; p1[r] *= w1; }
  } else {
#pragma unroll
    for (int r = 0; r < 16; ++r) { const float c = (float)((r & 3) + 8 * (r >> 2));
      const float d0 = dnb - c, d1 = dnb - c - 32.f;
      p0[r] *= __builtin_amdgcn_exp2f(lf2 * d0) + __builtin_amdgcn_exp2f(lb2 * (2304.f - d0));
      p1[r] *= __builtin_amdgcn_exp2f(lf2 * d1) + __builtin_amdgcn_exp2f(lb2 * (2304.f - d1)); }
  }
}

template <int DQK> struct Shm { static constexpr int V = KVBLK * 128 * 2, K = KVBLK * DQK * 2, WSO = 2 * V + 2 * K, TOTAL = WSO + NW * 64 * 4; };

template <int DQK, int MODE, int SDEPTH, int ldq, int ldk, int ldv, int ldo, int ldg>
__device__ __forceinline__ void attn_unit(const bf16_t* Qb, const bf16_t* __restrict__ Kh, const bf16_t* __restrict__ Vh, bf16_t* Ob, int seq, char* lds,
                                          int n0, float lf2, float lb2, const bf16_t* Gb) {
  using SH = Shm<DQK>;
  constexpr int ND = DQK / 16, NKC = DQK / 8, KPT = DQK / 64, NLD = 2 + KPT;
#define KSWZ(row, colB) ((row) * (DQK * 2) + ((colB) ^ (((row) & 7) << 4)))
  int tid_ = threadIdx.x; asm volatile("" : "+v"(tid_));
  const int tid = tid_, wid = tid >> 6, lane = tid & 63, r32 = lane & 31, hi = lane >> 5;
  char* V_lds = lds; char* K_lds = lds + 2 * SH::V;
  float* ws = (float*)(lds + SH::WSO) + wid * 64; float* li_l = ws; float* al_l = ws + 32;
  float m_reg = -1e30f, l_reg = 0; f32x16 o[4] = {}; bf16x8 qr[ND];
  const bf16_t* Qw = Qb + (long)(wid * QBLK + r32) * ldq + hi * 8;
#pragma unroll
  for (int d0 = 0; d0 < ND; ++d0) qr[d0] = *reinterpret_cast<const bf16x8*>(Qw + d0 * 16);
  const int sr = tid >> 4, sc = (tid & 15) * 8, vst0 = v_st(sr, sc), vst1 = v_st(32 + sr, sc);
  int krow[KPT], kcol[KPT];
#pragma unroll
  for (int i = 0; i < KPT; ++i) { const int id = tid + 512 * i; krow[i] = id / NKC; kcol[i] = (id % NKC) * 8; }
  const int vb0 = (int)(uintptr_t)V_lds + v_rd_base(lane);
  struct { bf16x8 vs0, vs1, ks[KPT]; } sr_[SDEPTH == 0 ? 1 : SDEPTH];
  constexpr int SE = 0, SO = SDEPTH == 2 ? 1 : 0;
#define SLOAD(i, k0) do { sr_[i].vs0 = *reinterpret_cast<const bf16x8*>(&Vh[(long)((k0) + sr) * ldv + sc]); sr_[i].vs1 = *reinterpret_cast<const bf16x8*>(&Vh[(long)((k0) + 32 + sr) * ldv + sc]); \
    _Pragma("unroll") for (int q_ = 0; q_ < KPT; ++q_) sr_[i].ks[q_] = *reinterpret_cast<const bf16x8*>(&Kh[(long)((k0) + krow[q_]) * ldk + kcol[q_]]); } while (0)
#define SWRITE(b, i) do { *(bf16x8*)(V_lds + (b) * SH::V + vst0) = sr_[i].vs0; *(bf16x8*)(V_lds + (b) * SH::V + vst1) = sr_[i].vs1; \
    _Pragma("unroll") for (int q_ = 0; q_ < KPT; ++q_) *(bf16x8*)(K_lds + (b) * SH::K + KSWZ(krow[q_], kcol[q_] * 2)) = sr_[i].ks[q_]; } while (0)
#define SWAIT() do { if constexpr (SDEPTH == 1) asm volatile("s_waitcnt vmcnt(0)" ::: "memory"); else if constexpr (NLD == 4) asm volatile("s_waitcnt vmcnt(4)" ::: "memory"); else asm volatile("s_waitcnt vmcnt(5)" ::: "memory"); } while (0)
#define RESC(a) do { if (__any((a) < 1.f)) { if (hi == 0) al_l[r32] = (a); asm volatile("s_waitcnt lgkmcnt(0)" ::: "memory"); \
    _Pragma("unroll") for (int d = 0; d < 4; ++d) _Pragma("unroll") for (int r = 0; r < 16; ++r) o[d][r] *= al_l[crow(r, hi)]; } } while (0)
#define QKT(P0, P1, Kbuf) do { P0 = f32x16{}; P1 = f32x16{}; _Pragma("unroll") for (int d0 = 0; d0 < ND; ++d0) { const int cb = (d0 * 16 + hi * 8) * 2; \
    const bf16x8 b0 = *reinterpret_cast<const bf16x8*>((Kbuf) + KSWZ(r32, cb)); const bf16x8 b1 = *reinterpret_cast<const bf16x8*>((Kbuf) + KSWZ(32 + r32, cb)); \
    P0 = __builtin_amdgcn_mfma_f32_32x32x16_bf16(b0, qr[d0], P0, 0, 0, 0); P1 = __builtin_amdgcn_mfma_f32_32x32x16_bf16(b1, qr[d0], P1, 0, 0, 0); } } while (0)
  const int qb4 = n0 >> 6;
  const float nlane = (float)(n0 + wid * QBLK + r32 - 4 * hi);
#define TKIND(tj) ((tj) < 4 ? 3 : ((tj) - 4 < qb4 ? 0 : ((tj) - 4 >= qb4 + 4 ? 1 : 2)))
#define PART(P0, P1, tj, MN, AL) do { if constexpr (MODE == 0) partialSM<DQK>(P0, P1, m_reg, MN, AL); else ret_weights(P0, P1, TKIND(tj), nlane - (float)(64 * (tj) - 256), lf2, lb2); } while (0)
#define FIN(P0, P1, AL) do { if constexpr (MODE == 0) finishSM(P0, P1, AL, l_reg, pa0, pa1, pa2, pa3); else pack_p(P0, P1, pa0, pa1, pa2, pa3); } while (0)
  f32x16 pA0, pA1, pB0, pB1; float mnA = 0.f, mnB = 0.f, alA = 1.f, alB = 1.f; bf16x8 pa0, pa1, pa2, pa3; const int NT = seq / KVBLK;
  if constexpr (SDEPTH == 0) {
    SLOAD(0, 0); asm volatile("s_waitcnt vmcnt(0)" ::: "memory"); SWRITE(0, 0); __syncthreads();
#pragma unroll 1
    for (int j = 0; j < NT; ++j) {
      const int bsel = j & 1;
      if (j + 1 < NT) SLOAD(0, (j + 1) * KVBLK);
      SBAR(); QKT(pA0, pA1, K_lds + bsel * SH::K);
      PART(pA0, pA1, j, mnA, alA);
      if constexpr (MODE == 0) RESC(alA);
      FIN(pA0, pA1, alA); SBAR();
      pv_d0(o, vb0 + bsel * SH::V, pa0, pa1, pa2, pa3);
      if (j + 1 < NT) { asm volatile("s_waitcnt vmcnt(0)" ::: "memory"); SWRITE(bsel ^ 1, 0); }
      __syncthreads();
    }
  } else {
    SLOAD(SE, 0); asm volatile("s_waitcnt vmcnt(0)" ::: "memory"); SWRITE(0, SE); __syncthreads();
    QKT(pA0, pA1, K_lds); PART(pA0, pA1, 0, mnA, alA);
    SLOAD(SO, KVBLK); if constexpr (SDEPTH == 2) { if (2 < NT) SLOAD(SE, 2 * KVBLK); }
    SWAIT(); SWRITE(1, SO); __syncthreads();
#pragma unroll 1
    for (int j = 1; j + 1 < NT; j += 2) {
      SBAR(); QKT(pB0, pB1, K_lds + SH::K);
      FIN(pA0, pA1, alA); SBAR();
      SLOAD(SO, (j + SDEPTH) * KVBLK); SBAR();
      pv_d0(o, vb0, pa0, pa1, pa2, pa3); PART(pB0, pB1, j, mnB, alB);
      __syncthreads(); SWAIT(); SWRITE(0, SE);
      if constexpr (MODE == 0) RESC(alB);
      __syncthreads();
      SBAR(); QKT(pA0, pA1, K_lds);
      FIN(pB0, pB1, alB); SBAR();
      if (SDEPTH == 1 || j + 3 < NT) SLOAD(SE, (j + 1 + SDEPTH) * KVBLK); SBAR();
      pv_d0(o, vb0 + SH::V, pa0, pa1, pa2, pa3); PART(pA0, pA1, j + 1, mnA, alA);
      __syncthreads(); SWAIT(); SWRITE(1, SO);
      if constexpr (MODE == 0) RESC(alA);
      __syncthreads();
    }
    SBAR(); QKT(pB0, pB1, K_lds + SH::K);
    FIN(pA0, pA1, alA); SBAR();
    pv_d0(o, vb0, pa0, pa1, pa2, pa3); PART(pB0, pB1, NT - 1, mnB, alB);
    __syncthreads();
    if constexpr (MODE == 0) RESC(alB);
    FIN(pB0, pB1, alB); SBAR();
    pv_d0(o, vb0 + SH::V, pa0, pa1, pa2, pa3);
  }
  bf16_t* Ow = Ob + (long)(wid * QBLK) * ldo;
  if constexpr (MODE == 0) {
    if (hi == 0) li_l[r32] = l_reg; asm volatile("s_waitcnt lgkmcnt(0)" ::: "memory");
    float rli[16];
#pragma unroll
    for (int r = 0; r < 16; ++r) rli[r] = __builtin_amdgcn_rcpf(li_l[crow(r, hi)]);
    __syncthreads();
    bf16_t* stg = (bf16_t*)(lds + wid * 8192);
#pragma unroll
    for (int r = 0; r < 16; ++r) { const int orow = crow(r, hi);
#pragma unroll
      for (int d0 = 0; d0 < 4; ++d0) stg[orow * 128 + d0 * 32 + r32] = f2bf(o[d0][r] * rli[r]); }
    asm volatile("s_waitcnt lgkmcnt(0)" ::: "memory");
#pragma unroll
    for (int i = 0; i < 8; ++i) { const int row = i * 4 + (lane >> 4), ch = lane & 15; const u32x4 v = *(const u32x4*)(stg + row * 128 + ch * 8); *(u32x4*)(Ow + (long)row * ldo + ch * 8) = v; }
  } else {
    const bf16_t* Gw = Gb + (long)(wid * QBLK) * ldg;
#pragma unroll
    for (int r = 0; r < 16; ++r) {
      float ss = (o[0][r] * o[0][r] + o[1][r] * o[1][r]) + (o[2][r] * o[2][r] + o[3][r] * o[3][r]);
#pragma unroll
      for (int off = 1; off < 32; off <<= 1) ss += __shfl_xor(ss, off);
      const float rs = rsqrtf(ss * (1.f / 128.f) + EPS_N); const int orow = crow(r, hi);
#pragma unroll
      for (int d0 = 0; d0 < 4; ++d0) { const float g = bf1(Gw[(long)orow * ldg + d0 * 32 + r32]); Ow[(long)orow * ldo + d0 * 32 + r32] = f2bf(o[d0][r] * rs * silu_t(g)); }
      SBAR();
    }
  }
  __syncthreads();
#undef KSWZ
#undef SLOAD
#undef SWRITE
#undef SWAIT
#undef RESC
#undef QKT
#undef TKIND
#undef PART
#undef FIN
}

__device__ __forceinline__ void ret_state_unit(const bf16_t* __restrict__ Kh, const bf16_t* __restrict__ Vh, bf16_t* ST  , int dir, int hf  , float l2, char* lds) {
  int tid_ = threadIdx.x; asm volatile("" : "+v"(tid_));
  const int tid = tid_, wid = tid >> 6, lane = tid & 63, r32 = lane & 31, hi = lane >> 5, d0k = wid & 3, dvp = wid >> 2;
  constexpr int SHV = KVBLK * 128 * 2; char* K_lds = lds; char* V_lds = lds + 2 * SHV;
  const int sr = tid >> 4, sc = (tid & 15) * 8, vst0 = v_st(sr, sc), vst1 = v_st(32 + sr, sc);
  const float w0 = dir ? __builtin_amdgcn_exp2f(l2 * (float)sr) : __builtin_amdgcn_exp2f(l2 * (float)(63 - sr)), w1 = dir ? __builtin_amdgcn_exp2f(l2 * (float)(32 + sr)) : __builtin_amdgcn_exp2f(l2 * (float)(31 - sr));
  const float dec64 = __builtin_amdgcn_exp2f(64.f * l2);
  const int kb = (int)(uintptr_t)K_lds + v_rd_base(lane) + d0k * 512, vb = (int)(uintptr_t)V_lds + v_rd_base(lane) + (2 * hf + dvp) * 512;
  f32x16 o0 = {}, o1 = {};
  bf16x8 ks0, ks1, vs0, vs1;
#define RS_TILE(s) (dir ? ((s) < 4 ? 3 - (s) : 39 - (s)) : (s))
#define RS_LOAD(s) do { const long k0 = 64L * RS_TILE(s); ks0 = *reinterpret_cast<const bf16x8*>(&Kh[(k0 + sr) * 512 + sc]); ks1 = *reinterpret_cast<const bf16x8*>(&Kh[(k0 + 32 + sr) * 512 + sc]); \
    vs0 = *reinterpret_cast<const bf16x8*>(&Vh[(k0 + sr) * 512 + sc]); vs1 = *reinterpret_cast<const bf16x8*>(&Vh[(k0 + 32 + sr) * 512 + sc]); } while (0)
#define RS_SCALE(VV, SCL) do { const u32x4 u_ = __builtin_bit_cast(u32x4, VV); u32x4 r_; r_[0] = pk2(bflo(u_[0]) * (SCL), bfhi(u_[0]) * (SCL)); r_[1] = pk2(bflo(u_[1]) * (SCL), bfhi(u_[1]) * (SCL)); \
    r_[2] = pk2(bflo(u_[2]) * (SCL), bfhi(u_[2]) * (SCL)); r_[3] = pk2(bflo(u_[3]) * (SCL), bfhi(u_[3]) * (SCL)); VV = __builtin_bit_cast(bf16x8, r_); } while (0)
#define RS_WRITE(b) do { *(bf16x8*)(K_lds + (b) * SHV + vst0) = ks0; *(bf16x8*)(K_lds + (b) * SHV + vst1) = ks1; RS_SCALE(vs0, w0); RS_SCALE(vs1, w1); \
    *(bf16x8*)(V_lds + (b) * SHV + vst0) = vs0; *(bf16x8*)(V_lds + (b) * SHV + vst1) = vs1; } while (0)
  RS_LOAD(0); asm volatile("s_waitcnt vmcnt(0)" ::: "memory"); RS_WRITE(0); __syncthreads();
#pragma unroll 1
  for (int s = 0; s < 36; ++s) {
    const int bsel = s & 1;
    if (s + 1 < 36) RS_LOAD(s + 1);
    SBAR();
    if (s >= 4 && ((s - 4) & 3) == 0) {
      const int uq = dir ? 7 - ((s - 4) >> 2) : ((s - 4) >> 2); bf16_t* dst = ST + (size_t)uq * 16384 + (size_t)(32 * d0k) * 128 + 32 * (2 * hf + dvp) + r32;
#pragma unroll
      for (int r = 0; r < 16; ++r) { const int row = crow(r, hi); dst[row * 128] = f2bf(o0[r] + o1[r]); }
    }
#pragma unroll
    for (int r = 0; r < 16; ++r) { o0[r] *= dec64; o1[r] *= dec64; }
    const int kbb = kb + bsel * SHV, vbb = vb + bsel * SHV;
#define RS_RD(KS) const s16x4 al##KS = tr_read<(KS) * 4096>(kbb), ah##KS = tr_read<(KS) * 4096 + 2048>(kbb), bl##KS = tr_read<(KS) * 4096>(vbb), bh##KS = tr_read<(KS) * 4096 + 2048>(vbb)
    RS_RD(0); RS_RD(1); RS_RD(2); RS_RD(3);
#undef RS_RD
    asm volatile("s_waitcnt lgkmcnt(0)" ::: "memory"); SBAR();
#define RS_MM(KS, ACC) ACC = __builtin_amdgcn_mfma_f32_32x32x16_bf16((bf16x8){al##KS[0], al##KS[1], al##KS[2], al##KS[3], ah##KS[0], ah##KS[1], ah##KS[2], ah##KS[3]}, \
      (bf16x8){bl##KS[0], bl##KS[1], bl##KS[2], bl##KS[3], bh##KS[0], bh##KS[1], bh##KS[2], bh##KS[3]}, ACC, 0, 0, 0)
    RS_MM(0, o0); RS_MM(1, o1); RS_MM(2, o0); RS_MM(3, o1);
#undef RS_MM
    if (s + 1 < 36) {
      if (s >= 4 && ((s - 4) & 3) == 0) asm volatile("s_waitcnt vmcnt(16)" ::: "memory"); else asm volatile("s_waitcnt vmcnt(0)" ::: "memory");
      RS_WRITE(bsel ^ 1); }
    __syncthreads();
  }
#undef RS_TILE
#undef RS_LOAD
#undef RS_SCALE
#undef RS_WRITE
}

__device__ __forceinline__ void ret_out_unit(bf16_t* Qb  , const bf16_t* __restrict__ Kh, const bf16_t* __restrict__ Vh, const bf16_t* __restrict__ Sf, const bf16_t* __restrict__ Sb,
                                             const bf16_t* Gb, float lf2, float lb2, char* lds) {
  using SH = Shm<128>;
  int tid_ = threadIdx.x; asm volatile("" : "+v"(tid_));
  const int tid = tid_, wid = tid >> 6, lane = tid & 63, r32 = lane & 31, hi = lane >> 5;
  char* V_lds = lds; char* K_lds = lds + 2 * SH::V;
  f32x16 o[4] = {}; bf16x8 qr[8];
  const bf16_t* Qw = Qb + (long)(wid * QBLK + r32) * 1024 + hi * 8;
#pragma unroll
  for (int d0 = 0; d0 < 8; ++d0) qr[d0] = *reinterpret_cast<const bf16x8*>(Qw + d0 * 16);
  const int sr = tid >> 4, sc = (tid & 15) * 8, vst0 = v_st(sr, sc), vst1 = v_st(32 + sr, sc);
  const int vb0 = (int)(uintptr_t)V_lds + v_rd_base(lane);
  const float nrel = (float)(wid * QBLK + r32), nlane = nrel - 4.f * (float)hi;
  const float ff = __builtin_amdgcn_exp2f(lf2 * (nrel + 1.f)), fb = __builtin_amdgcn_exp2f(lb2 * (256.f - nrel));
  bf16x8 vs0, vs1, ks0, ks1;
#define KSWZ(row, colB) ((row) * 256 + ((colB) ^ (((row) & 7) << 4)))
#define RO_LOAD(j) do { if ((j) < 4) { const long k0 = 64L * (j); vs0 = *reinterpret_cast<const bf16x8*>(&Vh[(k0 + sr) * 512 + sc]); vs1 = *reinterpret_cast<const bf16x8*>(&Vh[(k0 + 32 + sr) * 512 + sc]); \
      ks0 = *reinterpret_cast<const bf16x8*>(&Kh[(k0 + sr) * 512 + sc]); ks1 = *reinterpret_cast<const bf16x8*>(&Kh[(k0 + 32 + sr) * 512 + sc]); } \
    else { const bf16_t* S_ = ((j) < 6 ? Sf : Sb) + (size_t)(((j) & 1) * 64) * 128; vs0 = *reinterpret_cast<const bf16x8*>(&S_[sr * 128 + sc]); vs1 = *reinterpret_cast<const bf16x8*>(&S_[(32 + sr) * 128 + sc]); } } while (0)
#define RO_WRITE(b, j) do { *(bf16x8*)(V_lds + (b) * SH::V + vst0) = vs0; *(bf16x8*)(V_lds + (b) * SH::V + vst1) = vs1; \
    if ((j) < 4) { *(bf16x8*)(K_lds + (b) * SH::K + KSWZ(sr, sc * 2)) = ks0; *(bf16x8*)(K_lds + (b) * SH::K + KSWZ(32 + sr, sc * 2)) = ks1; } } while (0)
#define RO_SCALE(QQ, SCL) ({ const u32x4 u_ = __builtin_bit_cast(u32x4, QQ); u32x4 r_; r_[0] = pk2(bflo(u_[0]) * (SCL), bfhi(u_[0]) * (SCL)); r_[1] = pk2(bflo(u_[1]) * (SCL), bfhi(u_[1]) * (SCL)); \
    r_[2] = pk2(bflo(u_[2]) * (SCL), bfhi(u_[2]) * (SCL)); r_[3] = pk2(bflo(u_[3]) * (SCL), bfhi(u_[3]) * (SCL)); __builtin_bit_cast(bf16x8, r_); })
  RO_LOAD(0); asm volatile("s_waitcnt vmcnt(0)" ::: "memory"); RO_WRITE(0, 0); __syncthreads();
#pragma unroll 1
  for (int j = 0; j < 8; ++j) {
    const int bsel = j & 1; bf16x8 pa0, pa1, pa2, pa3;
    if (j + 1 < 8) RO_LOAD(j + 1);
    if (j < 4) {
      f32x16 p0 = {}, p1 = {}; const char* Kbuf = K_lds + bsel * SH::K;
#pragma unroll
      for (int d0 = 0; d0 < 8; ++d0) { const int cb = (d0 * 16 + hi * 8) * 2;
        const bf16x8 b0 = *reinterpret_cast<const bf16x8*>(Kbuf + KSWZ(r32, cb)); const bf16x8 b1 = *reinterpret_cast<const bf16x8*>(Kbuf + KSWZ(32 + r32, cb));
        p0 = __builtin_amdgcn_mfma_f32_32x32x16_bf16(b0, qr[d0], p0, 0, 0, 0); p1 = __builtin_amdgcn_mfma_f32_32x32x16_bf16(b1, qr[d0], p1, 0, 0, 0); }
      ret_weights(p0, p1, 2, nlane - (float)(64 * j), lf2, lb2);
      pack_p(p0, p1, pa0, pa1, pa2, pa3);
    } else {
      const float w = j < 6 ? ff : fb; const bool od = (j & 1) != 0;
      if (od) { pa0 = RO_SCALE(qr[4], w); pa1 = RO_SCALE(qr[5], w); pa2 = RO_SCALE(qr[6], w); pa3 = RO_SCALE(qr[7], w); }
      else { pa0 = RO_SCALE(qr[0], w); pa1 = RO_SCALE(qr[1], w); pa2 = RO_SCALE(qr[2], w); pa3 = RO_SCALE(qr[3], w); }
    }
    SBAR();
    pv_d0(o, vb0 + bsel * SH::V, pa0, pa1, pa2, pa3);
    if (j + 1 < 8) { asm volatile("s_waitcnt vmcnt(0)" ::: "memory"); RO_WRITE(bsel ^ 1, j + 1); }
    __syncthreads();
  }
  bf16_t* Ow = Qb + (long)(wid * QBLK) * 1024; const bf16_t* Gw = Gb + (long)(wid * QBLK) * 512;
#pragma unroll
  for (int r = 0; r < 16; ++r) {
    float ss = (o[0][r] * o[0][r] + o[1][r] * o[1][r]) + (o[2][r] * o[2][r] + o[3][r] * o[3][r]);
#pragma unroll
    for (int off = 1; off < 32; off <<= 1) ss += __shfl_xor(ss, off);
    const float rs = rsqrtf(ss * (1.f / 128.f) + EPS_N); const int orow = crow(r, hi);
#pragma unroll
    for (int d0 = 0; d0 < 4; ++d0) { const float g = bf1(Gw[(long)orow * 512 + d0 * 32 + r32]); Ow[(long)orow * 1024 + d0 * 32 + r32] = f2bf(o[d0][r] * rs * silu_t(g)); }
    SBAR();
  }
  __syncthreads();
#undef KSWZ
#undef RO_LOAD
#undef RO_WRITE
#undef RO_SCALE
}
#undef SBAR
}
constexpr int NWAVES = 8;
constexpr int RING_BYTES = 131072, SCR_OFF = RING_BYTES, MISC_OFF = SCR_OFF + 8192, LDS_BYTES = 147456;

__device__ __forceinline__ void s5_chunk_scan(unsigned char* ws, int g, int b, int dir, int p) {
  const bf16_t* E = (const bf16_t*)(ws + WS_XN) + ((size_t)g * 2304 + (size_t)b * 144) * 256 + dir * 128 + 2 * p;
  bf16_t* A5 = (bf16_t*)(ws + R_A5) + ((size_t)g * 2304 + (size_t)b * 144) * 512 + 256 + dir * 128 + 2 * p;
  const float* LAM = (const float*)(ws + WS_S5LAM) + ((size_t)(dir * 32 + g) * 64 + p) * 2; const float lr = LAM[0], li = LAM[1];
  float sr = 0.f, si = 0.f;
#define S5_CH(sig) (dir ? ((sig) < 16 ? 15 - (sig) : 159 - (sig)) : (sig))
#define S5_LOAD(dst, s0) do { _Pragma("unroll") for (int q = 0; q < 16; ++q) dst[q] = *(const unsigned*)(E + (size_t)S5_CH((s0) + q) * 256); } while (0)
#define S5_STEP(src, s0) do { _Pragma("unroll") for (int q = 0; q < 16; ++q) { *(unsigned*)(A5 + (size_t)S5_CH((s0) + q) * 512) = pk2(sr, si); \
      const float nr = lr * sr - li * si + bflo(src[q]), ni = lr * si + li * sr + bfhi(src[q]); sr = nr; si = ni; } } while (0)
  unsigned ea[16], eb[16];
  S5_LOAD(ea, 0);
#pragma unroll 1
  for (int s0 = 0; s0 < 128; s0 += 32) { S5_LOAD(eb, s0 + 16); S5_STEP(ea, s0); S5_LOAD(ea, s0 + 32); S5_STEP(eb, s0 + 16); }
  S5_STEP(ea, 128);
#undef S5_LOAD
#undef S5_STEP
#undef S5_CH
}

#define XB_TMO      128
#define XB_XCNT(j)  (256  + 64 * (j))
#define XB_XSUB(j)  (1280 + 64 * (j))
#define XB_XGEN(j)  (2304 + 64 * (j))
#define XB_TOP      3328
#define XB_TOPGEN   3392
#define XB_SPIN_CAP (1u << 22)
__device__ __forceinline__ unsigned xb_ld(unsigned* p)              { return __hip_atomic_load(p, __ATOMIC_RELAXED, __HIP_MEMORY_SCOPE_AGENT); }
__device__ __forceinline__ unsigned xb_add(unsigned* p, unsigned v) { return __hip_atomic_fetch_add(p, v, __ATOMIC_RELAXED, __HIP_MEMORY_SCOPE_AGENT); }
__device__ __forceinline__ unsigned xb_xcc_id() { return (unsigned)__builtin_amdgcn_s_getreg((3 << 11) | 20) & 0xFu; }
#define XB_SPIN(cond, bar) do { unsigned _sp = 0; while (cond) { __builtin_amdgcn_s_sleep(1); \
    if ((++_sp & 255u) == 0u) { if (xb_ld(&(bar)[XB_TMO])) break; if (_sp > XB_SPIN_CAP) { atomicAdd(&(bar)[XB_TMO], 1u); break; } } } } while (0)
struct XcdBarrier { unsigned* bar; unsigned x; volatile LAS unsigned* st; };
__device__ __forceinline__ XcdBarrier xcd_barrier_post(unsigned* bar, volatile LAS unsigned* st) {
    XcdBarrier b; b.bar = bar; b.x = xb_xcc_id(); b.st = st;
    if (threadIdx.x == 0) (void)xb_add(&bar[XB_XCNT(b.x)], 1u);
    return b;
}
__device__ __forceinline__ void xcd_barrier_complete(unsigned* bar, unsigned x, unsigned& nloc, unsigned& nx) {
    const unsigned G = gridDim.x * gridDim.y * gridDim.z;
    unsigned sum, cnt, mine, sp = 0u;
    for (;;) {
        sum = 0u; cnt = 0u; mine = 0u;
#pragma unroll
        for (unsigned j = 0; j < 16; ++j) { const unsigned c = xb_ld(&bar[XB_XCNT(j)]); sum += c; cnt += (c > 0u) ? 1u : 0u; mine = (j == x) ? c : mine; }
        if (sum == G) break;
        __builtin_amdgcn_s_sleep(1);
        if ((++sp & 255u) == 0u) { if (xb_ld(&bar[XB_TMO])) break; if (sp > XB_SPIN_CAP) { atomicAdd(&bar[XB_TMO], 1u); break; } }
    }
    nloc = mine > 0u ? mine : 1u; nx = cnt > 0u ? cnt : 1u;
}
__device__ __forceinline__ void xcd_barrier(const XcdBarrier& b) {
    asm volatile("s_waitcnt vmcnt(0)" ::: "memory");
    __syncthreads();
    if (threadIdx.x == 0) {
        unsigned* bar = b.bar;
        __builtin_amdgcn_s_waitcnt(0);
        unsigned nloc = b.st[0], nx = b.st[1];
        if (nloc == 0u) { xcd_barrier_complete(bar, b.x, nloc, nx); b.st[0] = nloc; b.st[1] = nx; }
        const unsigned old = xb_add(&bar[XB_XSUB(b.x)], 1u);
        const unsigned gen = old / nloc;
        if (old + 1u == (gen + 1u) * nloc) {
            __builtin_amdgcn_fence(__ATOMIC_RELEASE, "agent");
            asm volatile("s_waitcnt vmcnt(0)" ::: "memory");
            const unsigned og = xb_add(&bar[XB_TOP], 1u);
            const unsigned tg = og / nx;
            if (og + 1u == (tg + 1u) * nx) xb_add(&bar[XB_TOPGEN], 1u);
            else XB_SPIN(xb_ld(&bar[XB_TOPGEN]) == tg, bar);
            __builtin_amdgcn_fence(__ATOMIC_ACQUIRE, "agent");
            xb_add(&bar[XB_XGEN(b.x)], 1u);
            asm volatile("s_waitcnt vmcnt(0)" ::: "memory");
        } else {
            XB_SPIN(xb_ld(&bar[XB_XGEN(b.x)]) == gen, bar);
            __builtin_amdgcn_fence(__ATOMIC_ACQUIRE, "agent");
            asm volatile("s_waitcnt vmcnt(0)" ::: "memory");
        }
    }
    __syncthreads();
}

__device__ __forceinline__ void xcd_arrive(const XcdBarrier& b) {
    asm volatile("s_waitcnt vmcnt(0)" ::: "memory");
    __syncthreads();
    if (threadIdx.x == 0) {
        unsigned* bar = b.bar;
        unsigned nloc = b.st[0], nx = b.st[1];
        if (nloc == 0u) { xcd_barrier_complete(bar, b.x, nloc, nx); b.st[0] = nloc; b.st[1] = nx; }
        const unsigned old = xb_add(&bar[XB_XSUB(b.x)], 1u);
        const unsigned gen = old / nloc; b.st[2] = gen;
        if (old + 1u == (gen + 1u) * nloc) {
            __builtin_amdgcn_fence(__ATOMIC_RELEASE, "agent");
            asm volatile("s_waitcnt vmcnt(0)" ::: "memory");
            const unsigned og = xb_add(&bar[XB_TOP], 1u);
            const unsigned tg = og / nx;
            if (og + 1u == (tg + 1u) * nx) xb_add(&bar[XB_TOPGEN], 1u);
            xb_add(&bar[XB_XGEN(b.x)], 1u);
        }
    }
}
__device__ __forceinline__ void xcd_wait(const XcdBarrier& b) {
    if (threadIdx.x == 0) { const unsigned gen = b.st[2]; XB_SPIN(xb_ld(&b.bar[XB_TOPGEN]) == gen, b.bar); __builtin_amdgcn_fence(__ATOMIC_ACQUIRE, "agent"); asm volatile("s_waitcnt vmcnt(0)" ::: "memory"); }
    __syncthreads();
}

__device__ __forceinline__ int wt_src(int map, int n, int Nsrc) {
  if (map == 1) { const bool roped = (n < 1024) || (n >= 2048 && n < 2816); if (!roped) return n; const int hb = n & ~127, dp = n & 127; return hb + (dp & 64) + ((dp & 1) ? 32 : 0) + ((dp & 63) >> 1); }
  if (map == 2) { const int pn = n >> 8, bj = (n >> 7) & 1, jj = n & 127; return bj * FFH + 128 * pn + jj; }
  return n < Nsrc ? n : -1;
}
__device__ __forceinline__ void wt_item(const float* W, int K, int Nsrc, int Ndst, bf16_t* WT, int map, const float* kscale, LAS float* scr, int item, int lane) {
  const int nblk = Ndst / 32, kb = item / nblk, nb = item % nblk, k0 = 64 * kb, n0 = 32 * nb;
  const int src = wt_src(map, n0 + (lane & 31), Nsrc);
  float wv[32];
  const float* Wp = W + (size_t)(k0 + (lane >> 5)) * Nsrc + (src >= 0 ? src : 0);
#pragma unroll
  for (int i = 0; i < 32; ++i) wv[i] = Wp[(size_t)(2 * i) * Nsrc];
#pragma unroll
  for (int i = 0; i < 32; ++i) { const int kk = 2 * i + (lane >> 5); float v = src >= 0 ? wv[i] : 0.f; if (kscale) v *= kscale[k0 + kk]; scr[kk * 33 + (lane & 31)] = v; }
  asm volatile("s_waitcnt lgkmcnt(0)" ::: "memory");
  const int c = lane & 7;
#pragma unroll
  for (int j = 0; j < 4; ++j) { const int n = (lane >> 3) + 8 * j; const LAS float* s = scr + (8 * c) * 33 + n;
    u32x4 o; o.x = pk2(s[0 * 33], s[1 * 33]); o.y = pk2(s[2 * 33], s[3 * 33]); o.z = pk2(s[4 * 33], s[5 * 33]); o.w = pk2(s[6 * 33], s[7 * 33]);
    *(u32x4*)(WT + (size_t)(n0 + n) * K + k0 + 8 * c) = o; }
  asm volatile("s_waitcnt lgkmcnt(0)" ::: "memory");
}
__device__ __forceinline__ const float* hrow_ptr(const float* hc, const float* hl, int row) { const int b = row / RB, pos = row - b * RB; return pos < NCTX ? hc + ((size_t)b * NCTX + pos) * DMODEL : hl + ((size_t)b * NLAT + pos - NCTX) * DMODEL; }

__device__ __forceinline__ void fixup_tile(unsigned char* ws, const float* cw, int pm, int l, int tid) {
  bf16_t* HH = (bf16_t*)(ws + R_HH); const float* EP = (const float*)(ws + WS_EDGE); const float* EG = EP + EDGE_ARR / 4; const float* EA = EG + EDGE_ARR / 4;
#pragma unroll 11
  for (int it = 0; it < 22; ++it) { const int idx = tid + it * (NWAVES * 64); const int e4 = idx / FFH, j = idx - e4 * FFH, blk = 2 * pm + (e4 >> 1), e = e4 & 1, bi = blk % 18; const size_t i = ((size_t)blk * 2 + e) * FFH + j;
    if (l == 1 && bi < 2) continue;
    float cv = EP[i];
    if (e == 0) { if (!(bi == 0 || bi == 2)) cv += cw[j] * EA[((size_t)(blk - 1) * 2 + 1) * FFH + j]; }
    else { if (!(bi == 1 || bi == 17)) cv += cw[2 * FFH + j] * EA[((size_t)(blk + 1) * 2 + 0) * FFH + j]; }
    HH[((size_t)(j >> 5) * TT + (size_t)blk * 128 + (e ? 127 : 0)) * 32 + (j & 31)] = f2bf(gelu_t(cv) * EG[i]); }
}
struct NormPair { f32x4 v0[4], v1[4]; int row; const float* md; };
__device__ __forceinline__ void norm_pair_load(NormPair& P, unsigned char* ws, const float* x, const float* ctx, bool first, int l, int which, int sel, int k, int lane) {
  const float* MODS = (const float*)(ws + WS_MODS); const bf16_t* HB = (const bf16_t*)(ws + WS_HB);
  const int i = 2 * k;
  int b, pos; if (sel == 0) { b = i / RB; pos = i - b * RB; } else if (sel == 1) { b = i >> 11; pos = NCTX + (i & 2047); } else { b = i >> 8; pos = i & 255; }
  const int row = b * RB + pos; P.row = row;
  P.md = MODS + ((size_t)l * 17 + (pos < NCTX ? 16 : b)) * 6144 + which * 3 * 1024;
  if (first) { const float* hr = hrow_ptr(ctx, x, row);
#pragma unroll
    for (int j = 0; j < 4; ++j) { P.v0[j] = *(const f32x4*)(hr + lane * 4 + 256 * j); P.v1[j] = *(const f32x4*)(hr + DMODEL + lane * 4 + 256 * j); } }
  else { const bf16_t* hr = HB + (size_t)row * 1024;
#pragma unroll
    for (int j = 0; j < 4; ++j) { const u32x2 w = *(const u32x2*)(hr + lane * 4 + 256 * j), w2 = *(const u32x2*)(hr + 1024 + lane * 4 + 256 * j);
      P.v0[j] = (f32x4){bflo(w.x), bfhi(w.x), bflo(w.y), bfhi(w.y)}; P.v1[j] = (f32x4){bflo(w2.x), bfhi(w2.x), bflo(w2.y), bfhi(w2.y)}; } }
}
__device__ __forceinline__ void norm_pair_store(const NormPair& P, f32x4 (&sh)[4], f32x4 (&g)[4], const float*& md_cur, unsigned char* ws, int lane) {
  bf16_t* XN = (bf16_t*)(ws + WS_XN);
  if (P.md != md_cur) {
    md_cur = P.md;
#pragma unroll
    for (int j = 0; j < 4; ++j) { sh[j] = *(const f32x4*)(P.md + lane * 4 + 256 * j); g[j] = *(const f32x4*)(P.md + 1024 + lane * 4 + 256 * j) + 1.f; } }
  float ss0 = 0.f, ss1 = 0.f;
#pragma unroll
  for (int j = 0; j < 4; ++j) { ss0 += (P.v0[j][0] * P.v0[j][0] + P.v0[j][1] * P.v0[j][1]) + (P.v0[j][2] * P.v0[j][2] + P.v0[j][3] * P.v0[j][3]); ss1 += (P.v1[j][0] * P.v1[j][0] + P.v1[j][1] * P.v1[j][1]) + (P.v1[j][2] * P.v1[j][2] + P.v1[j][3] * P.v1[j][3]); }
  const float rs0 = rsqrtf(wave_sum64(ss0) * (1.f / 1024.f) + EPS_N), rs1 = rsqrtf(wave_sum64(ss1) * (1.f / 1024.f) + EPS_N);
#pragma unroll
  for (int j = 0; j < 4; ++j) {
    const f32x4 o0 = P.v0[j] * rs0 * g[j] + sh[j], o1 = P.v1[j] * rs1 * g[j] + sh[j]; u32x2 w, w2; w.x = pk2(o0[0], o0[1]); w.y = pk2(o0[2], o0[3]); w2.x = pk2(o1[0], o1[1]); w2.y = pk2(o1[2], o1[3]);
    *(u32x2*)(XN + (size_t)P.row * 1024 + lane * 4 + 256 * j) = w; *(u32x2*)(XN + (size_t)(P.row + 1) * 1024 + lane * 4 + 256 * j) = w2; }
}
__device__ __forceinline__ void norm_rows(unsigned char* ws, const float* x, const float* ctx, bool first, int l, int which, int sel, int w0, int wstride, int lane) {
  const int ppb = (sel == 0 ? RB : sel == 1 ? NLAT : NCTX) >> 1, wpb = wstride >> 4, b = w0 / wpb, wi = w0 - b * wpb, kb = b * ppb, n = (ppb - wi + wpb - 1) / wpb;
  if (b >= 16 || n <= 0) return;
  f32x4 sh[4], g[4]; const float* md_cur = nullptr;
  NormPair A, B; norm_pair_load(A, ws, x, ctx, first, l, which, sel, kb + wi, lane);
  for (int j = 0; j < n; j += 2) {
    if (j + 1 < n) norm_pair_load(B, ws, x, ctx, first, l, which, sel, kb + wi + wpb * (j + 1), lane);
    norm_pair_store(A, sh, g, md_cur, ws, lane);
    if (j + 1 >= n) break;
    if (j + 2 < n) norm_pair_load(A, ws, x, ctx, first, l, which, sel, kb + wi + wpb * (j + 2), lane);
    norm_pair_store(B, sh, g, md_cur, ws, lane);
  }
}
struct SchedCtx { int c; __device__ __forceinline__ bool next(int i, pg8::Unit& u) const { if (i > 0) return false; u.pm = 9 * (c >> 2); u.pn = c & 3; return true; } };
template <int ph> __device__ __forceinline__ void run_phase(const MArgs& a, unsigned char* lds, int tid, int lane, int wave, int G, int bx, int vcu) {
  LAS unsigned char* L = (LAS unsigned char*)lds; unsigned char* ws = a.ws;
  const float* x = a.in[0]; const float* ctx = a.in[2];
  float* MODS = (float*)(ws + WS_MODS); const bf16_t* HB = (const bf16_t*)(ws + WS_HB);
  const int gw = vcu * NWAVES + wave, NGW = G * NWAVES;
  if (ph == 0) {
    if (bx < 192) {
      LAS float* cond = (LAS float*)L; LAS float* red = (LAS float*)(L + 17 * 1024 * 4);
      for (int i = tid; i < 17 * 1024; i += NWAVES * 64) { const int r = i >> 10, k = i & 1023; const float v = r < 16 ? a.in[1][r * 1024 + k] : a.in[3][k]; cond[i] = v / (1.f + __expf(-v)); }
      __syncthreads();
      const int l = bx / 96, cc = bx % 96; const float* W = a.in[4] + (size_t)l * 1024 * 6144 + cc * 64 + lane;
      float acc[17];
#pragma unroll
      for (int r = 0; r < 17; ++r) acc[r] = 0.f;
      for (int k0 = wave * 128; k0 < wave * 128 + 128; k0 += 16) { float wv[16];
#pragma unroll
        for (int q = 0; q < 16; ++q) wv[q] = W[(size_t)(k0 + q) * 6144];
#pragma unroll
        for (int q = 0; q < 16; ++q)
#pragma unroll
          for (int r = 0; r < 17; ++r) acc[r] += cond[r * 1024 + k0 + q] * wv[q]; }
#pragma unroll
      for (int r = 0; r < 17; ++r) red[(wave * 17 + r) * 64 + lane] = acc[r];
      __syncthreads();
      for (int i = tid; i < 17 * 64; i += NWAVES * 64) { const int r = i >> 6, c = i & 63; float s = a.in[5][l * 6144 + cc * 64 + c];
#pragma unroll
        for (int w = 0; w < 8; ++w) s += red[(w * 17 + r) * 64 + c];
        MODS[((size_t)l * 17 + r) * 6144 + cc * 64 + c] = s; }
      asm volatile("s_waitcnt vmcnt(0)" ::: "memory"); __syncthreads();
    }
    else if (bx < 224) {
      const int g = bx - 192;
      LAS float* POW = (LAS float*)L; LAS float* BBc = POW + 2 * 17 * 64 * 2; LAS float* CCc = BBc + 2 * 64 * 16 * 2; LAS float* KT = CCc + 2 * 16 * 64 * 2;
      if (tid < 128) { const int d = tid >> 6, p = tid & 63, i = (d * 32 + g) * 64 + p;
        const float lr = a.in[8][i], li = a.in[9][i], dt = expf(a.in[10][d * 32 + g]); const float ar = lr * dt, ai = li * dt;
        for (int k = 0; k <= 16; ++k) { const float mag = expf(ar * (float)k); float sv, cv; sincosf(ai * (float)k, &sv, &cv); POW[((d * 17 + k) * 64 + p) * 2] = mag * cv; POW[((d * 17 + k) * 64 + p) * 2 + 1] = mag * sv; }
        const float er = POW[((d * 17 + 1) * 64 + p) * 2], ei = POW[((d * 17 + 1) * 64 + p) * 2 + 1];
        const float den = lr * lr + li * li, cr = ((er - 1.f) * lr + ei * li) / den, ci = (ei * lr - (er - 1.f) * li) / den;
        for (int h = 0; h < 16; ++h) { const float br = a.in[11][(size_t)i * 16 + h], bi = a.in[12][(size_t)i * 16 + h];
          BBc[((d * 64 + p) * 16 + h) * 2] = cr * br - ci * bi; BBc[((d * 64 + p) * 16 + h) * 2 + 1] = cr * bi + ci * br;
          CCc[((d * 16 + h) * 64 + p) * 2] = a.in[13][((size_t)(d * 32 + g) * 16 + h) * 64 + p]; CCc[((d * 16 + h) * 64 + p) * 2 + 1] = a.in[14][((size_t)(d * 32 + g) * 16 + h) * 64 + p]; }
        float* LAM = (float*)(ws + WS_S5LAM); LAM[(size_t)i * 2] = POW[((d * 17 + 16) * 64 + p) * 2]; LAM[(size_t)i * 2 + 1] = POW[((d * 17 + 16) * 64 + p) * 2 + 1]; }
      __syncthreads();
      for (int e = tid; e < 2 * 16 * 256; e += NWAVES * 64) { const int d = e >> 12, k = (e >> 8) & 15, hp = (e >> 4) & 15, h = e & 15; float s = 0.f;
        for (int p = 0; p < 64; ++p) { const float cr = CCc[((d * 16 + hp) * 64 + p) * 2], ci = CCc[((d * 16 + hp) * 64 + p) * 2 + 1], pr = POW[((d * 17 + k) * 64 + p) * 2], pi = POW[((d * 17 + k) * 64 + p) * 2 + 1];
          const float xr = cr * pr - ci * pi, xi = cr * pi + ci * pr; s += xr * BBc[((d * 64 + p) * 16 + h) * 2] - xi * BBc[((d * 64 + p) * 16 + h) * 2 + 1]; }
        KT[e] = s; }
      __syncthreads();
      bf16_t* PB = (bf16_t*)(ws + WS_S5PB) + (size_t)g * 256 * 256;
      for (int e = tid; e < 256 * 256; e += NWAVES * 64) { const int n = e >> 8, col = e & 255, d = n >> 7, nn = n & 127, p = nn >> 1, ri = nn & 1, tau = col >> 4, h = col & 15, kp = d ? tau : 15 - tau;
        const float pr = POW[((d * 17 + kp) * 64 + p) * 2], pi = POW[((d * 17 + kp) * 64 + p) * 2 + 1], br = BBc[((d * 64 + p) * 16 + h) * 2], bi = BBc[((d * 64 + p) * 16 + h) * 2 + 1];
        PB[e] = f2bf(ri ? pr * bi + pi * br : pr * br - pi * bi); }
      bf16_t* MR = (bf16_t*)(ws + WS_S5MR) + (size_t)g * 256 * 512;
      for (int e = tid; e < 256 * 512; e += NWAVES * 64) { const int r = e >> 9, k = e & 511, t = r >> 4, hp = r & 15; float v;
        if (k < 256) { const int tau = k >> 4, h = k & 15; v = 0.f; if (tau <= t) v += KT[((0 * 16 + (t - tau)) * 16 + hp) * 16 + h]; if (tau >= t) v += KT[((1 * 16 + (tau - t)) * 16 + hp) * 16 + h];
          if (tau == t && h == hp) v += a.in[15][g * 16 + h]; }
        else { const int kk = k - 256, d = kk >> 7, nn = kk & 127, p = nn >> 1, ri = nn & 1, kp = d ? 16 - t : t + 1;
          const float pr = POW[((d * 17 + kp) * 64 + p) * 2], pi = POW[((d * 17 + kp) * 64 + p) * 2 + 1], cr = CCc[((d * 16 + hp) * 64 + p) * 2], ci = CCc[((d * 16 + hp) * 64 + p) * 2 + 1];
          v = ri ? -(cr * pi + ci * pr) : (cr * pr - ci * pi); }
        MR[e] = f2bf(v); }
      __syncthreads();
    }
    { XcdBarrier b2; b2.bar = (unsigned*)(ws + WS_CTL) + 4096; b2.x = xb_xcc_id(); b2.st = (volatile LAS unsigned*)(L + MISC_OFF) + 8; xcd_arrive(b2); }
    if (bx < 192 || bx >= 224) {
      LAS float* scr = (LAS float*)(L + wave * 16384);
      int base = 0; const int gwc = (bx < 192 ? bx : bx - 32) * NWAVES + wave, NGWC = (G - 32) * NWAVES;
#define WT_MAT(Wp, K_, Nsrc_, Ndst_, dst_, map_, ks_) do { const int ni = ((K_) / 64) * ((Ndst_) / 32); int it0 = gwc - (base % NGWC); if (it0 < 0) it0 += NGWC; \
        for (int it = it0; it < ni; it += NGWC) wt_item((Wp), (K_), (Nsrc_), (Ndst_), (bf16_t*)(ws + (dst_)), (map_), (ks_), scr, it, lane); base += ni; } while (0)
      WT_MAT(a.in[6], 1024, 1216, 1280, W_INAB, 0, (const float*)nullptr);
      WT_MAT(a.in[7], 1024, 1024, 1024, W_OUTAB, 0, (const float*)nullptr);
      WT_MAT(a.in[16], 512, 512, 512, W_GLU, 0, (const float*)nullptr);
      WT_MAT(a.in[19], 384, 768, 768, W_UQ, 0, a.in[18]);
      WT_MAT(a.in[21], 256, 1024, 1024, W_UKV, 0, a.in[20]);
      WT_MAT(a.in[27], 1024, 5632, 5632, W_UP, 2, (const float*)nullptr);
      WT_MAT(a.in[30], 2816, 1024, 1024, W_DN, 0, (const float*)nullptr);
#undef WT_MAT
    }
    { const int gt = vcu * 512 + tid, NT_ = G * 512;
      float* c64 = (float*)(ws + WS_R64C); float* s64 = (float*)(ws + WS_R64S); float* c128 = (float*)(ws + WS_R128C); float* s128 = (float*)(ws + WS_R128S);
      for (int i = gt; i < 2048 * 32; i += NT_) { const int t = i >> 5, j = i & 31, ii = j & 15; const float inv = powf(10000.f, -(float)ii / 16.f), pos = j < 16 ? (float)(t >> 6) : (float)(t & 63);
        float sv, cv; sincosf(pos * inv, &sv, &cv); c64[i] = cv; s64[i] = sv; }
      for (int i = gt; i < 2048 * 64; i += NT_) { const int t = i >> 6, j = i & 63, ii = j & 31; const float inv = powf(10000.f, -(float)ii / 32.f), pos = j < 32 ? (float)(t >> 6) : (float)(t & 63);
        float sv, cv; sincosf(pos * inv, &sv, &cv); c128[i] = cv; s128[i] = sv; }
    }
    { XcdBarrier b2; b2.bar = (unsigned*)(ws + WS_CTL) + 4096; b2.x = xb_xcc_id(); b2.st = (volatile LAS unsigned*)(L + MISC_OFF) + 8; xcd_wait(b2); }

    norm_rows(ws, x, ctx, true, 0, 0, 0, gw, NGW, lane);
  } else if (ph == 1) {
    norm_rows(ws, x, ctx, true, 0, 0, 0, gw, NGW, lane);
  } else if (ph == 16) {
    norm_rows(ws, x, ctx, false, 1, 1, 1, gw, NGW, lane);
  } else if (ph == 24 || ph == 26) {
    norm_rows(ws, x, ctx, false, ph == 24 ? 0 : 1, ph == 24 ? 1 : 0, 2, gw, NGW, lane);
  } else if (ph == 23 || ph == 25) {
    const int nctx = ph == 23 ? 64 : 128;
    if (bx < nctx) {
      Epi<false> E{}; E.ws = ws; E.scr = (LAS float*)(L + SCR_OFF); E.kind = EK_RES; E.gate = MODS + (ph == 23 ? 2 : 5) * 1024; E.hin_c = ph == 23 ? ctx : nullptr; E.hin_l = ph == 23 ? x : nullptr;
      SchedCtx S; S.c = bx & 63;
      if (ph == 23) { pg8::Gemm g{(const bf16_t*)(ws + R_CAT), (const bf16_t*)(ws + W_OUTAB), 1024, 1024}; pg8::gemm_phase<Epi<false>, SchedCtx, false>(L, g, S, E); }
      else { const int kh = bx >> 6; unsigned* fl = (unsigned*)(ws + WS_CTL) + 256 + 16 * (bx & 63); E.wflag = kh ? fl : nullptr;
        pg8::Gemm g{(const bf16_t*)(ws + R_HH) + (size_t)kh * 44 * TT * 32, (const bf16_t*)(ws + W_DN) + kh * 1408, 1408, 2816, 2816}; pg8::gemm_phase<Epi<false>, SchedCtx, false, true>(L, g, S, E);
        if (kh == 0 && tid == 0) { __builtin_amdgcn_fence(__ATOMIC_RELEASE, "agent"); (void)xb_add(fl, 1u); }
      }
      { XcdBarrier b2; b2.bar = (unsigned*)(ws + WS_CTL) + 4096; b2.x = 0; b2.st = (volatile LAS unsigned*)(L + MISC_OFF) + 8; xcd_wait(b2); }
    } else {
      const int gw2 = (bx - nctx) * NWAVES + wave, NGW2 = (G - nctx) * NWAVES;
      { XcdBarrier b2; b2.bar = (unsigned*)(ws + WS_CTL) + 4096; b2.x = 0; b2.st = (volatile LAS unsigned*)(L + MISC_OFF) + 8; xcd_wait(b2); }
      norm_rows(ws, x, ctx, false, ph == 23 ? 0 : 1, ph == 23 ? 1 : 0, 1, gw2, NGW2, lane);
      if (ph == 25) {
        LAS float* scr = (LAS float*)(L + wave * 16384); int base = 0;
#define WT_MAT(Wp, K_, Nsrc_, Ndst_, dst_, map_, ks_) do { const int ni = ((K_) / 64) * ((Ndst_) / 32); int it0 = gw2 - (base % NGW2); if (it0 < 0) it0 += NGW2; \
          for (int it = it0; it < ni; it += NGW2) wt_item((Wp), (K_), (Nsrc_), (Ndst_), (bf16_t*)(ws + (dst_)), (map_), (ks_), scr, it, lane); base += ni; } while (0)
        WT_MAT(a.in[22], 1024, 3072, 3072, W_INCD, 1, (const float*)nullptr);
        WT_MAT(a.in[23], 1024, 1024, 1024, W_OUTCD, 0, (const float*)nullptr);
        WT_MAT(a.in[27] + (size_t)1024 * 5632, 1024, 5632, 5632, W_UP + (size_t)5632 * 1024 * 2, 2, (const float*)nullptr);
        WT_MAT(a.in[30] + (size_t)2816 * 1024, 2816, 1024, 1024, W_DN + (size_t)1024 * 2816 * 2, 0, (const float*)nullptr);
#undef WT_MAT
      }
    }
  } else if (ph == 2 || ph == 7 || ph == 9 || ph == 11 || ph == 13 || ph == 15 || ph == 17 || ph == 19) {
    const int l = ph >= 12 ? 1 : 0;
    if (ph == 9 || ph == 17) {
      Epi<true> E{}; E.kind = EK_UP; E.ws = ws; E.scr = (LAS float*)(L + SCR_OFF); E.cw = a.in[28] + (size_t)l * 3 * FFH; E.cb = a.in[29] + (size_t)l * FFH;
      pg8::Gemm g{(const bf16_t*)(ws + WS_XN), (const bf16_t*)(ws + W_UP + (size_t)l * 5632 * 1024 * 2), 1024, 1024};
      if (ph == 9) { SchedFull S; S.so.init(144, 22, G, bx); pg8::gemm_phase<Epi<true>, SchedFull, true>(L, g, S, E); }
      else { SchedLat S; S.so.init(128, 22, G, bx); pg8::gemm_phase<Epi<true>, SchedLat, true>(L, g, S, E); }
    } else {
      Epi<false> E{}; E.ws = ws; E.scr = (LAS float*)(L + SCR_OFF);
      if (ph == 2) { E.kind = EK_INAB; pg8::Gemm g{(const bf16_t*)(ws + WS_XN), (const bf16_t*)(ws + W_INAB), 1024, 1024}; SchedFull S; S.so.init(144, 5, G, bx); pg8::gemm_phase<Epi<false>, SchedFull, false>(L, g, S, E); }
      else if (ph == 13) { E.kind = EK_INCD; E.gq = a.in[25]; E.gk = a.in[26]; pg8::Gemm g{(const bf16_t*)(ws + WS_XN), (const bf16_t*)(ws + W_INCD), 1024, 1024};
        SchedInCd S; S.so.init(128, 12, G, bx); S.G = G; S.c = bx; pg8::gemm_phase<Epi<false>, SchedInCd, false>(L, g, S, E); }
      else {
        E.kind = EK_RES; const int which = (ph == 11 || ph == 19) ? 1 : 0; E.gate = MODS + (size_t)l * 17 * 6144 + (which * 3 + 2) * 1024;
        E.hin_c = ph == 7 ? ctx : nullptr; E.hin_l = ph == 7 ? x : nullptr;
        if (ph == 7) { pg8::Gemm g{(const bf16_t*)(ws + R_CAT), (const bf16_t*)(ws + W_OUTAB), 1024, 1024}; SchedLat S; S.so.init(128, 4, G, bx); pg8::gemm_phase<Epi<false>, SchedLat, false>(L, g, S, E); }
        else if (ph == 11) { pg8::Gemm g{(const bf16_t*)(ws + R_HH), (const bf16_t*)(ws + W_DN), 2816, 2816}; SchedLat S; S.so.init(128, 4, G, bx); pg8::gemm_phase<Epi<false>, SchedLat, false, true>(L, g, S, E); }
        else if (ph == 15) { pg8::Gemm g{(const bf16_t*)(ws + R_CAT1), (const bf16_t*)(ws + W_OUTCD), 1024, 1024}; SchedLat S; S.so.init(128, 4, G, bx); pg8::gemm_phase<Epi<false>, SchedLat, false>(L, g, S, E); }
        else { pg8::Gemm g{(const bf16_t*)(ws + R_HH), (const bf16_t*)(ws + W_DN + (size_t)1024 * 2816 * 2), 2816, 2816}; SchedLat S; S.so.init(128, 4, G, bx); pg8::gemm_phase<Epi<false>, SchedLat, false, true>(L, g, S, E); }
      }
    }
  } else if (ph == 3) {
    Epi<false> E{}; E.ws = ws; E.scr = (LAS float*)(L + SCR_OFF);
    { E.kind = EK_S5E; pg8::Gemm g{(const bf16_t*)(ws + R_A5), (const bf16_t*)(ws + WS_S5PB), 256, 512}; SchedS5 S; S.G = G; S.c = bx; pg8::gemm_phase<Epi<false>, SchedS5, false>(L, g, S, E); }
    { E.kind = EK_Q; pg8::Gemm g{(const bf16_t*)(ws + R_CQ), (const bf16_t*)(ws + W_UQ), 384, 384}; SchedFull S; S.so.init(144, 3, G, (bx + 224) & 255); pg8::gemm_phase<Epi<false>, SchedFull, false>(L, g, S, E); }
    { E.kind = EK_KV; pg8::Gemm g{(const bf16_t*)(ws + R_CKV), (const bf16_t*)(ws + W_UKV), 256, 256}; SchedFull S; S.so.init(144, 4, G, (bx + 48) & 255); pg8::gemm_phase<Epi<false>, SchedFull, false>(L, g, S, E); }
  } else if (ph == 4) {
    unsigned* CT = (unsigned*)(ws + WS_CTL); unsigned* TMO = CT + 4096;
    const bf16_t* Q = (const bf16_t*)(ws + R_Q); const bf16_t* Kb = (const bf16_t*)(ws + R_K); const bf16_t* Vb = (const bf16_t*)(ws + R_V); bf16_t* CAT = (bf16_t*)(ws + R_CAT);
    if (bx >= 128) { const int w = (bx - 128) * NWAVES + wave; s5_chunk_scan(ws, w & 31, (w >> 5) & 15, w >> 9, lane);
      asm volatile("s_waitcnt vmcnt(0)" ::: "memory"); __syncthreads();
    }
    { XcdBarrier b2; b2.bar = (unsigned*)(ws + WS_CTL) + 4096; b2.x = xb_xcc_id(); b2.st = (volatile LAS unsigned*)(L + MISC_OFF) + 8; xcd_arrive(b2); }
    { const int u = vcu, bh = u >> 3, qb = u & 7, b = bh >> 2, h = bh & 3; const size_t r0 = (size_t)b * RB + NCTX + 256 * qb;
      att::attn_unit<192, 0, 0, 768, 768, 512, 1024, 0>(Q + r0 * 768 + 192 * h, Kb + (size_t)b * RB * 768 + 192 * h, Vb + (size_t)b * RB * 512 + 128 * h, CAT + r0 * 1024 + 512 + 128 * h, RB, (char*)lds, 0, 0.f, 0.f, nullptr); }
    { XcdBarrier b2; b2.bar = (unsigned*)(ws + WS_CTL) + 4096; b2.x = xb_xcc_id(); b2.st = (volatile LAS unsigned*)(L + MISC_OFF) + 8; xcd_wait(b2); }

    { Epi<false> E{}; E.ws = ws; E.scr = (LAS float*)(L + SCR_OFF); E.kind = EK_S5Y;
      pg8::Gemm g{(const bf16_t*)(ws + R_A5), (const bf16_t*)(ws + WS_S5MR), 512, 512}; SchedS5 S; S.G = G; S.c = bx; pg8::gemm_phase<Epi<false>, SchedS5, false>(L, g, S, E); }
    { XcdBarrier b2; b2.bar = (unsigned*)(ws + WS_CTL) + 4096; b2.x = xb_xcc_id(); b2.st = (volatile LAS unsigned*)(L + MISC_OFF) + 8; xcd_arrive(b2); }
    { const int u = vcu + 256, bh = u >> 3, qb = u & 7, b = bh >> 2, h = bh & 3; const size_t r0 = (size_t)b * RB + NCTX + 256 * qb;
      att::attn_unit<192, 0, 0, 768, 768, 512, 1024, 0>(Q + r0 * 768 + 192 * h, Kb + (size_t)b * RB * 768 + 192 * h, Vb + (size_t)b * RB * 512 + 128 * h, CAT + r0 * 1024 + 512 + 128 * h, RB, (char*)lds, 0, 0.f, 0.f, nullptr); }
    if (bx >= 64 && bx < 128) { const int bh = bx - 64, b = bh >> 2, h = bh & 3; const size_t r0 = (size_t)b * RB;
      att::attn_unit<192, 0, 0, 768, 768, 512, 1024, 0>(Q + r0 * 768 + 192 * h, Kb + r0 * 768 + 192 * h, Vb + r0 * 512 + 128 * h, CAT + r0 * 1024 + 512 + 128 * h, NCTX, (char*)lds, 0, 0.f, 0.f, nullptr); }
    { XcdBarrier b2; b2.bar = (unsigned*)(ws + WS_CTL) + 4096; b2.x = xb_xcc_id(); b2.st = (volatile LAS unsigned*)(L + MISC_OFF) + 8; xcd_wait(b2); }

    { Epi<false> E{}; E.ws = ws; E.scr = (LAS float*)(L + SCR_OFF); E.kind = EK_GLU; E.bglu = a.in[17];
      pg8::Gemm g{(const bf16_t*)(ws + R_G), (const bf16_t*)(ws + W_GLU), 512, 512}; SchedFull S; S.so.init(144, 2, G, (bx + 224) & 255); pg8::gemm_phase<Epi<false>, SchedFull, false>(L, g, S, E); }
  } else if (ph == 5) {
    Epi<false> E{}; E.ws = ws; E.scr = (LAS float*)(L + SCR_OFF); E.kind = EK_S5Y;
    pg8::Gemm g{(const bf16_t*)(ws + R_A5), (const bf16_t*)(ws + WS_S5MR), 512, 512}; SchedS5 S; S.G = G; S.c = bx; pg8::gemm_phase<Epi<false>, SchedS5, false>(L, g, S, E);
  } else if (ph == 6) {
    const bf16_t* Q = (const bf16_t*)(ws + R_Q); const bf16_t* Kb = (const bf16_t*)(ws + R_K); const bf16_t* Vb = (const bf16_t*)(ws + R_V); bf16_t* CAT = (bf16_t*)(ws + R_CAT);
#pragma unroll 1
    for (int k = 0; k < 2; ++k) { const int u = vcu + 256 * k, bh = u >> 3, qb = u & 7, b = bh >> 2, h = bh & 3; const size_t r0 = (size_t)b * RB + NCTX + 256 * qb;
      att::attn_unit<192, 0, 0, 768, 768, 512, 1024, 0>(Q + r0 * 768 + 192 * h, Kb + (size_t)b * RB * 768 + 192 * h, Vb + (size_t)b * RB * 512 + 128 * h, CAT + r0 * 1024 + 512 + 128 * h, RB, (char*)lds, 0, 0.f, 0.f, nullptr); }
    if (vcu >= 64 && vcu < 128) { const int bh = vcu - 64, b = bh >> 2, h = bh & 3; const size_t r0 = (size_t)b * RB;
      att::attn_unit<192, 0, 0, 768, 768, 512, 1024, 0>(Q + r0 * 768 + 192 * h, Kb + r0 * 768 + 192 * h, Vb + r0 * 512 + 128 * h, CAT + r0 * 1024 + 512 + 128 * h, NCTX, (char*)lds, 0, 0.f, 0.f, nullptr); }
    Epi<false> E{}; E.ws = ws; E.scr = (LAS float*)(L + SCR_OFF); E.kind = EK_GLU; E.bglu = a.in[17];
    pg8::Gemm g{(const bf16_t*)(ws + R_G), (const bf16_t*)(ws + W_GLU), 512, 512}; SchedFull S; S.so.init(144, 2, G, bx); pg8::gemm_phase<Epi<false>, SchedFull, false>(L, g, S, E);
  } else if (ph == 10 || ph == 18) {
    const int l = ph == 18 ? 1 : 0; const float* cw = a.in[28] + (size_t)l * 3 * FFH; bf16_t* HH = (bf16_t*)(ws + R_HH);
    const float* EP = (const float*)(ws + WS_EDGE); const float* EG = EP + EDGE_ARR / 4; const float* EA = EG + EDGE_ARR / 4;
    constexpr int NE = NBLK128 * 2 * FFH; const int st = G * 512;
    for (int i0 = vcu * 512 + tid; i0 < NE; i0 += 4 * st) {
      float ep[4], eg[4], ea[4], wv[4]; bool ok[4], nb[4];
#pragma unroll
      for (int q = 0; q < 4; ++q) { const int i = i0 + q * st; const bool in = i < NE; const int ii = in ? i : i0; const int j = ii % FFH, be = ii / FFH, e = be & 1, blk = be >> 1, bi = blk % 18;
        ok[q] = in && !(l == 1 && bi < 2); nb[q] = e == 0 ? !(bi == 0 || bi == 2) : !(bi == 1 || bi == 17);
        ep[q] = EP[ii]; eg[q] = EG[ii]; wv[q] = cw[(e ? 2 * FFH : 0) + j];
        const size_t an = e == 0 ? ((size_t)(nb[q] ? blk - 1 : blk) * 2 + 1) * FFH + j : ((size_t)(nb[q] ? blk + 1 : blk) * 2 + 0) * FFH + j; ea[q] = EA[an]; }
#pragma unroll
      for (int q = 0; q < 4; ++q) { const int i = i0 + q * st; if (!ok[q]) continue; const int j = i % FFH, be = i / FFH, e = be & 1, blk = be >> 1;
        const float cv = nb[q] ? ep[q] + wv[q] * ea[q] : ep[q];
        HH[((size_t)(j >> 5) * TT + (size_t)blk * 128 + (e ? 127 : 0)) * 32 + (j & 31)] = f2bf(gelu_t(cv) * eg[q]); }
    }
  } else if (ph == 14) {
    bf16_t* CAT1 = (bf16_t*)(ws + R_CAT1); const bf16_t* RK = (const bf16_t*)(ws + R_RK); const bf16_t* RV = (const bf16_t*)(ws + R_RV); const bf16_t* RG = (const bf16_t*)(ws + R_RG);
    const bf16_t* GK = (const bf16_t*)(ws + R_GK); const bf16_t* GV = (const bf16_t*)(ws + R_GV);
    { const int bh = vcu >> 2, dir = (vcu >> 1) & 1, hf = vcu & 1, b = bh >> 2, h = bh & 3; const float dl = a.in[24][dir * 4 + h];
      const float l2 = __uint_as_float(__builtin_amdgcn_readfirstlane(__float_as_uint(-log1pf(expf(-dl)) * LOG2E)));
      att::ret_state_unit(RK + (size_t)b * RB * 512 + 128 * h, RV + (size_t)b * RB * 512 + 128 * h, (bf16_t*)(ws + R_ST) + (size_t)(bh * 2 + dir) * 8 * 16384, dir, hf, l2, (char*)lds); }

    { XcdBarrier b2; b2.bar = (unsigned*)(ws + WS_CTL) + 4096; b2.x = xb_xcc_id(); b2.st = (volatile LAS unsigned*)(L + MISC_OFF) + 8; xcd_arrive(b2); }
#pragma unroll 1
    for (int k = 0; k < 2; ++k) { const int u = vcu + 256 * k, bh = u >> 3, qb = u & 7, b = bh >> 2, h = bh & 3; const size_t r0 = (size_t)b * RB + NCTX + 256 * qb, rb = (size_t)b * RB;
      att::attn_unit<128, 0, 1, 1024, 256, 256, 1024, 0>(CAT1 + r0 * 1024 + 512 + 128 * h, GK + rb * 256 + 128 * (h >> 1), GV + rb * 256 + 128 * (h >> 1), CAT1 + r0 * 1024 + 512 + 128 * h, RB, (char*)lds, 0, 0.f, 0.f, nullptr); }
    { XcdBarrier b2; b2.bar = (unsigned*)(ws + WS_CTL) + 4096; b2.x = xb_xcc_id(); b2.st = (volatile LAS unsigned*)(L + MISC_OFF) + 8; xcd_wait(b2); }

    const bf16_t* ST = (const bf16_t*)(ws + R_ST);
#pragma unroll 1
    for (int k = 0; k < 2; ++k) { const int u = vcu + 256 * k, bh = u >> 3, qb = u & 7, b = bh >> 2, h = bh & 3; const size_t r0 = (size_t)b * RB + NCTX + 256 * qb;
      const float dl_f = a.in[24][h], dl_b = a.in[24][4 + h]; const float lf2 = __uint_as_float(__builtin_amdgcn_readfirstlane(__float_as_uint(-log1pf(expf(-dl_f)) * LOG2E))), lb2 = __uint_as_float(__builtin_amdgcn_readfirstlane(__float_as_uint(-log1pf(expf(-dl_b)) * LOG2E)));
      att::ret_out_unit(CAT1 + r0 * 1024 + 128 * h, RK + r0 * 512 + 128 * h, RV + r0 * 512 + 128 * h, ST + ((size_t)(bh * 2 + 0) * 8 + qb) * 16384, ST + ((size_t)(bh * 2 + 1) * 8 + qb) * 16384, RG + r0 * 512 + 128 * h, lf2, lb2, (char*)lds); }
  } else if (ph == 20) {
    const float* gf = a.in[31]; f32x4 gfv[4];
#pragma unroll
    for (int j = 0; j < 4; ++j) gfv[j] = *(const f32x4*)(gf + lane * 4 + 256 * j);
    constexpr int NP = 16 * NLAT / 2;
#define FN_LOAD(W, k) do { const int row_ = 2 * (k); const bf16_t* hr_ = HB + ((size_t)(row_ >> 11) * RB + NCTX + (row_ & 2047)) * 1024; \
      _Pragma("unroll") for (int j = 0; j < 4; ++j) { W[j] = *(const u32x2*)(hr_ + lane * 4 + 256 * j); W[4 + j] = *(const u32x2*)(hr_ + 1024 + lane * 4 + 256 * j); } } while (0)
#define FN_STORE(W, k) do { float* orow_ = a.out + (size_t)(2 * (k)) * 1024; f32x4 v0_[4], v1_[4]; float s0_ = 0.f, s1_ = 0.f; \
      _Pragma("unroll") for (int j = 0; j < 4; ++j) { v0_[j] = (f32x4){bflo(W[j].x), bfhi(W[j].x), bflo(W[j].y), bfhi(W[j].y)}; v1_[j] = (f32x4){bflo(W[4 + j].x), bfhi(W[4 + j].x), bflo(W[4 + j].y), bfhi(W[4 + j].y)}; \
        s0_ += (v0_[j][0] * v0_[j][0] + v0_[j][1] * v0_[j][1]) + (v0_[j][2] * v0_[j][2] + v0_[j][3] * v0_[j][3]); s1_ += (v1_[j][0] * v1_[j][0] + v1_[j][1] * v1_[j][1]) + (v1_[j][2] * v1_[j][2] + v1_[j][3] * v1_[j][3]); } \
      const float r0_ = rsqrtf(wave_sum64(s0_) * (1.f / 1024.f) + EPS_N), r1_ = rsqrtf(wave_sum64(s1_) * (1.f / 1024.f) + EPS_N); \
      _Pragma("unroll") for (int j = 0; j < 4; ++j) { *(f32x4*)(orow_ + lane * 4 + 256 * j) = v0_[j] * r0_ * gfv[j]; *(f32x4*)(orow_ + 1024 + lane * 4 + 256 * j) = v1_[j] * r1_ * gfv[j]; } } while (0)
    if (gw < NP) { u32x2 WA[8], WB[8]; FN_LOAD(WA, gw);
      for (int k = gw; k < NP; k += 2 * NGW) { const int k1 = k + NGW, k2 = k + 2 * NGW;
        if (k1 < NP) FN_LOAD(WB, k1);
        FN_STORE(WA, k);
        if (k1 >= NP) break;
        if (k2 < NP) FN_LOAD(WA, k2);
        FN_STORE(WB, k1); } }
#undef FN_LOAD
#undef FN_STORE
  }
}

__global__ void __launch_bounds__(NWAVES * 64, 2) mega_fwd(MArgs a) {
  extern __shared__ __attribute__((aligned(16))) unsigned char lds[];
  LAS unsigned char* L = (LAS unsigned char*)lds;
  volatile LAS unsigned* MISC = (volatile LAS unsigned*)(L + MISC_OFF);
  const int tid = threadIdx.x, lane = tid & 63, wave = __builtin_amdgcn_readfirstlane(tid >> 6);
  const int G = gridDim.x, bx = blockIdx.x, vcu = (G % 8 == 0) ? (bx % 8) * (G / 8) + bx / 8 : bx;
  for (int u = tid; u < 64; u += NWAVES * 64) MISC[u] = 0u;
  __syncthreads();
  XcdBarrier bar; bar.bar = (unsigned*)(a.ws + WS_CTL) + 4096; bar.x = 0; bar.st = nullptr;
  const int lo = a.ph_lo, hi = a.ph_hi;
  if (hi - lo > 1) bar = xcd_barrier_post((unsigned*)(a.ws + WS_CTL) + 4096, MISC + 8);
#ifndef MK_DUP
#define MK_DUP 0
#endif
#define RUN(k) do { if (lo <= (k) && (k) < hi) { run_phase<k>(a, lds, tid, lane, wave, G, bx, vcu); if ((k) != 20 && hi - lo > 1) xcd_barrier(bar); \
    if constexpr (((MK_DUP) >> (k)) & 1) { run_phase<k>(a, lds, tid, lane, wave, G, bx, vcu); xcd_barrier(bar); } } } while (0)
#define RUNAR(k) do { if (lo <= (k) && (k) < hi) { run_phase<k>(a, lds, tid, lane, wave, G, bx, vcu); xcd_arrive(bar); } } while (0)
  RUN(0); RUN(2); RUN(3); RUN(4); RUNAR(7); RUN(23); RUN(24); RUN(9); RUN(10); RUNAR(11); RUN(25); RUN(26); RUN(13); RUN(14); RUN(15); RUN(16); RUN(17); RUN(18); RUN(19); RUN(20);
#ifdef MK_XBAR
  for (int i = 0; i < MK_XBAR; ++i) xcd_barrier(bar);
#endif
#undef RUN
}

#ifndef MK_SINGLE
#define MK_SINGLE 1
#endif
static void mk_launch(void* const* d_in, void* d_out, void* d_ws, hipStream_t stream) {
  static int ok = 0;
  if (!ok) { if (hipFuncSetAttribute((const void*)mega_fwd, hipFuncAttributeMaxDynamicSharedMemorySize, LDS_BYTES) != hipSuccess) { fprintf(stderr, "hipFuncSetAttribute failed\n"); return; } ok = 1; }
  (void)hipMemsetAsync((char*)d_ws + WS_CTL, 0, CTL_BYTES, stream);
  MArgs a{}; for (int i = 0; i < 32; ++i) a.in[i] = (const float*)d_in[i]; a.out = (float*)d_out; a.ws = (unsigned char*)d_ws;
  if (MK_SINGLE) { a.ph_lo = 0; a.ph_hi = 27; hipLaunchKernelGGL(mega_fwd, dim3(256), dim3(512), LDS_BYTES, stream, a); }
  else for (int p = 0; p < 21; ++p) { a.ph_lo = p; a.ph_hi = p + 1; hipLaunchKernelGGL(mega_fwd, dim3(256), dim3(512), LDS_BYTES, stream, a); }
}
extern "C" void kernel_launch(void* const* d_in, const int* in_sizes, int n_in, void* d_out, int out_size, void* d_ws, size_t ws_size, hipStream_t stream) {
  if (ws_size < WS_END) { fprintf(stderr, "kernel_launch: workspace too small (%zu < %zu)\n", ws_size, (size_t)WS_END); return; }
  mk_launch(d_in, d_out, d_ws, stream);
}
```

```cpp
#include <hip/hip_runtime.h>
#include <cstdio>
#include <cstdint>

#define LAS __attribute__((address_space(3)))
#define GAS __attribute__((address_space(1)))
typedef unsigned short bf16_t;
typedef short bf16x8 __attribute__((ext_vector_type(8)));
typedef short s16x4 __attribute__((ext_vector_type(4)));
typedef float f32x2 __attribute__((ext_vector_type(2)));
typedef float f32x4 __attribute__((ext_vector_type(4)));
typedef float f32x16 __attribute__((ext_vector_type(16)));
typedef unsigned u32x2 __attribute__((ext_vector_type(2)));
typedef unsigned u32x4 __attribute__((ext_vector_type(4)));
typedef __bf16 bf16x2_t __attribute__((ext_vector_type(2)));

constexpr int TT = 36864;
constexpr int DMODEL = 1024, RB = 2304, NCTX = 256, NLAT = 2048, FFH = 2816, NBLK128 = TT / 128;
constexpr float EPS_N = 1e-6f, LOG2E = 1.4426950408889634f;

__device__ __forceinline__ unsigned pk2(float lo, float hi) { f32x2 v = {lo, hi}; bf16x2_t b = __builtin_convertvector(v, bf16x2_t); return __builtin_bit_cast(unsigned, b); }
__device__ __forceinline__ float bflo(unsigned u) { return __uint_as_float(u << 16); }
__device__ __forceinline__ float bfhi(unsigned u) { return __uint_as_float(u & 0xffff0000u); }
__device__ __forceinline__ float bf1(bf16_t h) { return __uint_as_float(((unsigned)h) << 16); }
__device__ __forceinline__ bf16_t f2bf(float f) { return (bf16_t)(pk2(f, 0.f) & 0xffffu); }
__device__ __forceinline__ void store8(bf16_t* p, const f32x4& a, const f32x4& b) { u32x4 w; w.x = pk2(a[0], a[1]); w.y = pk2(a[2], a[3]); w.z = pk2(b[0], b[1]); w.w = pk2(b[2], b[3]); *(u32x4*)p = w; }
__device__ __forceinline__ float fast_sigmoid(float x) { return __builtin_amdgcn_rcpf(1.f + __builtin_amdgcn_exp2f(-LOG2E * x)); }
__device__ __forceinline__ float gelu_t(float x) { const float u = x + 0.044715f * x * x * x; return x * __builtin_amdgcn_rcpf(1.f + __builtin_amdgcn_exp2f(-2.302208198f * u)); }
__device__ __forceinline__ float silu_t(float x) { return x * fast_sigmoid(x); }
__device__ __forceinline__ float wave_sum64(float v) {
#pragma unroll
  for (int o = 1; o < 64; o <<= 1) v += __shfl_xor(v, o);
  return v;
}

constexpr size_t MiB = 1u << 20;
constexpr size_t WS_CTL = 0, CTL_BYTES = 32768;
constexpr size_t WS_MODS = 1 * MiB;
constexpr size_t WS_R64C = 2 * MiB, WS_R64S = WS_R64C + 2048 * 32 * 4, WS_R128C = WS_R64S + 2048 * 32 * 4, WS_R128S = WS_R128C + 2048 * 64 * 4;
constexpr size_t WS_S5LAM = 3 * MiB + 512 * 1024;
constexpr size_t WS_PS = 5 * MiB;
constexpr size_t WS_EDGE = 11 * MiB, EDGE_ARR = (size_t)NBLK128 * 2 * FFH * 4;
constexpr size_t WS_S5PB = WS_EDGE, WS_S5MR = WS_S5PB + (size_t)32 * 256 * 256 * 2;
static_assert(WS_S5MR + (size_t)32 * 256 * 512 * 2 <= WS_EDGE + 3 * EDGE_ARR, "s5 matrices");
constexpr size_t WS_W = 31 * MiB;
constexpr size_t W_INAB = WS_W, W_OUTAB = W_INAB + 1280 * 1024 * 2, W_GLU = W_OUTAB + 1024 * 1024 * 2, W_UQ = W_GLU + 512 * 512 * 2, W_UKV = W_UQ + 768 * 384 * 2,
                 W_INCD = W_UKV + 1024 * 256 * 2, W_OUTCD = W_INCD + 3072 * 1024 * 2, W_UP = W_OUTCD + 1024 * 1024 * 2, W_DN = W_UP + 2 * (size_t)5632 * 1024 * 2, W_END = W_DN + 2 * (size_t)1024 * 2816 * 2;
static_assert(W_END <= 79 * MiB, "weights");
constexpr size_t WS_HB = 79 * MiB;
constexpr size_t WS_XN = 151 * MiB;
constexpr size_t WS_R = 223 * MiB;
constexpr size_t R_A5 = WS_HB  , R_CQ = WS_R + (size_t)32 * 2304 * 512 * 2, R_CKV = R_CQ + (size_t)TT * 384 * 2, R_CAT = WS_R;
constexpr size_t R_Q = WS_R + 117 * MiB, R_K = R_Q + (size_t)TT * 768 * 2, R_V = R_K + (size_t)TT * 768 * 2, R_G = R_CQ, R_END0 = R_V + (size_t)TT * 512 * 2;
constexpr size_t R_HH = WS_R;
constexpr size_t R_CAT1 = WS_R, R_RK = R_CAT1 + (size_t)TT * 1024 * 2, R_RV = R_RK + (size_t)TT * 512 * 2, R_RG = R_RV + (size_t)TT * 512 * 2, R_GK = R_RG + (size_t)TT * 512 * 2, R_GV = R_GK + (size_t)TT * 256 * 2, R_ST = R_GV + (size_t)TT * 256 * 2;
constexpr size_t WS_END = WS_R + 261 * MiB;
static_assert(R_G + (size_t)TT * 512 * 2 <= R_Q && R_CKV + (size_t)TT * 256 * 2 <= R_Q && R_END0 <= WS_END && R_HH + (size_t)TT * FFH * 2 <= WS_END && R_ST + (size_t)16 * 4 * 2 * 8 * 16384 * 2 <= WS_END && WS_END <= 512 * MiB, "ws map");

namespace pg8 {
constexpr int BM = 256, BK = 64, HALF = 128, HTB = HALF * BK * 2, STAGE_BYTES = 8 * HTB, NXCD = 8, WGM = 6;
__host__ __device__ __forceinline__ int lds_byte(int r, int c) { const int st = (r >> 4) * 2 + (c >> 5), rr = r & 15, cc = c & 31, ob = rr * 64 + cc * 2; return st * 1024 + (ob ^ (((ob >> 9) & 1) << 5)); }
__host__ __device__ __forceinline__ void stage_rc(int b, int& R, int& C) { const int st = b / 1024, sb = b % 1024, swz = sb ^ (((sb >> 9) & 1) << 5); R = (st >> 1) * 16 + swz / 64; C = (st & 1) * 32 + (swz % 64) / 2; }
__host__ __device__ __forceinline__ int perm32(int rho) { const int n = rho >> 4, i = rho & 15; return 8 * (i >> 2) + 4 * n + (i & 3); }
struct Unit { int pm, pn; };
struct Gemm { const bf16_t* A; const bf16_t* Bt; int K; int lda; int ldb; };
constexpr int PG8_FLAG_OFF = 131072 + 8192 + 1024;
struct StaticOrder {
    int nM, nN, nwg, G, c;
    __host__ __device__ void init(int nM_, int nN_, int G_, int c_) { nM = nM_; nN = nN_; nwg = nM * nN; G = G_; c = c_; }
    __host__ __device__ bool next(int i, Unit& u) const {
        const long L = (long)i * G + c; if (L >= nwg) return false;
        int wgid = (int)L; { const int q = nwg / NXCD, r = nwg % NXCD, xcd = wgid % NXCD, off = wgid / NXCD; wgid = (xcd < r ? xcd * (q + 1) : r * (q + 1) + (xcd - r) * q) + off; }
        const int nig = WGM * nN, gid = wgid / nig, fm = gid * WGM, gsz = (nM - fm) < WGM ? (nM - fm) : WGM;
        u.pm = fm + ((wgid % nig) % gsz); u.pn = (wgid % nig) / gsz; return true;
    }
};
template <class Epi, class Sched, bool APERM, bool ABLK = false, bool RELAX = true>
__device__ __forceinline__ void gemm_phase(LAS unsigned char* lds, const Gemm g, const Sched& S, const Epi& E) {
    int tid_l = threadIdx.x; asm volatile("" : "+v"(tid_l));
    const int tid = tid_l, wid = __builtin_amdgcn_readfirstlane(tid >> 6), lane = tid & 63, wr = wid >> 2, wc = wid & 3, fr = lane & 15, fq = lane >> 4;
    const int K = g.K, nt = K / BK, lda = g.lda, ldb = g.ldb ? g.ldb : g.K;
    unsigned voffA[2], voffB[2];
#pragma unroll
    for (int i = 0; i < 2; ++i) { int R, C; stage_rc(tid * 16 + i * 8192, R, C); const int Rb = (R & ~31) + perm32(R & 31);
        const int Ra = APERM ? (128 * (R >> 6) + 8 * (R & 15) + ((R >> 4) & 3)) : R;
        voffA[i] = ABLK ? (unsigned)(((C >> 5) * TT + Ra) * 32 + (C & 31)) * 2u : (unsigned)(Ra * lda + C) * 2u; voffB[i] = (unsigned)(Rb * ldb + C) * 2u; }
    const size_t kstep = (size_t)(BK * 2), kstepA = ABLK ? (size_t)2 * TT * 32 * 2 : kstep;
    const size_t hstepB = (size_t)HALF * ldb * 2, hstepA = ABLK ? (size_t)HALF * 32 * 2 : APERM ? (size_t)4 * lda * 2 : (size_t)HALF * lda * 2;
    const size_t tstep = (size_t)256 * ldb * 2, tstepA = ABLK ? (size_t)256 * 32 * 2 : (size_t)256 * lda * 2;
    const unsigned ldsw = (unsigned)wid * 1024u;
    const int aoff = lds_byte(wr * 64 + fr, fq * 8), boff = lds_byte(wc * 32 + fr, fq * 8);
#define PG8_SA(b, h) (((b) * 2 + (h)) * HTB)
#define PG8_SB(b, h) ((4 + (b) * 2 + (h)) * HTB)
#define PG8_STAGE(bufoff, gbase, voff) do { _Pragma("unroll") for (int _i = 0; _i < 2; ++_i) \
        __builtin_amdgcn_global_load_lds((const unsigned*)((const char*)(gbase) + (voff)[_i]), (LAS unsigned*)(lds + (bufoff) + ldsw + _i * 8192), 16, 0, 0); } while (0)
#define PG8_LDA(dst, b, h) do { _Pragma("unroll") for (int m = 0; m < 4; ++m) _Pragma("unroll") for (int k = 0; k < 2; ++k) dst[m][k] = *(const LAS bf16x8*)(lds + PG8_SA(b, h) + aoff + m * 2048 + k * 1024); } while (0)
#define PG8_LDB(dst, b, h) do { _Pragma("unroll") for (int n = 0; n < 2; ++n) _Pragma("unroll") for (int k = 0; k < 2; ++k) dst[n][k] = *(const LAS bf16x8*)(lds + PG8_SB(b, h) + boff + n * 2048 + k * 1024); } while (0)
#define PG8_MMA(ai, bj, At, Bt) do { __builtin_amdgcn_s_setprio(1); _Pragma("unroll") for (int m = 0; m < 4; ++m) _Pragma("unroll") for (int n = 0; n < 2; ++n) _Pragma("unroll") for (int k = 0; k < 2; ++k) \
        acc[ai][bj][m][n] = __builtin_amdgcn_mfma_f32_16x16x32_bf16(Bt[n][k], At[m][k], acc[ai][bj][m][n], 0, 0, 0); __builtin_amdgcn_s_setprio(0); } while (0)
#define PG8_WAIT_V(n) asm volatile("s_waitcnt vmcnt(" #n ")" ::: "memory")
#define PG8_WAIT_L(n) asm volatile("s_waitcnt lgkmcnt(" #n ")" ::: "memory")
#define PG8_BAR __builtin_amdgcn_s_barrier()
#define PG8_FLAG(v) do { } while (0)
#define PG8_WAIT_V8R do { if constexpr (!RELAX) PG8_WAIT_V(8); else asm volatile("s_cmp_lg_u32 %0, 0\n\ts_cbranch_scc1 .Lrn%=\n\ts_cmp_eq_u32 %1, 0\n\ts_cbranch_scc1 .Lrn%=\n\ts_waitcnt vmcnt(24)\n\ts_branch .Lre%=\n.Lrn%=:\n\ts_waitcnt vmcnt(8)\n.Lre%=:" \
        :: "s"(__builtin_amdgcn_readfirstlane(t)), "s"(__builtin_amdgcn_readfirstlane(ui)) : "memory", "scc"); } while (0)
#define PG8_SCHED __builtin_amdgcn_sched_barrier(0)
    Unit cur, nxt; int ui = 0;
    if (!S.next(0, cur)) return;
    f32x4 acc[2][2][4][2];
#pragma unroll
    for (int a = 0; a < 2; ++a)
#pragma unroll
        for (int b = 0; b < 2; ++b)
#pragma unroll
            for (int m = 0; m < 4; ++m)
#pragma unroll
                for (int n = 0; n < 2; ++n) acc[a][b][m][n] = (f32x4){0.f, 0.f, 0.f, 0.f};
    bf16x8 At[4][2], B0[2][2], B1[2][2];
    const char* cA = (const char*)g.A + (size_t)cur.pm * tstepA; const char* cB = (const char*)g.Bt + (size_t)cur.pn * tstep;
    PG8_FLAG(0u);
    if constexpr (Epi::PREFETCH) E.prefetch(cur, 0);
    PG8_STAGE(PG8_SB(0, 0), cB, voffB); PG8_STAGE(PG8_SB(0, 1), cB + hstepB, voffB); PG8_STAGE(PG8_SA(0, 0), cA, voffA); PG8_STAGE(PG8_SA(0, 1), cA + hstepA, voffA);
    if (wr == 1) PG8_BAR;
    PG8_WAIT_V(2); PG8_BAR;
    PG8_STAGE(PG8_SB(1, 0), cB + kstep, voffB); PG8_STAGE(PG8_SA(1, 0), cA + kstepA, voffA); PG8_STAGE(PG8_SB(1, 1), cB + hstepB + kstep, voffB);
    PG8_WAIT_V(6); PG8_BAR;
    for (;;) {
        const bool has_next = S.next(ui + 1, nxt);
        const char* nA = has_next ? (const char*)g.A + (size_t)nxt.pm * tstepA : cA; const char* nB = has_next ? (const char*)g.Bt + (size_t)nxt.pn * tstep : cB;
        for (int t = 0; t < nt; t += 2) {
            const bool last = (t == nt - 2);
            const char* a1 = cA + (size_t)(t + 1) * kstepA;
            const char* a2 = last ? nA : cA + (size_t)(t + 2) * kstepA; const char* b2 = last ? nB : cB + (size_t)(t + 2) * kstep;
            const char* a3 = a2 + kstepA; const char* b3 = b2 + kstep;
            PG8_LDB(B0, 0, 0); PG8_LDB(B1, 0, 1); PG8_SCHED; PG8_LDA(At, 0, 0); PG8_STAGE(PG8_SA(1, 1), a1 + hstepA, voffA);
            PG8_WAIT_V8R; PG8_WAIT_L(0); PG8_BAR; PG8_MMA(0, 0, At, B0); PG8_MMA(0, 1, At, B1); PG8_BAR; PG8_SCHED;
            PG8_LDA(At, 0, 1); PG8_STAGE(PG8_SB(0, 0), b2, voffB); PG8_STAGE(PG8_SB(0, 1), b2 + hstepB, voffB); PG8_STAGE(PG8_SA(0, 0), a2, voffA);
            PG8_WAIT_V8R; PG8_FLAG(0u); PG8_WAIT_L(0); PG8_BAR; PG8_MMA(1, 0, At, B0); PG8_MMA(1, 1, At, B1); PG8_BAR; PG8_SCHED;
            PG8_LDB(B0, 1, 0); PG8_LDB(B1, 1, 1); PG8_SCHED; PG8_LDA(At, 1, 0); PG8_STAGE(PG8_SA(0, 1), a2 + hstepA, voffA);
            PG8_WAIT_V(8); PG8_WAIT_L(0); PG8_BAR; PG8_MMA(0, 0, At, B0); PG8_MMA(0, 1, At, B1); PG8_BAR; PG8_SCHED;
            PG8_LDA(At, 1, 1); PG8_STAGE(PG8_SB(1, 0), b3, voffB); PG8_STAGE(PG8_SB(1, 1), b3 + hstepB, voffB); PG8_STAGE(PG8_SA(1, 0), a3, voffA);
            PG8_WAIT_V(8); PG8_WAIT_L(0); PG8_BAR; PG8_MMA(1, 0, At, B0); PG8_MMA(1, 1, At, B1); PG8_BAR; PG8_SCHED;
        }
        if (wr == 0) PG8_BAR;
        if constexpr (Epi::PREFETCH) { if (has_next) E.prefetch(nxt, (ui + 1) & 1); }
        { int frl = fr, fql = fq; asm volatile("" : "+v"(frl), "+v"(fql));
          E(acc, cur, wr, wc, frl, fql, ui & 1); }
        if (!has_next) break;
        PG8_FLAG(1u);
#pragma unroll
        for (int a = 0; a < 2; ++a)
#pragma unroll
            for (int b = 0; b < 2; ++b)
#pragma unroll
                for (int m = 0; m < 4; ++m)
#pragma unroll
                    for (int n = 0; n < 2; ++n) acc[a][b][m][n] = (f32x4){0.f, 0.f, 0.f, 0.f};
        cur = nxt; cA = nA; cB = nB; ++ui;
        if (wr == 1) PG8_BAR;
    }
    PG8_WAIT_V(0);
    PG8_BAR;
#undef PG8_SA
#undef PG8_SB
#undef PG8_STAGE
#undef PG8_LDA
#undef PG8_LDB
#undef PG8_MMA
#undef PG8_WAIT_V
#undef PG8_WAIT_L
#undef PG8_BAR
#undef PG8_FLAG
#undef PG8_WAIT_V8R
#undef PG8_SCHED
}
}
struct MArgs { const float* in[32]; float* out; unsigned char* ws; int ph_lo, ph_hi; };

struct SchedFull { pg8::StaticOrder so; __device__ __forceinline__ bool next(int i, pg8::Unit& u) const { return so.next(i, u); } };
struct SchedLat {
    pg8::StaticOrder so;
    __device__ __forceinline__ bool next(int i, pg8::Unit& u) const { if (!so.next(i, u)) return false; u.pm = (u.pm >> 3) * 9 + 1 + (u.pm & 7); return true; }
};
struct SchedInCd {
    pg8::StaticOrder so; int G, c;
    __device__ __forceinline__ bool next(int i, pg8::Unit& u) const {
        const int L = i * G + c;
        if (L < 1536) { so.next(i, u); u.pm = (u.pm >> 3) * 9 + 1 + (u.pm & 7); return true; }
        const int L2 = L - 1536; if (L2 >= 96) return false;
        const int q = L2 % 6; u.pm = (L2 / 6) * 9; u.pn = q < 4 ? 2 + q : 6 + q; return true;
    }
};

enum { EK_INAB = 0, EK_Q, EK_KV, EK_GLU, EK_RES, EK_UP, EK_INCD, EK_S5E, EK_S5Y };
struct SchedS5 { int G, c; __device__ __forceinline__ bool next(int i, pg8::Unit& u) const { const int L = i * G + c; if (L >= 288) return false; u.pm = L; u.pn = L / 9; return true; } };
template <bool UPK> struct Epi {
    static constexpr bool PREFETCH = UPK;
    int kind;
    unsigned char* ws;
    LAS float* scr;
    unsigned* wflag;
    const float* hin_c; const float* hin_l; const float* gate;
    const float* cw; const float* cb;
    const float* bglu;
    const float* gq; const float* gk;

    __device__ __forceinline__ void prefetch(const pg8::Unit& u, int buf) const {
        const int t = threadIdx.x, arr = t >> 7, col = t & 127; const float* src = (arr < 3 ? cw + arr * FFH : cb) + u.pn * 128 + col;
        const int wv = __builtin_amdgcn_readfirstlane(t >> 6);
        __builtin_amdgcn_global_load_lds((const unsigned*)src, (LAS unsigned*)(scr + buf * 512 + wv * 64), 4, 0, 0);
    }
    __device__ __forceinline__ void operator()(const f32x4 (&acc)[2][2][4][2], const pg8::Unit& u, int wr, int wc, int fr, int fq, int buf) const {
        const int jt = u.pm % 9, bb = u.pm / 9; const bool lat = jt != 0;
        const int rloc0 = wr * 64 + fr;
        if (!UPK && kind == EK_INAB) {
            bf16_t* A5 = (bf16_t*)(ws + R_A5); bf16_t* CQ = (bf16_t*)(ws + R_CQ); bf16_t* CKV = (bf16_t*)(ws + R_CKV); bf16_t* Kb = (bf16_t*)(ws + R_K);
            float* PS = (float*)(ws + WS_PS); const float* cs = (const float*)(ws + WS_R64C); const float* sn = (const float*)(ws + WS_R64S);
#pragma unroll
            for (int bj = 0; bj < 2; ++bj) {
                const int cbase = u.pn * 256 + bj * 128 + wc * 32;
                if (cbase >= 1216) continue;
                const int c0 = cbase + 8 * fq;
#pragma unroll
                for (int ai = 0; ai < 2; ++ai)
#pragma unroll
                    for (int m = 0; m < 4; ++m) {
                        const int rl = ai * 128 + m * 16 + rloc0; const size_t row = (size_t)u.pm * 256 + rl;
                        f32x4 v0 = acc[ai][bj][m][0], v1 = acc[ai][bj][m][1];
                        if (cbase < 512) { const int pos = jt * 256 + rl; store8(A5 + ((size_t)(c0 >> 4) * 2304 + bb * 144 + (pos >> 4)) * 512 + (pos & 15) * 16 + (c0 & 15), v0, v1); }
                        else if (cbase < 1152) {
                            float s = (v0[0] * v0[0] + v0[1] * v0[1]) + (v0[2] * v0[2] + v0[3] * v0[3]) + (v1[0] * v1[0] + v1[1] * v1[1]) + (v1[2] * v1[2] + v1[3] * v1[3]);
                            s += __shfl_xor(s, 16); s += __shfl_xor(s, 32);
                            if (fq == 0) PS[row * 40 + (cbase >> 5)] = s;
                            if (cbase < 896) store8(CQ + row * 384 + (c0 - 512), v0, v1); else store8(CKV + row * 256 + (c0 - 896), v0, v1);
                        } else {
                            const int wcc = (cbase - 1152) >> 5;
                            if (lat) {
                                const int t = (jt - 1) * 256 + rl;
                                const f32x4 ca = *(const f32x4*)(cs + t * 32 + wcc * 16 + 8 * (fq & 1)), cb2 = *(const f32x4*)(cs + t * 32 + wcc * 16 + 8 * (fq & 1) + 4);
                                const f32x4 sa = *(const f32x4*)(sn + t * 32 + wcc * 16 + 8 * (fq & 1)), sb2 = *(const f32x4*)(sn + t * 32 + wcc * 16 + 8 * (fq & 1) + 4);
                                f32x4 p0, p1;
#pragma unroll
                                for (int j = 0; j < 4; ++j) { p0[j] = __shfl_xor(v0[j], 32); p1[j] = __shfl_xor(v1[j], 32); }
                                const float sg = (fq < 2) ? -1.f : 1.f;
#pragma unroll
                                for (int j = 0; j < 4; ++j) { v0[j] = v0[j] * ca[j] + sg * p0[j] * sa[j]; v1[j] = v1[j] * cb2[j] + sg * p1[j] * sb2[j]; }
                            }
#pragma unroll
                            for (int h = 0; h < 4; ++h) store8(Kb + row * 768 + h * 192 + 128 + wcc * 32 + 8 * fq, v0, v1);
                        }
                    }
            }
        } else if (!UPK && (kind == EK_Q || kind == EK_KV)) {
            const float* PS = (const float*)(ws + WS_PS);
            bf16_t* Q = (bf16_t*)(ws + R_Q); const float* cs = (const float*)(ws + WS_R64C); const float* sn = (const float*)(ws + WS_R64S);
            bf16_t* Kb = (bf16_t*)(ws + R_K); bf16_t* Vb = (bf16_t*)(ws + R_V);
            if (wr == 0) { const int r = wc * 64 + fq * 16 + fr; const size_t row = (size_t)u.pm * 256 + r; float rq;
                if (kind == EK_Q) { const f32x4 a = *(const f32x4*)(PS + row * 40 + 16), b = *(const f32x4*)(PS + row * 40 + 20), c = *(const f32x4*)(PS + row * 40 + 24);
                    const float s = ((a[0] + a[1]) + (a[2] + a[3])) + ((b[0] + b[1]) + (b[2] + b[3])) + ((c[0] + c[1]) + (c[2] + c[3])); rq = rsqrtf(s * (1.f / 384.f) + EPS_N); }
                else { const f32x4 a = *(const f32x4*)(PS + row * 40 + 28), b = *(const f32x4*)(PS + row * 40 + 32);
                    const float s = ((a[0] + a[1]) + (a[2] + a[3])) + ((b[0] + b[1]) + (b[2] + b[3])); rq = rsqrtf(s * (1.f / 256.f) + EPS_N); }
                scr[r] = rq; }
            asm volatile("s_waitcnt lgkmcnt(0)" ::: "memory"); __builtin_amdgcn_s_barrier(); asm volatile("" ::: "memory");
#pragma unroll
            for (int ai = 0; ai < 2; ++ai)
#pragma unroll
                for (int m = 0; m < 4; ++m) {
                    const int rl = ai * 128 + m * 16 + rloc0; const size_t row = (size_t)u.pm * 256 + rl; const float rsc = scr[rl];
#pragma unroll
                    for (int bj = 0; bj < 2; ++bj) {
                        f32x4 v0 = acc[ai][bj][m][0] * rsc, v1 = acc[ai][bj][m][1] * rsc;
                        if (kind == EK_Q) {
                            const int cbase = u.pn * 256 + bj * 128 + wc * 32, d0 = cbase % 192; const bool rp = d0 >= 128; const int wcc = (d0 - 128) >> 5;
                            if (rp && lat) {
                                const int t = (jt - 1) * 256 + rl; const int to = t * 32 + wcc * 16 + 8 * (fq & 1); const float sg = (fq < 2) ? -1.f : 1.f;
                                { const f32x4 ca = *(const f32x4*)(cs + to), sa = *(const f32x4*)(sn + to);
#pragma unroll
                                  for (int j = 0; j < 4; ++j) { const float pp = __shfl_xor(v0[j], 32); v0[j] = v0[j] * ca[j] + sg * pp * sa[j]; } }
                                { const f32x4 ca = *(const f32x4*)(cs + to + 4), sa = *(const f32x4*)(sn + to + 4);
#pragma unroll
                                  for (int j = 0; j < 4; ++j) { const float pp = __shfl_xor(v1[j], 32); v1[j] = v1[j] * ca[j] + sg * pp * sa[j]; } }
                            }
                            store8(Q + row * 768 + cbase + 8 * fq, v0, v1);
                        } else {
                            if (bj == 0) store8(Kb + row * 768 + u.pn * 192 + wc * 32 + 8 * fq, v0, v1); else store8(Vb + row * 512 + u.pn * 128 + wc * 32 + 8 * fq, v0, v1);
                        }
                    }
                    __builtin_amdgcn_sched_barrier(0);
                }
        } else if (!UPK && kind == EK_GLU) {
            const bf16_t* G = (const bf16_t*)(ws + R_G); bf16_t* CAT = (bf16_t*)(ws + R_CAT);
#pragma unroll
            for (int bj = 0; bj < 2; ++bj) {
                const int c0 = u.pn * 256 + bj * 128 + wc * 32 + 8 * fq; const f32x4 b0 = *(const f32x4*)(bglu + c0), b1 = *(const f32x4*)(bglu + c0 + 4);
                u32x4 gwq[8];
#pragma unroll
                for (int q = 0; q < 8; ++q) { const size_t row = (size_t)u.pm * 256 + (q >> 2) * 128 + (q & 3) * 16 + rloc0; gwq[q] = *(const u32x4*)(G + row * 512 + c0); }
                __builtin_amdgcn_sched_barrier(0);
#pragma unroll
                for (int ai = 0; ai < 2; ++ai)
#pragma unroll
                    for (int m = 0; m < 4; ++m) { const size_t row = (size_t)u.pm * 256 + ai * 128 + m * 16 + rloc0;
                        const u32x4 gw = gwq[ai * 4 + m]; f32x4 v0 = acc[ai][bj][m][0] + b0, v1 = acc[ai][bj][m][1] + b1;
                        v0[0] = bflo(gw.x) * fast_sigmoid(v0[0]); v0[1] = bfhi(gw.x) * fast_sigmoid(v0[1]); v0[2] = bflo(gw.y) * fast_sigmoid(v0[2]); v0[3] = bfhi(gw.y) * fast_sigmoid(v0[3]);
                        v1[0] = bflo(gw.z) * fast_sigmoid(v1[0]); v1[1] = bfhi(gw.z) * fast_sigmoid(v1[1]); v1[2] = bflo(gw.w) * fast_sigmoid(v1[2]); v1[3] = bfhi(gw.w) * fast_sigmoid(v1[3]);
                        store8(CAT + row * 1024 + c0, v0, v1); }
            }
        } else if (!UPK && kind == EK_RES) {
            if (wflag) {
                if (wr == 0 && wc == 0 && fr == 0 && fq == 0) { unsigned sp_ = 0; while (__hip_atomic_load(wflag, __ATOMIC_RELAXED, __HIP_MEMORY_SCOPE_AGENT) == 0u && ++sp_ < (1u << 22)) __builtin_amdgcn_s_sleep(1);
                    __builtin_amdgcn_fence(__ATOMIC_ACQUIRE, "agent"); }
                __builtin_amdgcn_s_barrier(); asm volatile("" ::: "memory");
            }
            const float* hi_ = lat ? hin_l + ((size_t)bb * NLAT + (jt - 1) * 256) * DMODEL : hin_c + (size_t)bb * NCTX * DMODEL;
            bf16_t* HB = (bf16_t*)(ws + WS_HB) + (size_t)u.pm * 256 * DMODEL; const bool first = hin_l != nullptr;
            const float* gt = gate + (size_t)(lat ? bb : 16) * 6144;
#pragma unroll
            for (int bj = 0; bj < 2; ++bj) {
                const int c0 = u.pn * 256 + bj * 128 + wc * 32 + 8 * fq; const f32x4 g0 = *(const f32x4*)(gt + c0), g1 = *(const f32x4*)(gt + c0 + 4);
                if (first) { f32x4 h0[8], h1[8];
#pragma unroll
                    for (int q = 0; q < 8; ++q) { const size_t off = (size_t)((q >> 2) * 128 + (q & 3) * 16 + rloc0) * DMODEL + c0; h0[q] = *(const f32x4*)(hi_ + off); h1[q] = *(const f32x4*)(hi_ + off + 4); }
                    __builtin_amdgcn_sched_barrier(0);
#pragma unroll
                    for (int q = 0; q < 8; ++q) { const size_t off = (size_t)((q >> 2) * 128 + (q & 3) * 16 + rloc0) * DMODEL + c0;
                        store8(HB + off, h0[q] + g0 * acc[q >> 2][bj][q & 3][0], h1[q] + g1 * acc[q >> 2][bj][q & 3][1]); }
                } else { u32x4 hw[8];
#pragma unroll
                    for (int q = 0; q < 8; ++q) { const size_t off = (size_t)((q >> 2) * 128 + (q & 3) * 16 + rloc0) * DMODEL + c0; hw[q] = *(const u32x4*)(HB + off); }
                    __builtin_amdgcn_sched_barrier(0);
#pragma unroll
                    for (int q = 0; q < 8; ++q) { const size_t off = (size_t)((q >> 2) * 128 + (q & 3) * 16 + rloc0) * DMODEL + c0;
                        const f32x4 h0 = (f32x4){bflo(hw[q].x), bfhi(hw[q].x), bflo(hw[q].y), bfhi(hw[q].y)}, h1 = (f32x4){bflo(hw[q].z), bfhi(hw[q].z), bflo(hw[q].w), bfhi(hw[q].w)};
                        store8(HB + off, h0 + g0 * acc[q >> 2][bj][q & 3][0], h1 + g1 * acc[q >> 2][bj][q & 3][1]); }
                }
                __builtin_amdgcn_sched_barrier(0);
            }
        } else if (UPK) {
            bf16_t* HH = (bf16_t*)(ws + R_HH); float* EP = (float*)(ws + WS_EDGE); float* EG = EP + EDGE_ARR / 4; float* EA = EG + EDGE_ARR / 4;
            const int jc = u.pn * 128 + wc * 32 + 8 * fq;
            float w0[8], w1[8], w2[8], cbv[8], pvv[8], nxx[8]; const LAS float* cl = scr + buf * 512 + wc * 32 + 8 * fq;
#pragma unroll
            for (int c = 0; c < 8; ++c) { w0[c] = cl[c]; w1[c] = cl[128 + c]; w2[c] = cl[256 + c]; cbv[c] = cl[384 + c];
                const float pv_ = __shfl_up(acc[1][0][3][c >> 2][c & 3], 1, 16), nx_ = __shfl_down(acc[0][0][0][c >> 2][c & 3], 1, 16);
                pvv[c] = fr == 0 ? 0.f : pv_; nxx[c] = fr == 15 ? 0.f : nx_; }
            const size_t tok0 = (size_t)u.pm * 256 + wr * 128 + 8 * fr; const int blk = 2 * u.pm + wr;
#pragma unroll
            for (int ai = 0; ai < 2; ++ai)
#pragma unroll
                for (int m = 0; m < 4; ++m) {
                    const int idx = 4 * ai + m; float hv[8], av[8], gv[8];
#pragma unroll
                    for (int c = 0; c < 8; ++c) { const int n = c >> 2, jj = c & 3;
                        const float cur = acc[ai][0][m][n][jj];
                        const float prev = idx == 0 ? pvv[c] : (m > 0 ? acc[ai][0][m - 1][n][jj] : acc[0][0][3][n][jj]);
                        const float next = idx == 7 ? nxx[c] : (m < 3 ? acc[ai][0][m + 1][n][jj] : acc[1][0][0][n][jj]);
                        const float cv = cbv[c] + w0[c] * prev + w1[c] * cur + w2[c] * next;
                        av[c] = cur; gv[c] = acc[ai][1][m][n][jj]; hv[c] = cv; }
                    const bool edge0 = (idx == 0 && fr == 0), edge1 = (idx == 7 && fr == 15);
                    if (edge0 || edge1) { const size_t eo = ((size_t)blk * 2 + (edge1 ? 1 : 0)) * FFH + jc;
#pragma unroll
                        for (int c = 0; c < 8; ++c) { EP[eo + c] = hv[c]; EG[eo + c] = gv[c]; EA[eo + c] = av[c]; }
                    } else { f32x4 o0, o1;
#pragma unroll
                        for (int c = 0; c < 4; ++c) { o0[c] = gelu_t(hv[c]) * gv[c]; o1[c] = gelu_t(hv[4 + c]) * gv[4 + c]; }
                        store8(HH + ((size_t)(u.pn * 4 + wc) * TT + tok0 + idx) * 32 + 8 * fq, o0, o1); }
                }
        } else if (!UPK && kind == EK_S5E) {
            bf16_t* E = (bf16_t*)(ws + WS_XN);
#pragma unroll
            for (int bj = 0; bj < 2; ++bj)
#pragma unroll
                for (int ai = 0; ai < 2; ++ai)
#pragma unroll
                    for (int m = 0; m < 4; ++m) store8(E + ((size_t)u.pm * 256 + ai * 128 + m * 16 + rloc0) * 256 + bj * 128 + wc * 32 + 8 * fq, acc[ai][bj][m][0], acc[ai][bj][m][1]);
        } else if (!UPK && kind == EK_S5Y) {
            bf16_t* G = (bf16_t*)(ws + R_G); const int g = u.pn, j9 = u.pm - 9 * g;
#pragma unroll
            for (int bj = 0; bj < 2; ++bj) { const int n0 = bj * 128 + wc * 32 + 8 * fq, t = n0 >> 4, h0 = n0 & 15;
#pragma unroll
                for (int ai = 0; ai < 2; ++ai)
#pragma unroll
                    for (int m = 0; m < 4; ++m) { const int cr = j9 * 256 + ai * 128 + m * 16 + rloc0, b = cr / 144, c = cr - b * 144;
                        f32x4 v0 = acc[ai][bj][m][0], v1 = acc[ai][bj][m][1];
#pragma unroll
                        for (int q = 0; q < 4; ++q) { v0[q] = gelu_t(v0[q]); v1[q] = gelu_t(v1[q]); }
                        store8(G + ((size_t)b * RB + 16 * c + t) * 512 + 16 * g + h0, v0, v1); } }
        } else if (!UPK && kind == EK_INCD) {
            const int pn = u.pn; const int grp = pn < 2 ? 0 : pn < 4 ? 1 : pn < 6 ? 2 : pn < 8 ? 3 : pn < 10 ? 4 : pn == 10 ? 5 : 6;
            const bool roped = (grp == 0 || grp == 1 || grp == 4 || grp == 5), hnorm = (grp == 4 || grp == 5);
            bf16_t* CAT1 = (bf16_t*)(ws + R_CAT1); const float* cs = (const float*)(ws + WS_R128C); const float* sn = (const float*)(ws + WS_R128S);
            float rs[2][2][4];
            if (hnorm) {
#pragma unroll
                for (int bj = 0; bj < 2; ++bj)
#pragma unroll
                    for (int ai = 0; ai < 2; ++ai)
#pragma unroll
                        for (int m = 0; m < 4; ++m) { const f32x4 v0 = acc[ai][bj][m][0], v1 = acc[ai][bj][m][1];
                            float s = (v0[0] * v0[0] + v0[1] * v0[1]) + (v0[2] * v0[2] + v0[3] * v0[3]) + (v1[0] * v1[0] + v1[1] * v1[1]) + (v1[2] * v1[2] + v1[3] * v1[3]);
                            s += __shfl_xor(s, 16); s += __shfl_xor(s, 32);
                            if (fq == 0) scr[(((wr * 2 + bj) * 8 + ai * 4 + m) * 16 + fr) * 4 + wc] = s; }
                asm volatile("s_waitcnt lgkmcnt(0)" ::: "memory"); __builtin_amdgcn_s_barrier(); asm volatile("" ::: "memory");
#pragma unroll
                for (int bj = 0; bj < 2; ++bj)
#pragma unroll
                    for (int ai = 0; ai < 2; ++ai)
#pragma unroll
                        for (int m = 0; m < 4; ++m) { const f32x4 p = *(const LAS f32x4*)(scr + (((wr * 2 + bj) * 8 + ai * 4 + m) * 16 + fr) * 4);
                            rs[bj][ai][m] = rsqrtf(((p[0] + p[1]) + (p[2] + p[3])) * (1.f / 128.f) + EPS_N); }
                asm volatile("s_waitcnt lgkmcnt(0)" ::: "memory"); __builtin_amdgcn_s_barrier(); asm volatile("" ::: "memory");
            }
            const int dloc = 32 * wc + 8 * fq;
            bf16_t* dbase; int dld;
            if (grp == 0) { dbase = CAT1; dld = 1024; } else if (grp == 1) { dbase = (bf16_t*)(ws + R_RK); dld = 512; } else if (grp == 2) { dbase = (bf16_t*)(ws + R_RV); dld = 512; }
            else if (grp == 3) { dbase = (bf16_t*)(ws + R_RG); dld = 512; } else if (grp == 4) { dbase = CAT1 + 512; dld = 1024; } else if (grp == 5) { dbase = (bf16_t*)(ws + R_GK); dld = 256; } else { dbase = (bf16_t*)(ws + R_GV); dld = 256; }
            float gw[8];
            if (hnorm) {
#pragma unroll
                for (int c = 0; c < 8; ++c) { const int dp = dloc + c, orig = (dp & 64) + ((dp & 1) ? 32 : 0) + ((dp & 63) >> 1); gw[c] = (grp == 4 ? gq : gk)[orig]; }
            }
#pragma unroll
            for (int ai = 0; ai < 2; ++ai)
#pragma unroll
                for (int m = 0; m < 4; ++m) {
                    const int rl = ai * 128 + m * 16 + rloc0; const size_t row = (size_t)u.pm * 256 + rl;
                    f32x4 c4 = {}, s4 = {};
                    if (roped && lat) { const int t = (jt - 1) * 256 + rl; const int ti = t * 64 + 32 * (wc >> 1) + 16 * (wc & 1) + 4 * fq; c4 = *(const f32x4*)(cs + ti); s4 = *(const f32x4*)(sn + ti); }
#pragma unroll
                    for (int bj = 0; bj < 2; ++bj) {
                        const int hh = (grp >= 5) ? bj : (pn & 1) * 2 + bj;
                        f32x4 v0 = acc[ai][bj][m][0], v1 = acc[ai][bj][m][1];
                        if (hnorm) { const float r = rs[bj][ai][m];
#pragma unroll
                            for (int c = 0; c < 4; ++c) { v0[c] = v0[c] * r * gw[c]; v1[c] = v1[c] * r * gw[4 + c]; } }
                        if (grp == 1) { v0 = v0 * 0.08838834764831845f; v1 = v1 * 0.08838834764831845f; }
                        if (roped && lat) {
                            f32x4 o0, o1;
                            o0[0] = v0[0] * c4[0] - v0[1] * s4[0]; o0[1] = v0[1] * c4[0] + v0[0] * s4[0]; o0[2] = v0[2] * c4[1] - v0[3] * s4[1]; o0[3] = v0[3] * c4[1] + v0[2] * s4[1];
                            o1[0] = v1[0] * c4[2] - v1[1] * s4[2]; o1[1] = v1[1] * c4[2] + v1[0] * s4[2]; o1[2] = v1[2] * c4[3] - v1[3] * s4[3]; o1[3] = v1[3] * c4[3] + v1[2] * s4[3];
                            v0 = o0; v1 = o1;
                        }
                        bf16_t* dst = dbase + row * dld + 128 * hh + dloc;
                        store8(dst, v0, v1);
                    }
            }
        }
    }
};
namespace att {
constexpr int NW = 8, QBLK = 32, KVBLK = 64;
constexpr float THR = 8.f;
#define SBAR() __builtin_amdgcn_sched_barrier(0)
__device__ __forceinline__ int crow(int r, int hi) { return (r & 3) + 8 * (r >> 2) + 4 * hi; }
__device__ __forceinline__ int v_st(int k, int c) { const int kk = (k & ~0xC) | ((k & 4) << 1) | ((k & 8) >> 1); return ((kk >> 3) * 4 + (c >> 5)) * 512 + ((kk & 7) * 32 + (c & 31)) * 2; }
__device__ __forceinline__ int v_rd_base(int lane) { return ((lane & 3) << 3) | (((lane >> 2) & 3) << 6) | (((lane >> 4) & 1) << 5) | (((lane >> 5) & 1) << 8); }
constexpr int v_rd_off(int d0, int ks, int half) { return d0 * 512 + ks * 4096 + half * 2048; }
template <int OFF> __device__ __forceinline__ s16x4 tr_read(int vb) { s16x4 r; asm volatile("ds_read_b64_tr_b16 %0, %1 offset:%2" : "=&v"(r) : "v"(vb), "i"(OFF) : "memory"); return r; }
template <int D0> __device__ __forceinline__ void pv_one(f32x16& od, int vb, bf16x8 pa0, bf16x8 pa1, bf16x8 pa2, bf16x8 pa3) {
  const s16x4 l0 = tr_read<v_rd_off(D0, 0, 0)>(vb), h0 = tr_read<v_rd_off(D0, 0, 1)>(vb), l1 = tr_read<v_rd_off(D0, 1, 0)>(vb), h1 = tr_read<v_rd_off(D0, 1, 1)>(vb);
  const s16x4 l2 = tr_read<v_rd_off(D0, 2, 0)>(vb), h2 = tr_read<v_rd_off(D0, 2, 1)>(vb), l3 = tr_read<v_rd_off(D0, 3, 0)>(vb), h3 = tr_read<v_rd_off(D0, 3, 1)>(vb);
  asm volatile("s_waitcnt lgkmcnt(0)" ::: "memory"); SBAR();
#define PK(L, H) (bf16x8){L[0], L[1], L[2], L[3], H[0], H[1], H[2], H[3]}
  od = __builtin_amdgcn_mfma_f32_32x32x16_bf16(pa0, PK(l0, h0), od, 0, 0, 0);
  od = __builtin_amdgcn_mfma_f32_32x32x16_bf16(pa1, PK(l1, h1), od, 0, 0, 0);
  od = __builtin_amdgcn_mfma_f32_32x32x16_bf16(pa2, PK(l2, h2), od, 0, 0, 0);
  od = __builtin_amdgcn_mfma_f32_32x32x16_bf16(pa3, PK(l3, h3), od, 0, 0, 0);
#undef PK
}
__device__ __forceinline__ void pv_d0(f32x16* o, int vb, bf16x8 pa0, bf16x8 pa1, bf16x8 pa2, bf16x8 pa3) {
  pv_one<0>(o[0], vb, pa0, pa1, pa2, pa3); pv_one<1>(o[1], vb, pa0, pa1, pa2, pa3); pv_one<2>(o[2], vb, pa0, pa1, pa2, pa3); pv_one<3>(o[3], vb, pa0, pa1, pa2, pa3);
}
__device__ __forceinline__ void pack_p(const f32x16& p0, const f32x16& p1, bf16x8& pa0, bf16x8& pa1, bf16x8& pa2, bf16x8& pa3) {
#define PK4(P, BASE, OUT) do { unsigned a0 = pk2(P[BASE + 0], P[BASE + 1]), a1 = pk2(P[BASE + 2], P[BASE + 3]);   \
    unsigned b0 = pk2(P[BASE + 4], P[BASE + 5]), b1 = pk2(P[BASE + 6], P[BASE + 7]);                              \
    auto r0 = __builtin_amdgcn_permlane32_swap(a0, b0, false, false); auto r1 = __builtin_amdgcn_permlane32_swap(a1, b1, false, false); \
    u32x4 w = {r0[0], r1[0], r0[1], r1[1]}; OUT = __builtin_bit_cast(bf16x8, w); } while (0)
  PK4(p0, 0, pa0); PK4(p0, 8, pa1); PK4(p1, 0, pa2); PK4(p1, 8, pa3);
#undef PK4
}
template <int DQK>
__device__ __forceinline__ void partialSM(f32x16& p0, f32x16& p1, float& m_reg, float& mn, float& alpha) {
  constexpr float SCALE = DQK == 128 ? 0.088388347648318440f : 0.072168783648703220f;
  constexpr float C = SCALE * LOG2E;
  float pmax = p0[0];
#pragma unroll
  for (int r = 1; r < 16; ++r) pmax = fmaxf(pmax, p0[r]);
#pragma unroll
  for (int r = 0; r < 16; ++r) pmax = fmaxf(pmax, p1[r]);
  { auto rr = __builtin_amdgcn_permlane32_swap(__float_as_uint(pmax), __float_as_uint(pmax), false, false);
    pmax = fmaxf(__uint_as_float(rr[0]), __uint_as_float(rr[1])); }
  if (__builtin_expect(__all(pmax - m_reg <= THR / SCALE), 1)) { mn = m_reg; alpha = 1.f; }
  else { mn = fmaxf(m_reg, pmax); alpha = __builtin_amdgcn_exp2f((m_reg - mn) * C); m_reg = mn; }
  const float mnC = -mn * C;
#pragma unroll
  for (int r = 0; r < 16; ++r) p0[r] = fmaf(p0[r], C, mnC);
#pragma unroll
  for (int r = 0; r < 16; ++r) p1[r] = fmaf(p1[r], C, mnC);
#pragma unroll
  for (int r = 0; r < 16; ++r) p0[r] = __builtin_amdgcn_exp2f(p0[r]);
}
__device__ __forceinline__ void finishSM(f32x16& p0, f32x16& p1, float alpha, float& l_reg, bf16x8& pa0, bf16x8& pa1, bf16x8& pa2, bf16x8& pa3) {
#pragma unroll
  for (int r = 0; r < 16; ++r) p1[r] = __builtin_amdgcn_exp2f(p1[r]);
  float ps = 0;
#pragma unroll
  for (int r = 0; r < 16; ++r) ps += p0[r];
#pragma unroll
  for (int r = 0; r < 16; ++r) ps += p1[r];
  { auto rr = __builtin_amdgcn_permlane32_swap(__float_as_uint(ps), __float_as_uint(ps), false, false);
    ps = __uint_as_float(rr[0]) + __uint_as_float(rr[1]); }
  l_reg = l_reg * alpha + ps;
  pack_p(p0, p1, pa0, pa1, pa2, pa3);
}
__device__ __forceinline__ void ret_weights(f32x16& p0, f32x16& p1, int kind, float dnb  , float lf2, float lb2) {
  if (kind == 0) {
    const float a = lf2 * dnb;
#pragma unroll
    for (int r = 0; r < 16; ++r) { const float c = (float)((r & 3) + 8 * (r >> 2));
      p0[r] *= __builtin_amdgcn_exp2f(fmaf(-lf2, c, a)); p1[r] *= __builtin_amdgcn_exp2f(fmaf(-lf2, c + 32.f, a)); }
  } else if (kind == 1) {
    const float a = -lb2 * dnb;
#pragma unroll
    for (int r = 0; r < 16; ++r) { const float c = (float)((r & 3) + 8 * (r >> 2));
      p0[r] *= __builtin_amdgcn_exp2f(fmaf(lb2, c, a)); p1[r] *= __builtin_amdgcn_exp2f(fmaf(lb2, c + 32.f, a)); }
  } else if (kind == 2) {
#pragma unroll
    for (int r = 0; r < 16; ++r) { const float c = (float)((r & 3) + 8 * (r >> 2));
      const float d0 = dnb - c, d1 = dnb - c - 32.f;
      const float w0 = (d0 >= 0.f ? __builtin_amdgcn_exp2f(lf2 * d0) : 0.f) + (d0 <= 0.f ? __builtin_amdgcn_exp2f(-lb2 * d0) : 0.f);
      const float w1 = (d1 >= 0.f ? __builtin_amdgcn_exp2f(lf2 * d1) : 0.f) + (d1 <= 0.f ? __builtin_amdgcn_exp2f(-lb2 * d1) : 0.f);
      p0[r] *= w0; p1[r] *= w1; }
  } else {
#pragma unroll
    for (int r = 0; r < 16; ++r) { const float c = (float)((r & 3) + 8 * (r >> 2));
      const float d0 = dnb - c, d1 = dnb - c - 32.f;
      p0[r] *= __builtin_amdgcn_exp2f(lf2 * d0) + __builtin_amdgcn_exp2f(lb2 * (2304.f - d0));
      p1[r] *= __builtin_amdgcn_exp2f(lf2 * d1) + __builtin_amdgcn_exp2f(lb2 * (2304.f - d1)); }
  }
}

template <int DQK> struct Shm { static constexpr int V = KVBLK * 128 * 2, K = KVBLK * DQK * 2, WSO = 2 * V + 2 * K, TOTAL = WSO + NW * 64 * 4; };

template <int DQK, int MODE, int SDEPTH, int ldq, int ldk, int ldv, int ldo, int ldg>
__device__ __forceinline__ void attn_unit(const bf16_t* Qb, const bf16_t* __restrict__ Kh, const bf16_t* __restrict__ Vh, bf16_t* Ob, int seq, char* lds,
                                          int n0, float lf2, float lb2, const bf16_t* Gb) {
  using SH = Shm<DQK>;
  constexpr int ND = DQK / 16, NKC = DQK / 8, KPT = DQK / 64, NLD = 2 + KPT;
#define KSWZ(row, colB) ((row) * (DQK * 2) + ((colB) ^ (((row) & 7) << 4)))
  int tid_ = threadIdx.x; asm volatile("" : "+v"(tid_));
  const int tid = tid_, wid = tid >> 6, lane = tid & 63, r32 = lane & 31, hi = lane >> 5;
  char* V_lds = lds; char* K_lds = lds + 2 * SH::V;
  float* ws = (float*)(lds + SH::WSO) + wid * 64; float* li_l = ws; float* al_l = ws + 32;
  float m_reg = -1e30f, l_reg = 0; f32x16 o[4] = {}; bf16x8 qr[ND];
  const bf16_t* Qw = Qb + (long)(wid * QBLK + r32) * ldq + hi * 8;
#pragma unroll
  for (int d0 = 0; d0 < ND; ++d0) qr[d0] = *reinterpret_cast<const bf16x8*>(Qw + d0 * 16);
  const int sr = tid >> 4, sc = (tid & 15) * 8, vst0 = v_st(sr, sc), vst1 = v_st(32 + sr, sc);
  int krow[KPT], kcol[KPT];
#pragma unroll
  for (int i = 0; i < KPT; ++i) { const int id = tid + 512 * i; krow[i] = id / NKC; kcol[i] = (id % NKC) * 8; }
  const int vb0 = (int)(uintptr_t)V_lds + v_rd_base(lane);
  struct { bf16x8 vs0, vs1, ks[KPT]; } sr_[SDEPTH == 0 ? 1 : SDEPTH];
  constexpr int SE = 0, SO = SDEPTH == 2 ? 1 : 0;
#define SLOAD(i, k0) do { sr_[i].vs0 = *reinterpret_cast<const bf16x8*>(&Vh[(long)((k0) + sr) * ldv + sc]); sr_[i].vs1 = *reinterpret_cast<const bf16x8*>(&Vh[(long)((k0) + 32 + sr) * ldv + sc]); \
    _Pragma("unroll") for (int q_ = 0; q_ < KPT; ++q_) sr_[i].ks[q_] = *reinterpret_cast<const bf16x8*>(&Kh[(long)((k0) + krow[q_]) * ldk + kcol[q_]]); } while (0)
#define SWRITE(b, i) do { *(bf16x8*)(V_lds + (b) * SH::V + vst0) = sr_[i].vs0; *(bf16x8*)(V_lds + (b) * SH::V + vst1) = sr_[i].vs1; \
    _Pragma("unroll") for (int q_ = 0; q_ < KPT; ++q_) *(bf16x8*)(K_lds + (b) * SH::K + KSWZ(krow[q_], kcol[q_] * 2)) = sr_[i].ks[q_]; } while (0)
#define SWAIT() do { if constexpr (SDEPTH == 1) asm volatile("s_waitcnt vmcnt(0)" ::: "memory"); else if constexpr (NLD == 4) asm volatile("s_waitcnt vmcnt(4)" ::: "memory"); else asm volatile("s_waitcnt vmcnt(5)" ::: "memory"); } while (0)
#define RESC(a) do { if (__any((a) < 1.f)) { if (hi == 0) al_l[r32] = (a); asm volatile("s_waitcnt lgkmcnt(0)" ::: "memory"); \
    _Pragma("unroll") for (int d = 0; d < 4; ++d) _Pragma("unroll") for (int r = 0; r < 16; ++r) o[d][r] *= al_l[crow(r, hi)]; } } while (0)
#define QKT(P0, P1, Kbuf) do { P0 = f32x16{}; P1 = f32x16{}; _Pragma("unroll") for (int d0 = 0; d0 < ND; ++d0) { const int cb = (d0 * 16 + hi * 8) * 2; \
    const bf16x8 b0 = *reinterpret_cast<const bf16x8*>((Kbuf) + KSWZ(r32, cb)); const bf16x8 b1 = *reinterpret_cast<const bf16x8*>((Kbuf) + KSWZ(32 + r32, cb)); \
    P0 = __builtin_amdgcn_mfma_f32_32x32x16_bf16(b0, qr[d0], P0, 0, 0, 0); P1 = __builtin_amdgcn_mfma_f32_32x32x16_bf16(b1, qr[d0], P1, 0, 0, 0); } } while (0)
  const int qb4 = n0 >> 6;
  const float nlane = (float)(n0 + wid * QBLK + r32 - 4 * hi);
#define TKIND(tj) ((tj) < 4 ? 3 : ((tj) - 4 < qb4 ? 0 : ((tj) - 4 >= qb4 + 4 ? 1 : 2)))
#define PART(P0, P1, tj, MN, AL) do { if constexpr (MODE == 0) partialSM<DQK>(P0, P1, m_reg, MN, AL); else ret_weights(P0, P1, TKIND(tj), nlane - (float)(64 * (tj) - 256), lf2, lb2); } while (0)
#define FIN(P0, P1, AL) do { if constexpr (MODE == 0) finishSM(P0, P1, AL, l_reg, pa0, pa1, pa2, pa3); else pack_p(P0, P1, pa0, pa1, pa2, pa3); } while (0)
  f32x16 pA0, pA1, pB0, pB1; float mnA = 0.f, mnB = 0.f, alA = 1.f, alB = 1.f; bf16x8 pa0, pa1, pa2, pa3; const int NT = seq / KVBLK;
  if constexpr (SDEPTH == 0) {
    SLOAD(0, 0); asm volatile("s_waitcnt vmcnt(0)" ::: "memory"); SWRITE(0, 0); __syncthreads();
#pragma unroll 1
    for (int j = 0; j < NT; ++j) {
      const int bsel = j & 1;
      if (j + 1 < NT) SLOAD(0, (j + 1) * KVBLK);
      SBAR(); QKT(pA0, pA1, K_lds + bsel * SH::K);
      PART(pA0, pA1, j, mnA, alA);
      if constexpr (MODE == 0) RESC(alA);
      FIN(pA0, pA1, alA); SBAR();
      pv_d0(o, vb0 + bsel * SH::V, pa0, pa1, pa2, pa3);
      if (j + 1 < NT) { asm volatile("s_waitcnt vmcnt(0)" ::: "memory"); SWRITE(bsel ^ 1, 0); }
      __syncthreads();
    }
  } else {
    SLOAD(SE, 0); asm volatile("s_waitcnt vmcnt(0)" ::: "memory"); SWRITE(0, SE); __syncthreads();
    QKT(pA0, pA1, K_lds); PART(pA0, pA1, 0, mnA, alA);
    SLOAD(SO, KVBLK); if constexpr (SDEPTH == 2) { if (2 < NT) SLOAD(SE, 2 * KVBLK); }
    SWAIT(); SWRITE(1, SO); __syncthreads();
#pragma unroll 1
    for (int j = 1; j + 1 < NT; j += 2) {
      SBAR(); QKT(pB0, pB1, K_lds + SH::K);
      FIN(pA0, pA1, alA); SBAR();
      SLOAD(SO, (j + SDEPTH) * KVBLK); SBAR();
      pv_d0(o, vb0, pa0, pa1, pa2, pa3); PART(pB0, pB1, j, mnB, alB);
      __syncthreads(); SWAIT(); SWRITE(0, SE);
      if constexpr (MODE == 0) RESC(alB);
      __syncthreads();
      SBAR(); QKT(pA0, pA1, K_lds);
      FIN(pB0, pB1, alB); SBAR();
      if (SDEPTH == 1 || j + 3 < NT) SLOAD(SE, (j + 1 + SDEPTH) * KVBLK); SBAR();
      pv_d0(o, vb0 + SH::V, pa0, pa1, pa2, pa3); PART(pA0, pA1, j + 1, mnA, alA);
      __syncthreads(); SWAIT(); SWRITE(1, SO);
      if constexpr (MODE == 0) RESC(alA);
      __syncthreads();
    }
    SBAR(); QKT(pB0, pB1, K_lds + SH::K);
    FIN(pA0, pA1, alA); SBAR();
    pv_d0(o, vb0, pa0, pa1, pa2, pa3); PART(pB0, pB1, NT - 1, mnB, alB);
    __syncthreads();
    if constexpr (MODE == 0) RESC(alB);
    FIN(pB0, pB1, alB); SBAR();
    pv_d0(o, vb0 + SH::V, pa0, pa1, pa2, pa3);
  }
  bf16_t* Ow = Ob + (long)(wid * QBLK) * ldo;
  if constexpr (MODE == 0) {
    if (hi == 0) li_l[r32] = l_reg; asm volatile("s_waitcnt lgkmcnt(0)" ::: "memory");
    float rli[16];
#pragma unroll
    for (int r = 0; r < 16; ++r) rli[r] = __builtin_amdgcn_rcpf(li_l[crow(r, hi)]);
    __syncthreads();
    bf16_t* stg = (bf16_t*)(lds + wid * 8192);
#pragma unroll
    for (int r = 0; r < 16; ++r) { const int orow = crow(r, hi);
#pragma unroll
      for (int d0 = 0; d0 < 4; ++d0) stg[orow * 128 + d0 * 32 + r32] = f2bf(o[d0][r] * rli[r]); }
    asm volatile("s_waitcnt lgkmcnt(0)" ::: "memory");
#pragma unroll
    for (int i = 0; i < 8; ++i) { const int row = i * 4 + (lane >> 4), ch = lane & 15; const u32x4 v = *(const u32x4*)(stg + row * 128 + ch * 8); *(u32x4*)(Ow + (long)row * ldo + ch * 8) = v; }
  } else {
    const bf16_t* Gw = Gb + (long)(wid * QBLK) * ldg;
#pragma unroll
    for (int r = 0; r < 16; ++r) {
      float ss = (o[0][r] * o[0][r] + o[1][r] * o[1][r]) + (o[2][r] * o[2][r] + o[3][r] * o[3][r]);
#pragma unroll
      for (int off = 1; off < 32; off <<= 1) ss += __shfl_xor(ss, off);
      const float rs = rsqrtf(ss * (1.f / 128.f) + EPS_N); const int orow = crow(r, hi);
#pragma unroll
      for (int d0 = 0; d0 < 4; ++d0) { const float g = bf1(Gw[(long)orow * ldg + d0 * 32 + r32]); Ow[(long)orow * ldo + d0 * 32 + r32] = f2bf(o[d0][r] * rs * silu_t(g)); }
      SBAR();
    }
  }
  __syncthreads();
#undef KSWZ
#undef SLOAD
#undef SWRITE
#undef SWAIT
#undef RESC
#undef QKT
#undef TKIND
#undef PART
#undef FIN
}

__device__ __forceinline__ void ret_state_unit(const bf16_t* __restrict__ Kh, const bf16_t* __restrict__ Vh, bf16_t* ST  , int dir, int hf  , float l2, char* lds) {
  int tid_ = threadIdx.x; asm volatile("" : "+v"(tid_));
  const int tid = tid_, wid = tid >> 6, lane = tid & 63, r32 = lane & 31, hi = lane >> 5, d0k = wid & 3, dvp = wid >> 2;
  constexpr int SHV = KVBLK * 128 * 2; char* K_lds = lds; char* V_lds = lds + 2 * SHV;
  const int sr = tid >> 4, sc = (tid & 15) * 8, vst0 = v_st(sr, sc), vst1 = v_st(32 + sr, sc);
  const float w0 = dir ? __builtin_amdgcn_exp2f(l2 * (float)sr) : __builtin_amdgcn_exp2f(l2 * (float)(63 - sr)), w1 = dir ? __builtin_amdgcn_exp2f(l2 * (float)(32 + sr)) : __builtin_amdgcn_exp2f(l2 * (float)(31 - sr));
  const float dec64 = __builtin_amdgcn_exp2f(64.f * l2);
  const int kb = (int)(uintptr_t)K_lds + v_rd_base(lane) + d0k * 512, vb = (int)(uintptr_t)V_lds + v_rd_base(lane) + (2 * hf + dvp) * 512;
  f32x16 o0 = {}, o1 = {};
  bf16x8 ks0, ks1, vs0, vs1;
#define RS_TILE(s) (dir ? ((s) < 4 ? 3 - (s) : 39 - (s)) : (s))
#define RS_LOAD(s) do { const long k0 = 64L * RS_TILE(s); ks0 = *reinterpret_cast<const bf16x8*>(&Kh[(k0 + sr) * 512 + sc]); ks1 = *reinterpret_cast<const bf16x8*>(&Kh[(k0 + 32 + sr) * 512 + sc]); \
    vs0 = *reinterpret_cast<const bf16x8*>(&Vh[(k0 + sr) * 512 + sc]); vs1 = *reinterpret_cast<const bf16x8*>(&Vh[(k0 + 32 + sr) * 512 + sc]); } while (0)
#define RS_SCALE(VV, SCL) do { const u32x4 u_ = __builtin_bit_cast(u32x4, VV); u32x4 r_; r_[0] = pk2(bflo(u_[0]) * (SCL), bfhi(u_[0]) * (SCL)); r_[1] = pk2(bflo(u_[1]) * (SCL), bfhi(u_[1]) * (SCL)); \
    r_[2] = pk2(bflo(u_[2]) * (SCL), bfhi(u_[2]) * (SCL)); r_[3] = pk2(bflo(u_[3]) * (SCL), bfhi(u_[3]) * (SCL)); VV = __builtin_bit_cast(bf16x8, r_); } while (0)
#define RS_WRITE(b) do { *(bf16x8*)(K_lds + (b) * SHV + vst0) = ks0; *(bf16x8*)(K_lds + (b) * SHV + vst1) = ks1; RS_SCALE(vs0, w0); RS_SCALE(vs1, w1); \
    *(bf16x8*)(V_lds + (b) * SHV + vst0) = vs0; *(bf16x8*)(V_lds + (b) * SHV + vst1) = vs1; } while (0)
  RS_LOAD(0); asm volatile("s_waitcnt vmcnt(0)" ::: "memory"); RS_WRITE(0); __syncthreads();
#pragma unroll 1
  for (int s = 0; s < 36; ++s) {
    const int bsel = s & 1;
    if (s + 1 < 36) RS_LOAD(s + 1);
    SBAR();
    if (s >= 4 && ((s - 4) & 3) == 0) {
      const int uq = dir ? 7 - ((s - 4) >> 2) : ((s - 4) >> 2); bf16_t* dst = ST + (size_t)uq * 16384 + (size_t)(32 * d0k) * 128 + 32 * (2 * hf + dvp) + r32;
#pragma unroll
      for (int r = 0; r < 16; ++r) { const int row = crow(r, hi); dst[row * 128] = f2bf(o0[r] + o1[r]); }
    }
#pragma unroll
    for (int r = 0; r < 16; ++r) { o0[r] *= dec64; o1[r] *= dec64; }
    const int kbb = kb + bsel * SHV, vbb = vb + bsel * SHV;
#define RS_RD(KS) const s16x4 al##KS = tr_read<(KS) * 4096>(kbb), ah##KS = tr_read<(KS) * 4096 + 2048>(kbb), bl##KS = tr_read<(KS) * 4096>(vbb), bh##KS = tr_read<(KS) * 4096 + 2048>(vbb)
    RS_RD(0); RS_RD(1); RS_RD(2); RS_RD(3);
#undef RS_RD
    asm volatile("s_waitcnt lgkmcnt(0)" ::: "memory"); SBAR();
#define RS_MM(KS, ACC) ACC = __builtin_amdgcn_mfma_f32_32x32x16_bf16((bf16x8){al##KS[0], al##KS[1], al##KS[2], al##KS[3], ah##KS[0], ah##KS[1], ah##KS[2], ah##KS[3]}, \
      (bf16x8){bl##KS[0], bl##KS[1], bl##KS[2], bl##KS[3], bh##KS[0], bh##KS[1], bh##KS[2], bh##KS[3]}, ACC, 0, 0, 0)
    RS_MM(0, o0); RS_MM(1, o1); RS_MM(2, o0); RS_MM(3, o1);
#undef RS_MM
    if (s + 1 < 36) {
      if (s >= 4 && ((s - 4) & 3) == 0) asm volatile("s_waitcnt vmcnt(16)" ::: "memory"); else asm volatile("s_waitcnt vmcnt(0)" ::: "memory");
      RS_WRITE(bsel ^ 1); }
    __syncthreads();
  }
#undef RS_TILE
#undef RS_LOAD
#undef RS_SCALE
#undef RS_WRITE
}

__device__ __forceinline__ void ret_out_unit(bf16_t* Qb  , const bf16_t* __restrict__ Kh, const bf16_t* __restrict__ Vh, const bf16_t* __restrict__ Sf, const bf16_t* __restrict__ Sb,
                                             const bf16_t* Gb, float lf2, float lb2, char* lds) {
  using SH = Shm<128>;
  int tid_ = threadIdx.x; asm volatile("" : "+v"(tid_));
  const int tid = tid_, wid = tid >> 6, lane = tid & 63, r32 = lane & 31, hi = lane >> 5;
  char* V_lds = lds; char* K_lds = lds + 2 * SH::V;
  f32x16 o[4] = {}; bf16x8 qr[8];
  const bf16_t* Qw = Qb + (long)(wid * QBLK + r32) * 1024 + hi * 8;
#pragma unroll
  for (int d0 = 0; d0 < 8; ++d0) qr[d0] = *reinterpret_cast<const bf16x8*>(Qw + d0 * 16);
  const int sr = tid >> 4, sc = (tid & 15) * 8, vst0 = v_st(sr, sc), vst1 = v_st(32 + sr, sc);
  const int vb0 = (int)(uintptr_t)V_lds + v_rd_base(lane);
  const float nrel = (float)(wid * QBLK + r32), nlane = nrel - 4.f * (float)hi;
  const float ff = __builtin_amdgcn_exp2f(lf2 * (nrel + 1.f)), fb = __builtin_amdgcn_exp2f(lb2 * (256.f - nrel));
  bf16x8 vs0, vs1, ks0, ks1;
#define KSWZ(row, colB) ((row) * 256 + ((colB) ^ (((row) & 7) << 4)))
#define RO_LOAD(j) do { if ((j) < 4) { const long k0 = 64L * (j); vs0 = *reinterpret_cast<const bf16x8*>(&Vh[(k0 + sr) * 512 + sc]); vs1 = *reinterpret_cast<const bf16x8*>(&Vh[(k0 + 32 + sr) * 512 + sc]); \
      ks0 = *reinterpret_cast<const bf16x8*>(&Kh[(k0 + sr) * 512 + sc]); ks1 = *reinterpret_cast<const bf16x8*>(&Kh[(k0 + 32 + sr) * 512 + sc]); } \
    else { const bf16_t* S_ = ((j) < 6 ? Sf : Sb) + (size_t)(((j) & 1) * 64) * 128; vs0 = *reinterpret_cast<const bf16x8*>(&S_[sr * 128 + sc]); vs1 = *reinterpret_cast<const bf16x8*>(&S_[(32 + sr) * 128 + sc]); } } while (0)
#define RO_WRITE(b, j) do { *(bf16x8*)(V_lds + (b) * SH::V + vst0) = vs0; *(bf16x8*)(V_lds + (b) * SH::V + vst1) = vs1; \
    if ((j) < 4) { *(bf16x8*)(K_lds + (b) * SH::K + KSWZ(sr, sc * 2)) = ks0; *(bf16x8*)(K_lds + (b) * SH::K + KSWZ(32 + sr, sc * 2)) = ks1; } } while (0)
#define RO_SCALE(QQ, SCL) ({ const u32x4 u_ = __builtin_bit_cast(u32x4, QQ); u32x4 r_; r_[0] = pk2(bflo(u_[0]) * (SCL), bfhi(u_[0]) * (SCL)); r_[1] = pk2(bflo(u_[1]) * (SCL), bfhi(u_[1]) * (SCL)); \
    r_[2] = pk2(bflo(u_[2]) * (SCL), bfhi(u_[2]) * (SCL)); r_[3] = pk2(bflo(u_[3]) * (SCL), bfhi(u_[3]) * (SCL)); __builtin_bit_cast(bf16x8, r_); })
  RO_LOAD(0); asm volatile("s_waitcnt vmcnt(0)" ::: "memory"); RO_WRITE(0, 0); __syncthreads();
#pragma unroll 1
  for (int j = 0; j < 8; ++j) {
    const int bsel = j & 1; bf16x8 pa0, pa1, pa2, pa3;
    if (j + 1 < 8) RO_LOAD(j + 1);
    if (j < 4) {
      f32x16 p0 = {}, p1 = {}; const char* Kbuf = K_lds + bsel * SH::K;
#pragma unroll
      for (int d0 = 0; d0 < 8; ++d0) { const int cb = (d0 * 16 + hi * 8) * 2;
        const bf16x8 b0 = *reinterpret_cast<const bf16x8*>(Kbuf + KSWZ(r32, cb)); const bf16x8 b1 = *reinterpret_cast<const bf16x8*>(Kbuf + KSWZ(32 + r32, cb));
        p0 = __builtin_amdgcn_mfma_f32_32x32x16_bf16(b0, qr[d0], p0, 0, 0, 0); p1 = __builtin_amdgcn_mfma_f32_32x32x16_bf16(b1, qr[d0], p1, 0, 0, 0); }
      ret_weights(p0, p1, 2, nlane - (float)(64 * j), lf2, lb2);
      pack_p(p0, p1, pa0, pa1, pa2, pa3);
    } else {
      const float w = j < 6 ? ff : fb; const bool od = (j & 1) != 0;
      if (od) { pa0 = RO_SCALE(qr[4], w); pa1 = RO_SCALE(qr[5], w); pa2 = RO_SCALE(qr[6], w); pa3 = RO_SCALE(qr[7], w); }
      else { pa0 = RO_SCALE(qr[0], w); pa1 = RO_SCALE(qr[1], w); pa2 = RO_SCALE(qr[2], w); pa3 = RO_SCALE(qr[3], w); }
    }
    SBAR();
    pv_d0(o, vb0 + bsel * SH::V, pa0, pa1, pa2, pa3);
    if (j + 1 < 8) { asm volatile("s_waitcnt vmcnt(0)" ::: "memory"); RO_WRITE(bsel ^ 1, j + 1); }
    __syncthreads();
  }
  bf16_t* Ow = Qb + (long)(wid * QBLK) * 1024; const bf16_t* Gw = Gb + (long)(wid * QBLK) * 512;
#pragma unroll
  for (int r = 0; r < 16; ++r) {
    float ss = (o[0][r] * o[0][r] + o[1][r] * o[1][r]) + (o[2][r] * o[2][r] + o[3][r] * o[3][r]);
#pragma unroll
    for (int off = 1; off < 32; off <<= 1) ss += __shfl_xor(ss, off);
    const float rs = rsqrtf(ss * (1.f / 128.f) + EPS_N); const int orow = crow(r, hi);
#pragma unroll
    for (int d0 = 0; d0 < 4; ++d0) { const float g = bf1(Gw[(long)orow * 512 + d0 * 32 + r32]); Ow[(long)orow * 1024 + d0 * 32 + r32] = f2bf(o[d0][r] * rs * silu_t(g)); }
    SBAR();
  }
  __syncthreads();
#undef KSWZ
#undef RO_LOAD
#undef RO_WRITE
#undef RO_SCALE
}
#undef SBAR
}
constexpr int NWAVES = 8;
constexpr int RING_BYTES = 131072, SCR_OFF = RING_BYTES, MISC_OFF = SCR_OFF + 8192, LDS_BYTES = 147456;

__device__ __forceinline__ void s5_chunk_scan(unsigned char* ws, int g, int b, int dir, int p) {
  const bf16_t* E = (const bf16_t*)(ws + WS_XN) + ((size_t)g * 2304 + (size_t)b * 144) * 256 + dir * 128 + 2 * p;
  bf16_t* A5 = (bf16_t*)(ws + R_A5) + ((size_t)g * 2304 + (size_t)b * 144) * 512 + 256 + dir * 128 + 2 * p;
  const float* LAM = (const float*)(ws + WS_S5LAM) + ((size_t)(dir * 32 + g) * 64 + p) * 2; const float lr = LAM[0], li = LAM[1];
  float sr = 0.f, si = 0.f;
#define S5_CH(sig) (dir ? ((sig) < 16 ? 15 - (sig) : 159 - (sig)) : (sig))
#define S5_LOAD(dst, s0) do { _Pragma("unroll") for (int q = 0; q < 16; ++q) dst[q] = *(const unsigned*)(E + (size_t)S5_CH((s0) + q) * 256); } while (0)
#define S5_STEP(src, s0) do { _Pragma("unroll") for (int q = 0; q < 16; ++q) { *(unsigned*)(A5 + (size_t)S5_CH((s0) + q) * 512) = pk2(sr, si); \
      const float nr = lr * sr - li * si + bflo(src[q]), ni = lr * si + li * sr + bfhi(src[q]); sr = nr; si = ni; } } while (0)
  unsigned ea[16], eb[16];
  S5_LOAD(ea, 0);
#pragma unroll 1
  for (int s0 = 0; s0 < 128; s0 += 32) { S5_LOAD(eb, s0 + 16); S5_STEP(ea, s0); S5_LOAD(ea, s0 + 32); S5_STEP(eb, s0 + 16); }
  S5_STEP(ea, 128);
#undef S5_LOAD
#undef S5_STEP
#undef S5_CH
}

#define XB_TMO      128
#define XB_XCNT(j)  (256  + 64 * (j))
#define XB_XSUB(j)  (1280 + 64 * (j))
#define XB_XGEN(j)  (2304 + 64 * (j))
#define XB_TOP      3328
#define XB_TOPGEN   3392
#define XB_SPIN_CAP (1u << 22)
__device__ __forceinline__ unsigned xb_ld(unsigned* p)              { return __hip_atomic_load(p, __ATOMIC_RELAXED, __HIP_MEMORY_SCOPE_AGENT); }
__device__ __forceinline__ unsigned xb_add(unsigned* p, unsigned v) { return __hip_atomic_fetch_add(p, v, __ATOMIC_RELAXED, __HIP_MEMORY_SCOPE_AGENT); }
__device__ __forceinline__ unsigned xb_xcc_id() { return (unsigned)__builtin_amdgcn_s_getreg((3 << 11) | 20) & 0xFu; }
#define XB_SPIN(cond, bar) do { unsigned _sp = 0; while (cond) { __builtin_amdgcn_s_sleep(1); \
    if ((++_sp & 255u) == 0u) { if (xb_ld(&(bar)[XB_TMO])) break; if (_sp > XB_SPIN_CAP) { atomicAdd(&(bar)[XB_TMO], 1u); break; } } } } while (0)
struct XcdBarrier { unsigned* bar; unsigned x; volatile LAS unsigned* st; };
__device__ __forceinline__ XcdBarrier xcd_barrier_post(unsigned* bar, volatile LAS unsigned* st) {
    XcdBarrier b; b.bar = bar; b.x = xb_xcc_id(); b.st = st;
    if (threadIdx.x == 0) (void)xb_add(&bar[XB_XCNT(b.x)], 1u);
    return b;
}
__device__ __forceinline__ void xcd_barrier_complete(unsigned* bar, unsigned x, unsigned& nloc, unsigned& nx) {
    const unsigned G = gridDim.x * gridDim.y * gridDim.z;
    unsigned sum, cnt, mine, sp = 0u;
    for (;;) {
        sum = 0u; cnt = 0u; mine = 0u;
#pragma unroll
        for (unsigned j = 0; j < 16; ++j) { const unsigned c = xb_ld(&bar[XB_XCNT(j)]); sum += c; cnt += (c > 0u) ? 1u : 0u; mine = (j == x) ? c : mine; }
        if (sum == G) break;
        __builtin_amdgcn_s_sleep(1);
        if ((++sp & 255u) == 0u) { if (xb_ld(&bar[XB_TMO])) break; if (sp > XB_SPIN_CAP) { atomicAdd(&bar[XB_TMO], 1u); break; } }
    }
    nloc = mine > 0u ? mine : 1u; nx = cnt > 0u ? cnt : 1u;
}
__device__ __forceinline__ void xcd_barrier(const XcdBarrier& b) {
    asm volatile("s_waitcnt vmcnt(0)" ::: "memory");
    __syncthreads();
    if (threadIdx.x == 0) {
        unsigned* bar = b.bar;
        __builtin_amdgcn_s_waitcnt(0);
        unsigned nloc = b.st[0], nx = b.st[1];
        if (nloc == 0u) { xcd_barrier_complete(bar, b.x, nloc, nx); b.st[0] = nloc; b.st[1] = nx; }
        const unsigned old = xb_add(&bar[XB_XSUB(b.x)], 1u);
        const unsigned gen = old / nloc;
        if (old + 1u == (gen + 1u) * nloc) {
            __builtin_amdgcn_fence(__ATOMIC_RELEASE, "agent");
            asm volatile("s_waitcnt vmcnt(0)" ::: "memory");
            const unsigned og = xb_add(&bar[XB_TOP], 1u);
            const unsigned tg = og / nx;
            if (og + 1u == (tg + 1u) * nx) xb_add(&bar[XB_TOPGEN], 1u);
            else XB_SPIN(xb_ld(&bar[XB_TOPGEN]) == tg, bar);
            __builtin_amdgcn_fence(__ATOMIC_ACQUIRE, "agent");
            xb_add(&bar[XB_XGEN(b.x)], 1u);
            asm volatile("s_waitcnt vmcnt(0)" ::: "memory");
        } else {
            XB_SPIN(xb_ld(&bar[XB_XGEN(b.x)]) == gen, bar);
            __builtin_amdgcn_fence(__ATOMIC_ACQUIRE, "agent");
            asm volatile("s_waitcnt vmcnt(0)" ::: "memory");
        }
    }
    __syncthreads();
}

__device__ __forceinline__ void xcd_arrive(const XcdBarrier& b) {
    asm volatile("s_waitcnt vmcnt(0)" ::: "memory");
    __syncthreads();
    if (threadIdx.x == 0) {
        unsigned* bar = b.bar;
        unsigned nloc = b.st[0], nx = b.st[1];
        if (nloc == 0u) { xcd_barrier_complete(bar, b.x, nloc, nx); b.st[0] = nloc; b.st[1] = nx; }
        const unsigned old = xb_add(&bar[XB_XSUB(b.x)], 1u);
        const unsigned gen = old / nloc; b.st[2] = gen;
        if (old + 1u == (gen + 1u) * nloc) {
            __builtin_amdgcn_fence(__ATOMIC_RELEASE, "agent");
            asm volatile("s_waitcnt vmcnt(0)" ::: "memory");
            const unsigned og = xb_add(&bar[XB_TOP], 1u);
            const unsigned tg = og / nx;
            if (og + 1u == (tg + 1u) * nx) xb_add(&bar[XB_TOPGEN], 1u);
            xb_add(&bar[XB_XGEN(b.x)], 1u);
        }
    }
}
__device__ __forceinline__ void xcd_wait(const XcdBarrier& b) {
    if (threadIdx.x == 0) { const unsigned gen = b.st[2]; XB_SPIN(xb_ld(&b.bar[XB_TOPGEN]) == gen, b.bar); __builtin_amdgcn_fence(__ATOMIC_ACQUIRE, "agent"); asm volatile("s_waitcnt vmcnt(0)" ::: "memory"); }
    __syncthreads();
}

__device__ __forceinline__ int wt_src(int map, int n, int Nsrc) {
  if (map == 1) { const bool roped = (n < 1024) || (n >= 2048 && n < 2816); if (!roped) return n; const int hb = n & ~127, dp = n & 127; return hb + (dp & 64) + ((dp & 1) ? 32 : 0) + ((dp & 63) >> 1); }
  if (map == 2) { const int pn = n >> 8, bj = (n >> 7) & 1, jj = n & 127; return bj * FFH + 128 * pn + jj; }
  return n < Nsrc ? n : -1;
}
__device__ __forceinline__ void wt_item(const float* W, int K, int Nsrc, int Ndst, bf16_t* WT, int map, const float* kscale, LAS float* scr, int item, int lane) {
  const int nblk = Ndst / 32, kb = item / nblk, nb = item % nblk, k0 = 64 * kb, n0 = 32 * nb;
  const int src = wt_src(map, n0 + (lane & 31), Nsrc);
  float wv[32];
  const float* Wp = W + (size_t)(k0 + (lane >> 5)) * Nsrc + (src >= 0 ? src : 0);
#pragma unroll
  for (int i = 0; i < 32; ++i) wv[i] = Wp[(size_t)(2 * i) * Nsrc];
#pragma unroll
  for (int i = 0; i < 32; ++i) { const int kk = 2 * i + (lane >> 5); float v = src >= 0 ? wv[i] : 0.f; if (kscale) v *= kscale[k0 + kk]; scr[kk * 33 + (lane & 31)] = v; }
  asm volatile("s_waitcnt lgkmcnt(0)" ::: "memory");
  const int c = lane & 7;
#pragma unroll
  for (int j = 0; j < 4; ++j) { const int n = (lane >> 3) + 8 * j; const LAS float* s = scr + (8 * c) * 33 + n;
    u32x4 o; o.x = pk2(s[0 * 33], s[1 * 33]); o.y = pk2(s[2 * 33], s[3 * 33]); o.z = pk2(s[4 * 33], s[5 * 33]); o.w = pk2(s[6 * 33], s[7 * 33]);
    *(u32x4*)(WT + (size_t)(n0 + n) * K + k0 + 8 * c) = o; }
  asm volatile("s_waitcnt lgkmcnt(0)" ::: "memory");
}
__device__ __forceinline__ const float* hrow_ptr(const float* hc, const float* hl, int row) { const int b = row / RB, pos = row - b * RB; return pos < NCTX ? hc + ((size_t)b * NCTX + pos) * DMODEL : hl + ((size_t)b * NLAT + pos - NCTX) * DMODEL; }

__device__ __forceinline__ void fixup_tile(unsigned char* ws, const float* cw, int pm, int l, int tid) {
  bf16_t* HH = (bf16_t*)(ws + R_HH); const float* EP = (const float*)(ws + WS_EDGE); const float* EG = EP + EDGE_ARR / 4; const float* EA = EG + EDGE_ARR / 4;
#pragma unroll 11
  for (int it = 0; it < 22; ++it) { const int idx = tid + it * (NWAVES * 64); const int e4 = idx / FFH, j = idx - e4 * FFH, blk = 2 * pm + (e4 >> 1), e = e4 & 1, bi = blk % 18; const size_t i = ((size_t)blk * 2 + e) * FFH + j;
    if (l == 1 && bi < 2) continue;
    float cv = EP[i];
    if (e == 0) { if (!(bi == 0 || bi == 2)) cv += cw[j] * EA[((size_t)(blk - 1) * 2 + 1) * FFH + j]; }
    else { if (!(bi == 1 || bi == 17)) cv += cw[2 * FFH + j] * EA[((size_t)(blk + 1) * 2 + 0) * FFH + j]; }
    HH[((size_t)(j >> 5) * TT + (size_t)blk * 128 + (e ? 127 : 0)) * 32 + (j & 31)] = f2bf(gelu_t(cv) * EG[i]); }
}
struct NormPair { f32x4 v0[4], v1[4]; int row; const float* md; };
__device__ __forceinline__ void norm_pair_load(NormPair& P, unsigned char* ws, const float* x, const float* ctx, bool first, int l, int which, int sel, int k, int lane) {
  const float* MODS = (const float*)(ws + WS_MODS); const bf16_t* HB = (const bf16_t*)(ws + WS_HB);
  const int i = 2 * k;
  int b, pos; if (sel == 0) { b = i / RB; pos = i - b * RB; } else if (sel == 1) { b = i >> 11; pos = NCTX + (i & 2047); } else { b = i >> 8; pos = i & 255; }
  const int row = b * RB + pos; P.row = row;
  P.md = MODS + ((size_t)l * 17 + (pos < NCTX ? 16 : b)) * 6144 + which * 3 * 1024;
  if (first) { const float* hr = hrow_ptr(ctx, x, row);
#pragma unroll
    for (int j = 0; j < 4; ++j) { P.v0[j] = *(const f32x4*)(hr + lane * 4 + 256 * j); P.v1[j] = *(const f32x4*)(hr + DMODEL + lane * 4 + 256 * j); } }
  else { const bf16_t* hr = HB + (size_t)row * 1024;
#pragma unroll
    for (int j = 0; j < 4; ++j) { const u32x2 w = *(const u32x2*)(hr + lane * 4 + 256 * j), w2 = *(const u32x2*)(hr + 1024 + lane * 4 + 256 * j);
      P.v0[j] = (f32x4){bflo(w.x), bfhi(w.x), bflo(w.y), bfhi(w.y)}; P.v1[j] = (f32x4){bflo(w2.x), bfhi(w2.x), bflo(w2.y), bfhi(w2.y)}; } }
}
__device__ __forceinline__ void norm_pair_store(const NormPair& P, f32x4 (&sh)[4], f32x4 (&g)[4], const float*& md_cur, unsigned char* ws, int lane) {
  bf16_t* XN = (bf16_t*)(ws + WS_XN);
  if (P.md != md_cur) {
    md_cur = P.md;
#pragma unroll
    for (int j = 0; j < 4; ++j) { sh[j] = *(const f32x4*)(P.md + lane * 4 + 256 * j); g[j] = *(const f32x4*)(P.md + 1024 + lane * 4 + 256 * j) + 1.f; } }
  float ss0 = 0.f, ss1 = 0.f;
#pragma unroll
  for (int j = 0; j < 4; ++j) { ss0 += (P.v0[j][0] * P.v0[j][0] + P.v0[j][1] * P.v0[j][1]) + (P.v0[j][2] * P.v0[j][2] + P.v0[j][3] * P.v0[j][3]); ss1 += (P.v1[j][0] * P.v1[j][0] + P.v1[j][1] * P.v1[j][1]) + (P.v1[j][2] * P.v1[j][2] + P.v1[j][3] * P.v1[j][3]); }
  const float rs0 = rsqrtf(wave_sum64(ss0) * (1.f / 1024.f) + EPS_N), rs1 = rsqrtf(wave_sum64(ss1) * (1.f / 1024.f) + EPS_N);
#pragma unroll
  for (int j = 0; j < 4; ++j) {
    const f32x4 o0 = P.v0[j] * rs0 * g[j] + sh[j], o1 = P.v1[j] * rs1 * g[j] + sh[j]; u32x2 w, w2; w.x = pk2(o0[0], o0[1]); w.y = pk2(o0[2], o0[3]); w2.x = pk2(o1[0], o1[1]); w2.y = pk2(o1[2], o1[3]);
    *(u32x2*)(XN + (size_t)P.row * 1024 + lane * 4 + 256 * j) = w; *(u32x2*)(XN + (size_t)(P.row + 1) * 1024 + lane * 4 + 256 * j) = w2; }
}
__device__ __forceinline__ void norm_rows(unsigned char* ws, const float* x, const float* ctx, bool first, int l, int which, int sel, int w0, int wstride, int lane) {
  const int ppb = (sel == 0 ? RB : sel == 1 ? NLAT : NCTX) >> 1, wpb = wstride >> 4, b = w0 / wpb, wi = w0 - b * wpb, kb = b * ppb, n = (ppb - wi + wpb - 1) / wpb;
  if (b >= 16 || n <= 0) return;
  f32x4 sh[4], g[4]; const float* md_cur = nullptr;
  NormPair A, B; norm_pair_load(A, ws, x, ctx, first, l, which, sel, kb + wi, lane);
  for (int j = 0; j < n; j += 2) {
    if (j + 1 < n) norm_pair_load(B, ws, x, ctx, first, l, which, sel, kb + wi + wpb * (j + 1), lane);
    norm_pair_store(A, sh, g, md_cur, ws, lane);
    if (j + 1 >= n) break;
    if (j + 2 < n) norm_pair_load(A, ws, x, ctx, first, l, which, sel, kb + wi + wpb * (j + 2), lane);
    norm_pair_store(B, sh, g, md_cur, ws, lane);
  }
}
struct SchedCtx { int c; __device__ __forceinline__ bool next(int i, pg8::Unit& u) const { if (i > 0) return false; u.pm = 9 * (c >> 2); u.pn = c & 3; return true; } };
template <int ph> __device__ __forceinline__ void run_phase(const MArgs& a, unsigned char* lds, int tid, int lane, int wave, int G, int bx, int vcu) {
  LAS unsigned char* L = (LAS unsigned char*)lds; unsigned char* ws = a.ws;
  const float* x = a.in[0]; const float* ctx = a.in[2];
  float* MODS = (float*)(ws + WS_MODS); const bf16_t* HB = (const bf16_t*)(ws + WS_HB);
  const int gw = vcu * NWAVES + wave, NGW = G * NWAVES;
  if (ph == 0) {
    if (bx < 192) {
      LAS float* cond = (LAS float*)L; LAS float* red = (LAS float*)(L + 17 * 1024 * 4);
      for (int i = tid; i < 17 * 1024; i += NWAVES * 64) { const int r = i >> 10, k = i & 1023; const float v = r < 16 ? a.in[1][r * 1024 + k] : a.in[3][k]; cond[i] = v / (1.f + __expf(-v)); }
      __syncthreads();
      const int l = bx / 96, cc = bx % 96; const float* W = a.in[4] + (size_t)l * 1024 * 6144 + cc * 64 + lane;
      float acc[17];
#pragma unroll
      for (int r = 0; r < 17; ++r) acc[r] = 0.f;
      for (int k0 = wave * 128; k0 < wave * 128 + 128; k0 += 16) { float wv[16];
#pragma unroll
        for (int q = 0; q < 16; ++q) wv[q] = W[(size_t)(k0 + q) * 6144];
#pragma unroll
        for (int q = 0; q < 16; ++q)
#pragma unroll
          for (int r = 0; r < 17; ++r) acc[r] += cond[r * 1024 + k0 + q] * wv[q]; }
#pragma unroll
      for (int r = 0; r < 17; ++r) red[(wave * 17 + r) * 64 + lane] = acc[r];
      __syncthreads();
      for (int i = tid; i < 17 * 64; i += NWAVES * 64) { const int r = i >> 6, c = i & 63; float s = a.in[5][l * 6144 + cc * 64 + c];
#pragma unroll
        for (int w = 0; w < 8; ++w) s += red[(w * 17 + r) * 64 + c];
        MODS[((size_t)l * 17 + r) * 6144 + cc * 64 + c] = s; }
      asm volatile("s_waitcnt vmcnt(0)" ::: "memory"); __syncthreads();
    }
    else if (bx < 224) {
      const int g = bx - 192;
      LAS float* POW = (LAS float*)L; LAS float* BBc = POW + 2 * 17 * 64 * 2; LAS float* CCc = BBc + 2 * 64 * 16 * 2; LAS float* KT = CCc + 2 * 16 * 64 * 2;
      if (tid < 128) { const int d = tid >> 6, p = tid & 63, i = (d * 32 + g) * 64 + p;
        const float lr = a.in[8][i], li = a.in[9][i], dt = expf(a.in[10][d * 32 + g]); const float ar = lr * dt, ai = li * dt;
        for (int k = 0; k <= 16; ++k) { const float mag = expf(ar * (float)k); float sv, cv; sincosf(ai * (float)k, &sv, &cv); POW[((d * 17 + k) * 64 + p) * 2] = mag * cv; POW[((d * 17 + k) * 64 + p) * 2 + 1] = mag * sv; }
        const float er = POW[((d * 17 + 1) * 64 + p) * 2], ei = POW[((d * 17 + 1) * 64 + p) * 2 + 1];
        const float den = lr * lr + li * li, cr = ((er - 1.f) * lr + ei * li) / den, ci = (ei * lr - (er - 1.f) * li) / den;
        for (int h = 0; h < 16; ++h) { const float br = a.in[11][(size_t)i * 16 + h], bi = a.in[12][(size_t)i * 16 + h];
          BBc[((d * 64 + p) * 16 + h) * 2] = cr * br - ci * bi; BBc[((d * 64 + p) * 16 + h) * 2 + 1] = cr * bi + ci * br;
          CCc[((d * 16 + h) * 64 + p) * 2] = a.in[13][((size_t)(d * 32 + g) * 16 + h) * 64 + p]; CCc[((d * 16 + h) * 64 + p) * 2 + 1] = a.in[14][((size_t)(d * 32 + g) * 16 + h) * 64 + p]; }
        float* LAM = (float*)(ws + WS_S5LAM); LAM[(size_t)i * 2] = POW[((d * 17 + 16) * 64 + p) * 2]; LAM[(size_t)i * 2 + 1] = POW[((d * 17 + 16) * 64 + p) * 2 + 1]; }
      __syncthreads();
      for (int e = tid; e < 2 * 16 * 256; e += NWAVES * 64) { const int d = e >> 12, k = (e >> 8) & 15, hp = (e >> 4) & 15, h = e & 15; float s = 0.f;
        for (int p = 0; p < 64; ++p) { const float cr = CCc[((d * 16 + hp) * 64 + p) * 2], ci = CCc[((d * 16 + hp) * 64 + p) * 2 + 1], pr = POW[((d * 17 + k) * 64 + p) * 2], pi = POW[((d * 17 + k) * 64 + p) * 2 + 1];
          const float xr = cr * pr - ci * pi, xi = cr * pi + ci * pr; s += xr * BBc[((d * 64 + p) * 16 + h) * 2] - xi * BBc[((d * 64 + p) * 16 + h) * 2 + 1]; }
        KT[e] = s; }
      __syncthreads();
      bf16_t* PB = (bf16_t*)(ws + WS_S5PB) + (size_t)g * 256 * 256;
      for (int e = tid; e < 256 * 256; e += NWAVES * 64) { const int n = e >> 8, col = e & 255, d = n >> 7, nn = n & 127, p = nn >> 1, ri = nn & 1, tau = col >> 4, h = col & 15, kp = d ? tau : 15 - tau;
        const float pr = POW[((d * 17 + kp) * 64 + p) * 2], pi = POW[((d * 17 + kp) * 64 + p) * 2 + 1], br = BBc[((d * 64 + p) * 16 + h) * 2], bi = BBc[((d * 64 + p) * 16 + h) * 2 + 1];
        PB[e] = f2bf(ri ? pr * bi + pi * br : pr * br - pi * bi); }
      bf16_t* MR = (bf16_t*)(ws + WS_S5MR) + (size_t)g * 256 * 512;
      for (int e = tid; e < 256 * 512; e += NWAVES * 64) { const int r = e >> 9, k = e & 511, t = r >> 4, hp = r & 15; float v;
        if (k < 256) { const int tau = k >> 4, h = k & 15; v = 0.f; if (tau <= t) v += KT[((0 * 16 + (t - tau)) * 16 + hp) * 16 + h]; if (tau >= t) v += KT[((1 * 16 + (tau - t)) * 16 + hp) * 16 + h];
          if (tau == t && h == hp) v += a.in[15][g * 16 + h]; }
        else { const int kk = k - 256, d = kk >> 7, nn = kk & 127, p = nn >> 1, ri = nn & 1, kp = d ? 16 - t : t + 1;
          const float pr = POW[((d * 17 + kp) * 64 + p) * 2], pi = POW[((d * 17 + kp) * 64 + p) * 2 + 1], cr = CCc[((d * 16 + hp) * 64 + p) * 2], ci = CCc[((d * 16 + hp) * 64 + p) * 2 + 1];
          v = ri ? -(cr * pi + ci * pr) : (cr * pr - ci * pi); }
        MR[e] = f2bf(v); }
      __syncthreads();
    }
    { XcdBarrier b2; b2.bar = (unsigned*)(ws + WS_CTL) + 4096; b2.x = xb_xcc_id(); b2.st = (volatile LAS unsigned*)(L + MISC_OFF) + 8; xcd_arrive(b2); }
    {
      LAS float* scr = (LAS float*)(L + wave * 16384);
      int base = 0;
#define WT_MAT(Wp, K_, Nsrc_, Ndst_, dst_, map_, ks_) do { const int ni = ((K_) / 64) * ((Ndst_) / 32); int it0 = gw - (base % NGW); if (it0 < 0) it0 += NGW; \
        for (int it = it0; it < ni; it += NGW) wt_item((Wp), (K_), (Nsrc_), (Ndst_), (bf16_t*)(ws + (dst_)), (map_), (ks_), scr, it, lane); base += ni; } while (0)
      WT_MAT(a.in[6], 1024, 1216, 1280, W_INAB, 0, (const float*)nullptr);
      WT_MAT(a.in[7], 1024, 1024, 1024, W_OUTAB, 0, (const float*)nullptr);
      WT_MAT(a.in[16], 512, 512, 512, W_GLU, 0, (const float*)nullptr);
      WT_MAT(a.in[19], 384, 768, 768, W_UQ, 0, a.in[18]);
      WT_MAT(a.in[21], 256, 1024, 1024, W_UKV, 0, a.in[20]);
      WT_MAT(a.in[27], 1024, 5632, 5632, W_UP, 2, (const float*)nullptr);
      WT_MAT(a.in[30], 2816, 1024, 1024, W_DN, 0, (const float*)nullptr);
      WT_MAT(a.in[22], 1024, 3072, 3072, W_INCD, 1, (const float*)nullptr);
      WT_MAT(a.in[23], 1024, 1024, 1024, W_OUTCD, 0, (const float*)nullptr);
      WT_MAT(a.in[27] + (size_t)1024 * 5632, 1024, 5632, 5632, W_UP + (size_t)5632 * 1024 * 2, 2, (const float*)nullptr);
      WT_MAT(a.in[30] + (size_t)2816 * 1024, 2816, 1024, 1024, W_DN + (size_t)1024 * 2816 * 2, 0, (const float*)nullptr);
#undef WT_MAT
    }
    { const int gt = vcu * 512 + tid, NT_ = G * 512;
      float* c64 = (float*)(ws + WS_R64C); float* s64 = (float*)(ws + WS_R64S); float* c128 = (float*)(ws + WS_R128C); float* s128 = (float*)(ws + WS_R128S);
      for (int i = gt; i < 2048 * 32; i += NT_) { const int t = i >> 5, j = i & 31, ii = j & 15; const float inv = powf(10000.f, -(float)ii / 16.f), pos = j < 16 ? (float)(t >> 6) : (float)(t & 63);
        float sv, cv; sincosf(pos * inv, &sv, &cv); c64[i] = cv; s64[i] = sv; }
      for (int i = gt; i < 2048 * 64; i += NT_) { const int t = i >> 6, j = i & 63, ii = j & 31; const float inv = powf(10000.f, -(float)ii / 32.f), pos = j < 32 ? (float)(t >> 6) : (float)(t & 63);
        float sv, cv; sincosf(pos * inv, &sv, &cv); c128[i] = cv; s128[i] = sv; }
    }
    { XcdBarrier b2; b2.bar = (unsigned*)(ws + WS_CTL) + 4096; b2.x = xb_xcc_id(); b2.st = (volatile LAS unsigned*)(L + MISC_OFF) + 8; xcd_wait(b2); }

    norm_rows(ws, x, ctx, true, 0, 0, 0, gw, NGW, lane);
  } else if (ph == 1) {
    norm_rows(ws, x, ctx, true, 0, 0, 0, gw, NGW, lane);
  } else if (ph == 16) {
    norm_rows(ws, x, ctx, false, 1, 1, 1, gw, NGW, lane);
  } else if (ph == 24 || ph == 26) {
    norm_rows(ws, x, ctx, false, ph == 24 ? 0 : 1, ph == 24 ? 1 : 0, 2, gw, NGW, lane);
  } else if (ph == 23 || ph == 25) {
    const int nctx = ph == 23 ? 64 : 128;
    if (bx < nctx) {
      Epi<false> E{}; E.ws = ws; E.scr = (LAS float*)(L + SCR_OFF); E.kind = EK_RES; E.gate = MODS + (ph == 23 ? 2 : 5) * 1024; E.hin_c = ph == 23 ? ctx : nullptr; E.hin_l = ph == 23 ? x : nullptr;
      SchedCtx S; S.c = bx & 63;
      if (ph == 23) { pg8::Gemm g{(const bf16_t*)(ws + R_CAT), (const bf16_t*)(ws + W_OUTAB), 1024, 1024}; pg8::gemm_phase<Epi<false>, SchedCtx, false>(L, g, S, E); }
      else { const int kh = bx >> 6; unsigned* fl = (unsigned*)(ws + WS_CTL) + 256 + 16 * (bx & 63); E.wflag = kh ? fl : nullptr;
        pg8::Gemm g{(const bf16_t*)(ws + R_HH) + (size_t)kh * 44 * TT * 32, (const bf16_t*)(ws + W_DN) + kh * 1408, 1408, 2816, 2816}; pg8::gemm_phase<Epi<false>, SchedCtx, false, true>(L, g, S, E);
        if (kh == 0 && tid == 0) { __builtin_amdgcn_fence(__ATOMIC_RELEASE, "agent"); (void)xb_add(fl, 1u); }
      }
      { XcdBarrier b2; b2.bar = (unsigned*)(ws + WS_CTL) + 4096; b2.x = 0; b2.st = (volatile LAS unsigned*)(L + MISC_OFF) + 8; xcd_wait(b2); }
    } else {
      const int gw2 = (bx - nctx) * NWAVES + wave, NGW2 = (G - nctx) * NWAVES;
      { XcdBarrier b2; b2.bar = (unsigned*)(ws + WS_CTL) + 4096; b2.x = 0; b2.st = (volatile LAS unsigned*)(L + MISC_OFF) + 8; xcd_wait(b2); }
      norm_rows(ws, x, ctx, false, ph == 23 ? 0 : 1, ph == 23 ? 1 : 0, 1, gw2, NGW2, lane);
    }
  } else if (ph == 2 || ph == 7 || ph == 9 || ph == 11 || ph == 13 || ph == 15 || ph == 17 || ph == 19) {
    const int l = ph >= 12 ? 1 : 0;
    if (ph == 9 || ph == 17) {
      Epi<true> E{}; E.kind = EK_UP; E.ws = ws; E.scr = (LAS float*)(L + SCR_OFF); E.cw = a.in[28] + (size_t)l * 3 * FFH; E.cb = a.in[29] + (size_t)l * FFH;
      pg8::Gemm g{(const bf16_t*)(ws + WS_XN), (const bf16_t*)(ws + W_UP + (size_t)l * 5632 * 1024 * 2), 1024, 1024};
      if (ph == 9) { SchedFull S; S.so.init(144, 22, G, bx); pg8::gemm_phase<Epi<true>, SchedFull, true>(L, g, S, E); }
      else { SchedLat S; S.so.init(128, 22, G, bx); pg8::gemm_phase<Epi<true>, SchedLat, true>(L, g, S, E); }
    } else {
      Epi<false> E{}; E.ws = ws; E.scr = (LAS float*)(L + SCR_OFF);
      if (ph == 2) { E.kind = EK_INAB; pg8::Gemm g{(const bf16_t*)(ws + WS_XN), (const bf16_t*)(ws + W_INAB), 1024, 1024}; SchedFull S; S.so.init(144, 5, G, bx); pg8::gemm_phase<Epi<false>, SchedFull, false>(L, g, S, E); }
      else if (ph == 13) { E.kind = EK_INCD; E.gq = a.in[25]; E.gk = a.in[26]; pg8::Gemm g{(const bf16_t*)(ws + WS_XN), (const bf16_t*)(ws + W_INCD), 1024, 1024};
        SchedInCd S; S.so.init(128, 12, G, bx); S.G = G; S.c = bx; pg8::gemm_phase<Epi<false>, SchedInCd, false>(L, g, S, E); }
      else {
        E.kind = EK_RES; const int which = (ph == 11 || ph == 19) ? 1 : 0; E.gate = MODS + (size_t)l * 17 * 6144 + (which * 3 + 2) * 1024;
        E.hin_c = ph == 7 ? ctx : nullptr; E.hin_l = ph == 7 ? x : nullptr;
        if (ph == 7) { pg8::Gemm g{(const bf16_t*)(ws + R_CAT), (const bf16_t*)(ws + W_OUTAB), 1024, 1024}; SchedLat S; S.so.init(128, 4, G, bx); pg8::gemm_phase<Epi<false>, SchedLat, false>(L, g, S, E); }
        else if (ph == 11) { pg8::Gemm g{(const bf16_t*)(ws + R_HH), (const bf16_t*)(ws + W_DN), 2816, 2816}; SchedLat S; S.so.init(128, 4, G, bx); pg8::gemm_phase<Epi<false>, SchedLat, false, true>(L, g, S, E); }
        else if (ph == 15) { pg8::Gemm g{(const bf16_t*)(ws + R_CAT1), (const bf16_t*)(ws + W_OUTCD), 1024, 1024}; SchedLat S; S.so.init(128, 4, G, bx); pg8::gemm_phase<Epi<false>, SchedLat, false>(L, g, S, E); }
        else { pg8::Gemm g{(const bf16_t*)(ws + R_HH), (const bf16_t*)(ws + W_DN + (size_t)1024 * 2816 * 2), 2816, 2816}; SchedLat S; S.so.init(128, 4, G, bx); pg8::gemm_phase<Epi<false>, SchedLat, false, true>(L, g, S, E); }
      }
    }
  } else if (ph == 3) {
    Epi<false> E{}; E.ws = ws; E.scr = (LAS float*)(L + SCR_OFF);
    { E.kind = EK_S5E; pg8::Gemm g{(const bf16_t*)(ws + R_A5), (const bf16_t*)(ws + WS_S5PB), 256, 512}; SchedS5 S; S.G = G; S.c = bx; pg8::gemm_phase<Epi<false>, SchedS5, false>(L, g, S, E); }
    { E.kind = EK_Q; pg8::Gemm g{(const bf16_t*)(ws + R_CQ), (const bf16_t*)(ws + W_UQ), 384, 384}; SchedFull S; S.so.init(144, 3, G, (bx + 224) & 255); pg8::gemm_phase<Epi<false>, SchedFull, false>(L, g, S, E); }
    { E.kind = EK_KV; pg8::Gemm g{(const bf16_t*)(ws + R_CKV), (const bf16_t*)(ws + W_UKV), 256, 256}; SchedFull S; S.so.init(144, 4, G, (bx + 48) & 255); pg8::gemm_phase<Epi<false>, SchedFull, false>(L, g, S, E); }
  } else if (ph == 4) {
    unsigned* CT = (unsigned*)(ws + WS_CTL); unsigned* TMO = CT + 4096;
    const bf16_t* Q = (const bf16_t*)(ws + R_Q); const bf16_t* Kb = (const bf16_t*)(ws + R_K); const bf16_t* Vb = (const bf16_t*)(ws + R_V); bf16_t* CAT = (bf16_t*)(ws + R_CAT);
    if (bx >= 128) { const int w = (bx - 128) * NWAVES + wave; s5_chunk_scan(ws, w & 31, (w >> 5) & 15, w >> 9, lane);
      asm volatile("s_waitcnt vmcnt(0)" ::: "memory"); __syncthreads();
    }
    { XcdBarrier b2; b2.bar = (unsigned*)(ws + WS_CTL) + 4096; b2.x = xb_xcc_id(); b2.st = (volatile LAS unsigned*)(L + MISC_OFF) + 8; xcd_arrive(b2); }
    { const int u = vcu, bh = u >> 3, qb = u & 7, b = bh >> 2, h = bh & 3; const size_t r0 = (size_t)b * RB + NCTX + 256 * qb;
      att::attn_unit<192, 0, 0, 768, 768, 512, 1024, 0>(Q + r0 * 768 + 192 * h, Kb + (size_t)b * RB * 768 + 192 * h, Vb + (size_t)b * RB * 512 + 128 * h, CAT + r0 * 1024 + 512 + 128 * h, RB, (char*)lds, 0, 0.f, 0.f, nullptr); }
    { XcdBarrier b2; b2.bar = (unsigned*)(ws + WS_CTL) + 4096; b2.x = xb_xcc_id(); b2.st = (volatile LAS unsigned*)(L + MISC_OFF) + 8; xcd_wait(b2); }

    { Epi<false> E{}; E.ws = ws; E.scr = (LAS float*)(L + SCR_OFF); E.kind = EK_S5Y;
      pg8::Gemm g{(const bf16_t*)(ws + R_A5), (const bf16_t*)(ws + WS_S5MR), 512, 512}; SchedS5 S; S.G = G; S.c = bx; pg8::gemm_phase<Epi<false>, SchedS5, false>(L, g, S, E); }
    { XcdBarrier b2; b2.bar = (unsigned*)(ws + WS_CTL) + 4096; b2.x = xb_xcc_id(); b2.st = (volatile LAS unsigned*)(L + MISC_OFF) + 8; xcd_arrive(b2); }
    { const int u = vcu + 256, bh = u >> 3, qb = u & 7, b = bh >> 2, h = bh & 3; const size_t r0 = (size_t)b * RB + NCTX + 256 * qb;
      att::attn_unit<192, 0, 0, 768, 768, 512, 1024, 0>(Q + r0 * 768 + 192 * h, Kb + (size_t)b * RB * 768 + 192 * h, Vb + (size_t)b * RB * 512 + 128 * h, CAT + r0 * 1024 + 512 + 128 * h, RB, (char*)lds, 0, 0.f, 0.f, nullptr); }
    if (bx >= 64 && bx < 128) { const int bh = bx - 64, b = bh >> 2, h = bh & 3; const size_t r0 = (size_t)b * RB;
      att::attn_unit<192, 0, 0, 768, 768, 512, 1024, 0>(Q + r0 * 768 + 192 * h, Kb + r0 * 768 + 192 * h, Vb + r0 * 512 + 128 * h, CAT + r0 * 1024 + 512 + 128 * h, NCTX, (char*)lds, 0, 0.f, 0.f, nullptr); }
    { XcdBarrier b2; b2.bar = (unsigned*)(ws + WS_CTL) + 4096; b2.x = xb_xcc_id(); b2.st = (volatile LAS unsigned*)(L + MISC_OFF) + 8; xcd_wait(b2); }

    { Epi<false> E{}; E.ws = ws; E.scr = (LAS float*)(L + SCR_OFF); E.kind = EK_GLU; E.bglu = a.in[17];
      pg8::Gemm g{(const bf16_t*)(ws + R_G), (const bf16_t*)(ws + W_GLU), 512, 512}; SchedFull S; S.so.init(144, 2, G, (bx + 224) & 255); pg8::gemm_phase<Epi<false>, SchedFull, false>(L, g, S, E); }
  } else if (ph == 5) {
    Epi<false> E{}; E.ws = ws; E.scr = (LAS float*)(L + SCR_OFF); E.kind = EK_S5Y;
    pg8::Gemm g{(const bf16_t*)(ws + R_A5), (const bf16_t*)(ws + WS_S5MR), 512, 512}; SchedS5 S; S.G = G; S.c = bx; pg8::gemm_phase<Epi<false>, SchedS5, false>(L, g, S, E);
  } else if (ph == 6) {
    const bf16_t* Q = (const bf16_t*)(ws + R_Q); const bf16_t* Kb = (const bf16_t*)(ws + R_K); const bf16_t* Vb = (const bf16_t*)(ws + R_V); bf16_t* CAT = (bf16_t*)(ws + R_CAT);
#pragma unroll 1
    for (int k = 0; k < 2; ++k) { const int u = vcu + 256 * k, bh = u >> 3, qb = u & 7, b = bh >> 2, h = bh & 3; const size_t r0 = (size_t)b * RB + NCTX + 256 * qb;
      att::attn_unit<192, 0, 0, 768, 768, 512, 1024, 0>(Q + r0 * 768 + 192 * h, Kb + (size_t)b * RB * 768 + 192 * h, Vb + (size_t)b * RB * 512 + 128 * h, CAT + r0 * 1024 + 512 + 128 * h, RB, (char*)lds, 0, 0.f, 0.f, nullptr); }
    if (vcu >= 64 && vcu < 128) { const int bh = vcu - 64, b = bh >> 2, h = bh & 3; const size_t r0 = (size_t)b * RB;
      att::attn_unit<192, 0, 0, 768, 768, 512, 1024, 0>(Q + r0 * 768 + 192 * h, Kb + r0 * 768 + 192 * h, Vb + r0 * 512 + 128 * h, CAT + r0 * 1024 + 512 + 128 * h, NCTX, (char*)lds, 0, 0.f, 0.f, nullptr); }
    Epi<false> E{}; E.ws = ws; E.scr = (LAS float*)(L + SCR_OFF); E.kind = EK_GLU; E.bglu = a.in[17];
    pg8::Gemm g{(const bf16_t*)(ws + R_G), (const bf16_t*)(ws + W_GLU), 512, 512}; SchedFull S; S.so.init(144, 2, G, bx); pg8::gemm_phase<Epi<false>, SchedFull, false>(L, g, S, E);
  } else if (ph == 10 || ph == 18) {
    const int l = ph == 18 ? 1 : 0; const float* cw = a.in[28] + (size_t)l * 3 * FFH; bf16_t* HH = (bf16_t*)(ws + R_HH);
    const float* EP = (const float*)(ws + WS_EDGE); const float* EG = EP + EDGE_ARR / 4; const float* EA = EG + EDGE_ARR / 4;
    constexpr int NE = NBLK128 * 2 * FFH; const int st = G * 512;
    for (int i0 = vcu * 512 + tid; i0 < NE; i0 += 4 * st) {
      float ep[4], eg[4], ea[4], wv[4]; bool ok[4], nb[4];
#pragma unroll
      for (int q = 0; q < 4; ++q) { const int i = i0 + q * st; const bool in = i < NE; const int ii = in ? i : i0; const int j = ii % FFH, be = ii / FFH, e = be & 1, blk = be >> 1, bi = blk % 18;
        ok[q] = in && !(l == 1 && bi < 2); nb[q] = e == 0 ? !(bi == 0 || bi == 2) : !(bi == 1 || bi == 17);
        ep[q] = EP[ii]; eg[q] = EG[ii]; wv[q] = cw[(e ? 2 * FFH : 0) + j];
        const size_t an = e == 0 ? ((size_t)(nb[q] ? blk - 1 : blk) * 2 + 1) * FFH + j : ((size_t)(nb[q] ? blk + 1 : blk) * 2 + 0) * FFH + j; ea[q] = EA[an]; }
#pragma unroll
      for (int q = 0; q < 4; ++q) { const int i = i0 + q * st; if (!ok[q]) continue; const int j = i % FFH, be = i / FFH, e = be & 1, blk = be >> 1;
        const float cv = nb[q] ? ep[q] + wv[q] * ea[q] : ep[q];
        HH[((size_t)(j >> 5) * TT + (size_t)blk * 128 + (e ? 127 : 0)) * 32 + (j & 31)] = f2bf(gelu_t(cv) * eg[q]); }
    }
  } else if (ph == 14) {
    bf16_t* CAT1 = (bf16_t*)(ws + R_CAT1); const bf16_t* RK = (const bf16_t*)(ws + R_RK); const bf16_t* RV = (const bf16_t*)(ws + R_RV); const bf16_t* RG = (const bf16_t*)(ws + R_RG);
    const bf16_t* GK = (const bf16_t*)(ws + R_GK); const bf16_t* GV = (const bf16_t*)(ws + R_GV);
    { const int bh = vcu >> 2, dir = (vcu >> 1) & 1, hf = vcu & 1, b = bh >> 2, h = bh & 3; const float dl = a.in[24][dir * 4 + h];
      const float l2 = __uint_as_float(__builtin_amdgcn_readfirstlane(__float_as_uint(-log1pf(expf(-dl)) * LOG2E)));
      att::ret_state_unit(RK + (size_t)b * RB * 512 + 128 * h, RV + (size_t)b * RB * 512 + 128 * h, (bf16_t*)(ws + R_ST) + (size_t)(bh * 2 + dir) * 8 * 16384, dir, hf, l2, (char*)lds); }

    { XcdBarrier b2; b2.bar = (unsigned*)(ws + WS_CTL) + 4096; b2.x = xb_xcc_id(); b2.st = (volatile LAS unsigned*)(L + MISC_OFF) + 8; xcd_arrive(b2); }
#pragma unroll 1
    for (int k = 0; k < 2; ++k) { const int u = vcu + 256 * k, bh = u >> 3, qb = u & 7, b = bh >> 2, h = bh & 3; const size_t r0 = (size_t)b * RB + NCTX + 256 * qb, rb = (size_t)b * RB;
      att::attn_unit<128, 0, 1, 1024, 256, 256, 1024, 0>(CAT1 + r0 * 1024 + 512 + 128 * h, GK + rb * 256 + 128 * (h >> 1), GV + rb * 256 + 128 * (h >> 1), CAT1 + r0 * 1024 + 512 + 128 * h, RB, (char*)lds, 0, 0.f, 0.f, nullptr); }
    { XcdBarrier b2; b2.bar = (unsigned*)(ws + WS_CTL) + 4096; b2.x = xb_xcc_id(); b2.st = (volatile LAS unsigned*)(L + MISC_OFF) + 8; xcd_wait(b2); }

    const bf16_t* ST = (const bf16_t*)(ws + R_ST);
#pragma unroll 1
    for (int k = 0; k < 2; ++k) { const int u = vcu + 256 * k, bh = u >> 3, qb = u & 7, b = bh >> 2, h = bh & 3; const size_t r0 = (size_t)b * RB + NCTX + 256 * qb;
      const float dl_f = a.in[24][h], dl_b = a.in[24][4 + h]; const float lf2 = __uint_as_float(__builtin_amdgcn_readfirstlane(__float_as_uint(-log1pf(expf(-dl_f)) * LOG2E))), lb2 = __uint_as_float(__builtin_amdgcn_readfirstlane(__float_as_uint(-log1pf(expf(-dl_b)) * LOG2E)));
      att::ret_out_unit(CAT1 + r0 * 1024 + 128 * h, RK + r0 * 512 + 128 * h, RV + r0 * 512 + 128 * h, ST + ((size_t)(bh * 2 + 0) * 8 + qb) * 16384, ST + ((size_t)(bh * 2 + 1) * 8 + qb) * 16384, RG + r0 * 512 + 128 * h, lf2, lb2, (char*)lds); }
  } else if (ph == 20) {
    const float* gf = a.in[31]; f32x4 gfv[4];
#pragma unroll
    for (int j = 0; j < 4; ++j) gfv[j] = *(const f32x4*)(gf + lane * 4 + 256 * j);
    constexpr int NP = 16 * NLAT / 2;
#define FN_LOAD(W, k) do { const int row_ = 2 * (k); const bf16_t* hr_ = HB + ((size_t)(row_ >> 11) * RB + NCTX + (row_ & 2047)) * 1024; \
      _Pragma("unroll") for (int j = 0; j < 4; ++j) { W[j] = *(const u32x2*)(hr_ + lane * 4 + 256 * j); W[4 + j] = *(const u32x2*)(hr_ + 1024 + lane * 4 + 256 * j); } } while (0)
#define FN_STORE(W, k) do { float* orow_ = a.out + (size_t)(2 * (k)) * 1024; f32x4 v0_[4], v1_[4]; float s0_ = 0.f, s1_ = 0.f; \
      _Pragma("unroll") for (int j = 0; j < 4; ++j) { v0_[j] = (f32x4){bflo(W[j].x), bfhi(W[j].x), bflo(W[j].y), bfhi(W[j].y)}; v1_[j] = (f32x4){bflo(W[4 + j].x), bfhi(W[4 + j].x), bflo(W[4 + j].y), bfhi(W[4 + j].y)}; \
        s0_ += (v0_[j][0] * v0_[j][0] + v0_[j][1] * v0_[j][1]) + (v0_[j][2] * v0_[j][2] + v0_[j][3] * v0_[j][3]); s1_ += (v1_[j][0] * v1_[j][0] + v1_[j][1] * v1_[j][1]) + (v1_[j][2] * v1_[j][2] + v1_[j][3] * v1_[j][3]); } \
      const float r0_ = rsqrtf(wave_sum64(s0_) * (1.f / 1024.f) + EPS_N), r1_ = rsqrtf(wave_sum64(s1_) * (1.f / 1024.f) + EPS_N); \
      _Pragma("unroll") for (int j = 0; j < 4; ++j) { *(f32x4*)(orow_ + lane * 4 + 256 * j) = v0_[j] * r0_ * gfv[j]; *(f32x4*)(orow_ + 1024 + lane * 4 + 256 * j) = v1_[j] * r1_ * gfv[j]; } } while (0)
    if (gw < NP) { u32x2 WA[8], WB[8]; FN_LOAD(WA, gw);
      for (int k = gw; k < NP; k += 2 * NGW) { const int k1 = k + NGW, k2 = k + 2 * NGW;
        if (k1 < NP) FN_LOAD(WB, k1);
        FN_STORE(WA, k);
        if (k1 >= NP) break;
        if (k2 < NP) FN_LOAD(WA, k2);
        FN_STORE(WB, k1); } }
#undef FN_LOAD
#undef FN_STORE
  }
}

__global__ void __launch_bounds__(NWAVES * 64, 2) mega_fwd(MArgs a) {
  extern __shared__ __attribute__((aligned(16))) unsigned char lds[];
  LAS unsigned char* L = (LAS unsigned char*)lds;
  volatile LAS unsigned* MISC = (volatile LAS unsigned*)(L + MISC_OFF);
  const int tid = threadIdx.x, lane = tid & 63, wave = __builtin_amdgcn_readfirstlane(tid >> 6);
  const int G = gridDim.x, bx = blockIdx.x, vcu = (G % 8 == 0) ? (bx % 8) * (G / 8) + bx / 8 : bx;
  for (int u = tid; u < 64; u += NWAVES * 64) MISC[u] = 0u;
  __syncthreads();
  XcdBarrier bar; bar.bar = (unsigned*)(a.ws + WS_CTL) + 4096; bar.x = 0; bar.st = nullptr;
  const int lo = a.ph_lo, hi = a.ph_hi;
  if (hi - lo > 1) bar = xcd_barrier_post((unsigned*)(a.ws + WS_CTL) + 4096, MISC + 8);
#ifndef MK_DUP
#define MK_DUP 0
#endif
#define RUN(k) do { if (lo <= (k) && (k) < hi) { run_phase<k>(a, lds, tid, lane, wave, G, bx, vcu); if ((k) != 20 && hi - lo > 1) xcd_barrier(bar); \
    if constexpr (((MK_DUP) >> (k)) & 1) { run_phase<k>(a, lds, tid, lane, wave, G, bx, vcu); xcd_barrier(bar); } } } while (0)
#define RUNAR(k) do { if (lo <= (k) && (k) < hi) { run_phase<k>(a, lds, tid, lane, wave, G, bx, vcu); xcd_arrive(bar); } } while (0)
  RUN(0); RUN(2); RUN(3); RUN(4); RUNAR(7); RUN(23); RUN(24); RUN(9); RUN(10); RUNAR(11); RUN(25); RUN(26); RUN(13); RUN(14); RUN(15); RUN(16); RUN(17); RUN(18); RUN(19); RUN(20);
#ifdef MK_XBAR
  for (int i = 0; i < MK_XBAR; ++i) xcd_barrier(bar);
#endif
#undef RUN
}

#ifndef MK_SINGLE
#define MK_SINGLE 1
#endif
static void mk_launch(void* const* d_in, void* d_out, void* d_ws, hipStream_t stream) {
  static int ok = 0;
  if (!ok) { if (hipFuncSetAttribute((const void*)mega_fwd, hipFuncAttributeMaxDynamicSharedMemorySize, LDS_BYTES) != hipSuccess) { fprintf(stderr, "hipFuncSetAttribute failed\n"); return; } ok = 1; }
  (void)hipMemsetAsync((char*)d_ws + WS_CTL, 0, CTL_BYTES, stream);
  MArgs a{}; for (int i = 0; i < 32; ++i) a.in[i] = (const float*)d_in[i]; a.out = (float*)d_out; a.ws = (unsigned char*)d_ws;
  if (MK_SINGLE) { a.ph_lo = 0; a.ph_hi = 27; hipLaunchKernelGGL(mega_fwd, dim3(256), dim3(512), LDS_BYTES, stream, a); }
  else for (int p = 0; p < 21; ++p) { a.ph_lo = p; a.ph_hi = p + 1; hipLaunchKernelGGL(mega_fwd, dim3(256), dim3(512), LDS_BYTES, stream, a); }
}
extern "C" void kernel_launch(void* const* d_in, const int* in_sizes, int n_in, void* d_out, int out_size, void* d_ws, size_t ws_size, hipStream_t stream) {
  if (ws_size < WS_END) { fprintf(stderr, "kernel_launch: workspace too small (%zu < %zu)\n", ws_size, (size_t)WS_END); return; }
  mk_launch(d_in, d_out, d_ws, stream);
}
```
